# Optimizing an MI355X kernel written in HIP

```python
import jax
import jax.numpy as jnp
from jax import lax
import numpy as np

D_MODEL = 1024
BATCH = 4
SEQ = 8192
DEPTH = 2

N_META = 16
LEAD = 128
PAD = LEAD - N_META
Q_BLOCK = 128
CHUNK = 64
EPS = 1e-6
NEG_INF = -1e30

MLA_HEADS = 8
MLA_Q_LORA = 256
MLA_KV_LORA = 128
MLA_NOPE = 64
MLA_ROPE = 32
MLA_V = 64
MLA_QK = MLA_NOPE + MLA_ROPE
MLA_VW = MLA_HEADS * MLA_V
ROPE_THETA = 10000.0

GLA_HEADS = 4
GLA_DK = 64
GLA_DV = 128
GLA_KW = GLA_HEADS * GLA_DK
GLA_VW = GLA_HEADS * GLA_DV
GLA_GATE_RANK = 16
GLA_GATE_NORM = 16.0

HGRN_HEADS = 4
HGRN_DK = 128
HGRN_DV = 128
HGRN_KW = HGRN_HEADS * HGRN_DK
HGRN_VW = HGRN_HEADS * HGRN_DV

N_BRANCH = 3
IN_SPLITS = (MLA_Q_LORA, MLA_KV_LORA, MLA_ROPE, GLA_KW, GLA_KW, GLA_VW, GLA_GATE_RANK, GLA_VW, HGRN_KW, HGRN_KW, HGRN_VW, HGRN_VW, N_BRANCH * D_MODEL)
IN_COLS = sum(IN_SPLITS)

D_FF = 2816
N_EXPERTS = 8
TOP_K = 2
D_EXPERT = 3584
MOE_BLOCK = 128
N_DENSE = (DEPTH + 1) // 2
N_MOE = DEPTH // 2

kernel_name = 'hybrid_mla_gla_hgrn2_moe_block'


def rmsnorm(x, g):
    xf = x.astype(jnp.float32)
    y = xf * lax.rsqrt(jnp.mean(xf * xf, axis=-1, keepdims=True) + EPS)
    return (y * g.astype(jnp.float32)).astype(x.dtype)


def rope(x, pos):
    half = x.shape[-1] // 2
    inv = ROPE_THETA ** (-jnp.arange(half, dtype=jnp.float32) / half)
    ang = pos.astype(jnp.float32)[:, None] * inv[None, :]
    cos = jnp.cos(ang)[None, :, None, :]
    sin = jnp.sin(ang)[None, :, None, :]
    xf = x.astype(jnp.float32)
    x1, x2 = xf[..., :half], xf[..., half:]
    return jnp.concatenate([x1 * cos - x2 * sin, x1 * sin + x2 * cos], axis=-1).astype(x.dtype)


def causal_block_attention(q, k, v):
    B, L, H, dq = q.shape
    padw = ((0, 0), (PAD, 0), (0, 0), (0, 0))
    qp, kp, vp = (jnp.pad(t, padw) for t in (q, k, v))
    Lp = L + PAD
    nb = Lp // Q_BLOCK
    key_pos = jnp.arange(Lp)
    key_ok = key_pos >= PAD
    q_blocks = qp.reshape(B, nb, Q_BLOCK, H, dq).transpose(1, 0, 2, 3, 4)
    scale = dq ** -0.5

    def attend(args):
        qb, i = args
        s = jnp.einsum('bqhd,bkhd->bhqk', qb, kp).astype(jnp.float32) * scale
        q_pos = i * Q_BLOCK + jnp.arange(Q_BLOCK)
        mask = (key_pos[None, :] <= q_pos[:, None]) & key_ok[None, :]
        p = jax.nn.softmax(jnp.where(mask, s, NEG_INF), axis=-1).astype(vp.dtype)
        return jnp.einsum('bhqk,bkhd->bqhd', p, vp)

    o = lax.map(attend, (q_blocks, jnp.arange(nb)))
    o = o.transpose(1, 0, 2, 3, 4).reshape(B, Lp, H, v.shape[-1])
    return o[:, PAD:]


def chunk_gated_linear_attention(q, k, v, log_g):
    dtype = v.dtype
    B, L, H, dk = q.shape
    dv = v.shape[-1]
    Lp = L + PAD
    N = Lp // CHUNK
    padw = ((0, 0), (PAD, 0), (0, 0), (0, 0))

    def to_chunks(t):
        return jnp.pad(t.astype(jnp.float32), padw).reshape(B, N, CHUNK, H, t.shape[-1])

    q, k, v, log_g = (to_chunks(t) for t in (q, k, v, log_g))
    b = jnp.cumsum(log_g, axis=2)
    b_ref = b[:, :, CHUNK // 2 - 1:CHUNK // 2]
    b_last = b[:, :, CHUNK - 1:CHUNK]
    causal = jnp.tril(jnp.ones((CHUNK, CHUNK), dtype=bool))
    a = jnp.einsum('bnihd,bnjhd->bnhij', q * jnp.exp(b - b_ref), k * jnp.exp(b_ref - b))
    a = jnp.where(causal, a, 0.0)
    o_intra = jnp.einsum('bnhij,bnjhv->bnihv', a, v)
    d_state = jnp.einsum('bnjhd,bnjhv->bnhdv', k * jnp.exp(b_last - b), v)
    decay = jnp.exp(b_last[:, :, 0])

    def step(S, inp):
        ds_n, dec_n = inp
        return dec_n[..., None] * S + ds_n, S

    _, s_prev = lax.scan(step, jnp.zeros((B, H, dk, dv), jnp.float32),
                         (jnp.moveaxis(d_state, 1, 0), jnp.moveaxis(decay, 1, 0)))
    s_prev = jnp.moveaxis(s_prev, 0, 1)
    o_inter = jnp.einsum('bnihd,bnhdv->bnihv', q * jnp.exp(b), s_prev)
    o = (o_intra + o_inter).reshape(B, Lp, H, dv)[:, PAD:]
    return o.astype(dtype)


def mla_branch(x_dq, x_dkv, x_kr, cq_norm, w_uq, ckv_norm, w_ukv, q_norm, k_norm):
    B, L, _ = x_dq.shape
    pos = jnp.arange(L, dtype=jnp.int32)
    q = (rmsnorm(x_dq, cq_norm) @ w_uq).reshape(B, L, MLA_HEADS, MLA_QK)
    kv = (rmsnorm(x_dkv, ckv_norm) @ w_ukv).reshape(B, L, MLA_HEADS, MLA_NOPE + MLA_V)
    k_rope = jnp.broadcast_to(x_kr[:, :, None, :], (B, L, MLA_HEADS, MLA_ROPE))
    k = jnp.concatenate([kv[..., :MLA_NOPE], k_rope], axis=-1)
    v = kv[..., MLA_NOPE:]
    q = rmsnorm(q, q_norm)
    k = rmsnorm(k, k_norm)
    q = jnp.concatenate([q[..., :MLA_NOPE], rope(q[..., MLA_NOPE:], pos)], axis=-1)
    k = jnp.concatenate([k[..., :MLA_NOPE], rope(k[..., MLA_NOPE:], pos)], axis=-1)
    return causal_block_attention(q, k, v).reshape(B, L, MLA_VW)


def gla_branch(x_q, x_k, x_v, x_gd, x_r, w_g2, b_g, o_norm):
    B, L, _ = x_q.shape
    log_g = jax.nn.log_sigmoid((x_gd @ w_g2 + b_g).astype(jnp.float32)) / GLA_GATE_NORM
    q = x_q.reshape(B, L, GLA_HEADS, GLA_DK) * (GLA_DK ** -0.5)
    k = x_k.reshape(B, L, GLA_HEADS, GLA_DK)
    v = x_v.reshape(B, L, GLA_HEADS, GLA_DV)
    o = chunk_gated_linear_attention(q, k, v, log_g.reshape(B, L, GLA_HEADS, GLA_DK))
    return rmsnorm(o, o_norm).reshape(B, L, GLA_VW) * jax.nn.silu(x_r)


def hgrn2_branch(x_q, x_f, x_i, x_g, lower_bound, o_norm):
    B, L, _ = x_q.shape
    f = lower_bound + (1.0 - lower_bound) * jax.nn.sigmoid(x_f.astype(jnp.float32))
    log_f = jnp.log(f)
    k = 1.0 - f
    q = jax.nn.silu(x_q)
    o = chunk_gated_linear_attention(q.reshape(B, L, HGRN_HEADS, HGRN_DK), k.reshape(B, L, HGRN_HEADS, HGRN_DK),
                                     x_i.reshape(B, L, HGRN_HEADS, HGRN_DV), log_f.reshape(B, L, HGRN_HEADS, HGRN_DK))
    return rmsnorm(o, o_norm).reshape(B, L, HGRN_VW) * jax.nn.silu(x_g)


def swiglu(u, w_gate, w_up, w_down):
    return (jax.nn.silu(u @ w_gate) * (u @ w_up)) @ w_down


def moe_swiglu(u, w_router, b_router, w_gate, w_up, w_down):
    B, L, D = u.shape
    T = B * L
    A = T * TOP_K
    xt = u.reshape(T, D)
    logits = (xt @ w_router + b_router).astype(jnp.float32)
    top_val, top_idx = lax.top_k(logits, TOP_K)
    gate = jax.nn.softmax(top_val, axis=-1)
    e_flat = top_idx.reshape(A)
    tok_flat = jnp.repeat(jnp.arange(T, dtype=jnp.int32), TOP_K)
    order = jnp.argsort(e_flat)
    e_sorted = e_flat[order]
    counts = jnp.bincount(e_flat, length=N_EXPERTS)
    start = jnp.cumsum(counts) - counts
    padded = (counts + MOE_BLOCK - 1) // MOE_BLOCK * MOE_BLOCK
    pend = jnp.cumsum(padded)
    pstart = pend - padded
    dest = pstart[e_sorted] + jnp.arange(A) - start[e_sorted]
    n_blocks = -(-A // MOE_BLOCK) + N_EXPERTS
    P = n_blocks * MOE_BLOCK
    slot_tok = jnp.zeros((P,), jnp.int32).at[dest].set(tok_flat[order])
    slot_w = jnp.zeros((P,), jnp.float32).at[dest].set(gate.reshape(A)[order])
    block_expert = jnp.minimum(jnp.searchsorted(pend, jnp.arange(n_blocks) * MOE_BLOCK, side='right'), N_EXPERTS - 1)

    def expert_block(args):
        tok, e = args
        xb = xt[tok]
        hb = jax.nn.silu(xb @ w_gate[e]) * (xb @ w_up[e])
        return hb @ w_down[e]

    y_slots = lax.map(expert_block, (slot_tok.reshape(n_blocks, MOE_BLOCK), block_expert))
    y_slots = y_slots.reshape(P, D) * slot_w[:, None].astype(u.dtype)
    return jnp.zeros((T, D), u.dtype).at[slot_tok].add(y_slots).reshape(B, L, D)


def setup_inputs(seed: int = 0) -> dict:
    key = jax.random.key(seed)
    keys = iter(jax.random.split(key, 40))
    f32 = jnp.float32

    def w(shape, fan_in):
        return jax.random.normal(next(keys), shape, f32) * (fan_in ** -0.5)

    def gain(shape):
        return 1.0 + 0.02 * jax.random.normal(next(keys), shape, f32)

    def small(shape, s):
        return s * jax.random.normal(next(keys), shape, f32)

    return {
        'x': jax.random.normal(next(keys), (BATCH, SEQ, D_MODEL), f32),
        'meta_tokens': small((N_META, D_MODEL), 1.0),
        'attn_norm': gain((DEPTH, D_MODEL)),
        'w_in': w((DEPTH, D_MODEL, IN_COLS), D_MODEL),
        'mla_cq_norm': gain((DEPTH, MLA_Q_LORA)),
        'w_mla_uq': w((DEPTH, MLA_Q_LORA, MLA_HEADS * MLA_QK), MLA_Q_LORA),
        'mla_ckv_norm': gain((DEPTH, MLA_KV_LORA)),
        'w_mla_ukv': w((DEPTH, MLA_KV_LORA, MLA_HEADS * (MLA_NOPE + MLA_V)), MLA_KV_LORA),
        'mla_q_norm': gain((DEPTH, MLA_QK)),
        'mla_k_norm': gain((DEPTH, MLA_QK)),
        'w_gla_g2': w((DEPTH, GLA_GATE_RANK, GLA_KW), GLA_GATE_RANK),
        'b_gla_g': small((DEPTH, GLA_KW), 0.1),
        'gla_o_norm': gain((DEPTH, GLA_DV)),
        'hgrn_lower_bounds': small((DEPTH, HGRN_KW), 0.1),
        'hgrn_o_norm': gain((DEPTH, HGRN_DV)),
        'w_mla_o': w((DEPTH, MLA_VW, D_MODEL), MLA_VW),
        'w_gla_o': w((DEPTH, GLA_VW, D_MODEL), GLA_VW),
        'w_hgrn_o': w((DEPTH, HGRN_VW, D_MODEL), HGRN_VW),
        'w_out': w((DEPTH, D_MODEL, D_MODEL), D_MODEL),
        'ffn_norm': gain((DEPTH, D_MODEL)),
        'w_ff_gate': w((N_DENSE, D_MODEL, D_FF), D_MODEL),
        'w_ff_up': w((N_DENSE, D_MODEL, D_FF), D_MODEL),
        'w_ff_down': w((N_DENSE, D_FF, D_MODEL), D_FF),
        'w_router': w((N_MOE, D_MODEL, N_EXPERTS), D_MODEL),
        'b_router': small((N_MOE, N_EXPERTS), 0.01),
        'w_exp_gate': w((N_MOE, N_EXPERTS, D_MODEL, D_EXPERT), D_MODEL),
        'w_exp_up': w((N_MOE, N_EXPERTS, D_MODEL, D_EXPERT), D_MODEL),
        'w_exp_down': w((N_MOE, N_EXPERTS, D_EXPERT, D_MODEL), D_EXPERT),
    }


def reference(x, meta_tokens, attn_norm, w_in, mla_cq_norm, w_mla_uq, mla_ckv_norm, w_mla_ukv, mla_q_norm, mla_k_norm,
              w_gla_g2, b_gla_g, gla_o_norm, hgrn_lower_bounds, hgrn_o_norm, w_mla_o, w_gla_o, w_hgrn_o, w_out,
              ffn_norm, w_ff_gate, w_ff_up, w_ff_down, w_router, b_router, w_exp_gate, w_exp_up, w_exp_down):
    B = x.shape[0]
    meta = jnp.broadcast_to(meta_tokens[None].astype(x.dtype), (B, N_META, D_MODEL))
    h = jnp.concatenate([meta, x], axis=1)
    L = h.shape[1]
    lbs = jax.nn.softmax(hgrn_lower_bounds.astype(jnp.float32), axis=0)
    lbs = jnp.cumsum(lbs, axis=0) - lbs[0]
    offsets = np.cumsum(IN_SPLITS)[:-1]
    for layer in range(DEPTH):
        u = rmsnorm(h, attn_norm[layer])
        (mla_dq, mla_dkv, mla_kr, gla_q, gla_k, gla_v, gla_gd, gla_r,
         hgrn_q, hgrn_f, hgrn_i, hgrn_g, gate_logits) = jnp.split(u @ w_in[layer], offsets, axis=-1)
        o_mla = mla_branch(mla_dq, mla_dkv, mla_kr, mla_cq_norm[layer], w_mla_uq[layer], mla_ckv_norm[layer],
                           w_mla_ukv[layer], mla_q_norm[layer], mla_k_norm[layer])
        o_gla = gla_branch(gla_q, gla_k, gla_v, gla_gd, gla_r, w_gla_g2[layer], b_gla_g[layer], gla_o_norm[layer])
        o_hgrn = hgrn2_branch(hgrn_q, hgrn_f, hgrn_i, hgrn_g, lbs[layer], hgrn_o_norm[layer])
        gates = jax.nn.sigmoid(gate_logits).reshape(B, L, N_BRANCH, D_MODEL)
        mixed = (gates[:, :, 0] * (o_mla @ w_mla_o[layer])
                 + gates[:, :, 1] * (o_gla @ w_gla_o[layer])
                 + gates[:, :, 2] * (o_hgrn @ w_hgrn_o[layer]))
        h = h + mixed @ w_out[layer]
        u = rmsnorm(h, ffn_norm[layer])
        if layer % 2 == 0:
            i = layer // 2
            h = h + swiglu(u, w_ff_gate[i], w_ff_up[i], w_ff_down[i])
        else:
            i = layer // 2
            h = h + moe_swiglu(u, w_router[i], b_router[i], w_exp_gate[i], w_exp_up[i], w_exp_down[i])
    return h[:, N_META:]
```

```cpp
#include <hip/hip_runtime.h>
#include <cstdio>
#include <cstdint>

#define GAS __attribute__((address_space(1)))
#define LAS __attribute__((address_space(3)))
typedef unsigned short bf16;
typedef short bf16x8 __attribute__((ext_vector_type(8)));
typedef float f32x4 __attribute__((ext_vector_type(4)));
typedef float f32x2 __attribute__((ext_vector_type(2)));
typedef unsigned u32x4 __attribute__((ext_vector_type(4)));
typedef unsigned u32x2 __attribute__((ext_vector_type(2)));
typedef GAS unsigned gu32;

constexpr int BATCH = 4, SEQ = 8192, NMETA = 16, LTOK = SEQ + NMETA, PADL = 112, LP = LTOK + PADL, M = BATCH * LP, D = 1024;
constexpr int NWAVES = 8, NTHREADS = 512;
constexpr int YW = 4096, NGATE = 3072, IN_COLS = 7088;
constexpr int C_DQ = 0, C_DKV = 256, C_KR = 384, C_GQ = 416, C_GK = 672, C_GV = 928, C_GGD = 1440, C_GR = 1456, C_HQ = 1968, C_HF = 2480, C_HI = 2992, C_HG = 3504, C_END = 4016;
constexpr int QKW = 768, VW = 512;
constexpr float EPS = 1e-6f;
constexpr float QSCALE = 0.10206207261596577f * 1.4426950408889634f;
constexpr int DFF = 2816, DEXP = 3584, NEXP = 8;
constexpr float XB_SCALE = 8.f, WU_SCALE = 64.f, HQ_SCALE = 4.f, WD_SCALE = 128.f;
constexpr int MOE_TILES = 137, MOE_ROWS = MOE_TILES * 256;

constexpr size_t MiB = 1u << 20;
constexpr size_t WS_CTL = 0, CTL_BYTES = 1 * MiB;
constexpr size_t WS_ROPE = 1 * MiB;
constexpr size_t WS_SMALL = 3 * MiB;
constexpr size_t WS_H = 8 * MiB;
constexpr size_t WS_O = 74 * MiB;
constexpr size_t WS_WL = 138 * MiB;
constexpr size_t WS_YM = 160 * MiB;
constexpr size_t WS_YG = 420 * MiB;
constexpr size_t WS_V = 518 * MiB;
constexpr size_t WS_END = 562 * MiB;
constexpr size_t WS_WFF = WS_YG;
constexpr size_t WS_HMID = WS_YM;
constexpr size_t WS_WEXP = WS_YM;
constexpr size_t WS_HQ = WS_YM + 84 * MiB;
constexpr size_t WS_XB = 484 * MiB;
constexpr size_t WL_IN = 0, WL_UQKV = 14 * MiB, WL_OM = WL_UQKV + 1835008, WL_OG = WL_OM + 1572864, WL_OH = WL_OG + 1048576, WL_OUT = WL_OH + 1048576;
static_assert(WL_OUT + 2097152 <= 22 * MiB, "WL");
constexpr size_t DO_U = 0;
constexpr size_t DO_Q = 0, DO_K = 49 * MiB;
constexpr size_t DO_MIX = 49 * MiB;
constexpr size_t DO_XB1 = 0;
constexpr size_t SM_ASG_E = 0, SM_ASG_I = 262144, SM_ASG_W = 524288;
constexpr size_t SM_SLOT_TOK = 786432, SM_SLOT_W = SM_SLOT_TOK + 2 * MOE_ROWS * 4;
constexpr size_t SM_TILE_E = SM_SLOT_W + 2 * MOE_ROWS * 4;
constexpr size_t SM_NT = SM_TILE_E + 2048;
static_assert(SM_NT + 64 <= 5 * MiB, "small");
constexpr int CW_BAR = 4096, CW_CNT = 8192, CW_ATTQ = 16384, CW_LINC = 20480;

constexpr int RING_BYTES = 131072, LDSCTL_OFF = RING_BYTES, MISC_OFF = LDSCTL_OFF + 320, TAB_OFF = MISC_OFF + 128, LDS_BYTES = 147456;

__device__ __forceinline__ unsigned pk2(float lo, float hi) { unsigned r; asm("v_cvt_pk_bf16_f32 %0, %1, %2" : "=v"(r) : "v"(lo), "v"(hi)); return r; }
__device__ __forceinline__ unsigned f2bf(float f) { return pk2(f, f) & 0xffffu; }
__device__ __forceinline__ float bf2f(unsigned short b) { return __builtin_bit_cast(float, (unsigned)b << 16); }
__device__ __forceinline__ float bflo(unsigned w) { return __builtin_bit_cast(float, w << 16); }
__device__ __forceinline__ float bfhi(unsigned w) { return __builtin_bit_cast(float, w & 0xffff0000u); }
template <int CTRL> __device__ __forceinline__ float dppf(float v) { return __builtin_bit_cast(float, __builtin_amdgcn_update_dpp(0, __builtin_bit_cast(int, v), CTRL, 0xF, 0xF, true)); }
__device__ __forceinline__ float sum8(float v) { v += dppf<0xB1>(v); v += dppf<0x4E>(v); v += dppf<0x141>(v); return v; }
__device__ __forceinline__ float sum16(float v) { v = sum8(v); v += dppf<0x140>(v); return v; }
__device__ __forceinline__ float wave_sum(int, float v) {
    v = sum16(v);
    { float a = v, b = v; asm volatile("s_nop 1\n\tv_permlane16_swap_b32 %0, %1\n\ts_nop 1" : "+v"(a), "+v"(b)); v = a + b; }
    { float a = v, b = v; asm volatile("s_nop 1\n\tv_permlane32_swap_b32 %0, %1\n\ts_nop 1" : "+v"(a), "+v"(b)); v = a + b; }
    return v;
}
__device__ __forceinline__ float frcp(float x) { return __builtin_amdgcn_rcpf(x); }
__device__ __forceinline__ float frsq(float x) { return __builtin_amdgcn_rsqf(x); }
__device__ __forceinline__ float flog(float x) { return __builtin_amdgcn_logf(x) * 0.6931471805599453f; }
__device__ __forceinline__ float sigmoidf_(float x) { return frcp(1.f + __expf(-x)); }
__device__ __forceinline__ float siluf_(float x) { return x * frcp(1.f + __expf(-x)); }
#define WAVE_SYNC() do { asm volatile("s_waitcnt lgkmcnt(0)" ::: "memory"); __builtin_amdgcn_wave_barrier(); } while (0)
template <class T> __device__ __forceinline__ const GAS T* gp(const T* p) { return (const GAS T*)p; }
template <class T> __device__ __forceinline__ GAS T* gpw(T* p) { return (GAS T*)p; }
template <class T> __device__ __forceinline__ T gld(const void* p) { return *(const GAS T*)p; }
template <class T> __device__ __forceinline__ void gst(void* p, const T v) { *(GAS T*)p = v; }
__device__ __forceinline__ u32x4 zero4() { unsigned z = 0u; asm volatile("" : "+v"(z)); return (u32x4){z, z, z, z}; }
__device__ __forceinline__ const float* inptr(int k) {
    const __attribute__((address_space(4))) unsigned long long* ka = (const __attribute__((address_space(4))) unsigned long long*)__builtin_amdgcn_kernarg_segment_ptr();
    asm volatile("" : "+s"(ka));
    return (const float*)ka[k];
}

namespace pg8 {
#define PG8_LAS __attribute__((address_space(3)))
typedef unsigned short bf16_t;
constexpr int BM = 256, BK = 64, HALF = 128, HTB = HALF * BK * 2, NXCD = 8, WGM = 8;
__host__ __device__ __forceinline__ int lds_byte(int r, int c) { const int st = (r >> 4) * 2 + (c >> 5), rr = r & 15, cc = c & 31, ob = rr * 64 + cc * 2; return st * 1024 + (ob ^ (((ob >> 9) & 1) << 5)); }
__host__ __device__ __forceinline__ void stage_rc(int b, int& R, int& C) { const int st = b / 1024, sb = b % 1024, swz = sb ^ (((sb >> 9) & 1) << 5); R = (st >> 1) * 16 + swz / 64; C = (st & 1) * 32 + (swz % 64) / 2; }
__host__ __device__ __forceinline__ int perm32(int rho) { const int n = rho >> 4, i = rho & 15; return 8 * (i >> 2) + 4 * n + (i & 3); }

struct Unit { int pm, pn, pb, ao; };
struct Gemm { const bf16_t* A; const bf16_t* Bt; int K, lda, ldb; };

__device__ __forceinline__ void tile_order(long L, int nM, int nN, int& pm, int& pn) {
    const int nwg = nM * nN; int wgid = (int)L;
    { const int q = nwg / NXCD, r = nwg % NXCD, xcd = wgid % NXCD, off = wgid / NXCD; wgid = (xcd < r ? xcd * (q + 1) : r * (q + 1) + (xcd - r) * q) + off; }
    const int nig = WGM * nN, gid = wgid / nig, fm = gid * WGM, gsz = (nM - fm) < WGM ? (nM - fm) : WGM;
    pm = fm + ((wgid % nig) % gsz); pn = (wgid % nig) / gsz;
}
struct Order {
    int nM, nN, nwg, G, c, tpe, boff, grouped; const PG8_LAS int* te; int xrow; int late; int asplit, aoff2;
    __device__ __forceinline__ bool next(int i, Unit& u) const {
        long L = (long)i * G + c;
        if (late > 0) {
            const int nf = G - late, R = nwg / nf;
            if (c >= late) { if (i >= R) return false; L = (long)i * nf + (c - late); } else L = (long)nf * R + (long)i * late + c; }
        if (L >= nwg) return false;
        tile_order(L, nM, nN, u.pm, u.pn);
        u.pb = grouped ? __builtin_amdgcn_readfirstlane(te[u.pm]) * tpe + boff + u.pn : u.pn;
        u.ao = (asplit > 0 && u.pn >= asplit) ? aoff2 : 0;
        u.pm = 2 * u.pm + xrow * ((u.pm >> 5) + 1);
        return true;
    }
    __device__ __forceinline__ void a_ready(const Unit&) const {}
    __device__ __forceinline__ void done(const Unit&) const {}
};

typedef int v8i_t __attribute__((ext_vector_type(8)));
template <class Epi, class Sched, bool ALIGN_EPI = false, bool FP8 = false>
__device__ __forceinline__ void gemm_phase(PG8_LAS unsigned char* lds, const Gemm g, const Sched& S, const Epi& E, const int tid) {
    const int wid = __builtin_amdgcn_readfirstlane(tid >> 6), lane = tid & 63, wr = wid >> 2, wc = wid & 3, fr = lane & 15, fq = lane >> 4;
    constexpr int ESZ = FP8 ? 1 : 2;
    const int K = g.K, nt = K * ESZ / (BK * 2);
    unsigned voffA[2], voffB[2];
#pragma unroll
    for (int i = 0; i < 2; ++i) { int R, C; stage_rc(tid * 16 + i * 8192, R, C); const int Rb = Epi::PERM ? ((R & ~31) + perm32(R & 31)) : R;
        voffA[i] = (unsigned)(R * g.lda * ESZ + C * 2); voffB[i] = (unsigned)(Rb * g.ldb * ESZ + C * 2); }
    const size_t kstep = (size_t)(BK * 2);
    const size_t hstepA = (size_t)HALF * g.lda * ESZ, hstepB = (size_t)HALF * g.ldb * ESZ;
    const size_t tstepB = 2 * hstepB;
    const unsigned ldsw = (unsigned)wid * 1024u;
    const int aoff = lds_byte(wr * 64 + fr, FP8 ? fq * 16 : fq * 8), boff = lds_byte(wc * 32 + fr, FP8 ? fq * 16 : fq * 8);
    const int aoff1 = FP8 ? lds_byte(wr * 64 + fr, fq * 16 + 8) - aoff : 1024, boff1 = FP8 ? lds_byte(wc * 32 + fr, fq * 16 + 8) - boff : 1024;
#define PG8_SA(b, h) (((b) * 2 + (h)) * HTB)
#define PG8_SB(b, h) ((4 + (b) * 2 + (h)) * HTB)
#define PG8_STAGE(bufoff, gbase, voff) do { _Pragma("unroll") for (int _i = 0; _i < 2; ++_i) \
        __builtin_amdgcn_global_load_lds((const unsigned*)((const char*)(gbase) + (voff)[_i]), (PG8_LAS unsigned*)(lds + (bufoff) + ldsw + _i * 8192), 16, 0, 0); } while (0)
#define PG8_LDA(dst, b, h) do { _Pragma("unroll") for (int m = 0; m < 4; ++m) { \
        if constexpr (FP8) { const u32x4 lo_ = *(const PG8_LAS u32x4*)(lds + PG8_SA(b, h) + aoff + m * 2048), hi_ = *(const PG8_LAS u32x4*)(lds + PG8_SA(b, h) + aoff + m * 2048 + aoff1); \
            dst##8[m] = __builtin_bit_cast(v8i_t, __builtin_shufflevector(lo_, hi_, 0, 1, 2, 3, 4, 5, 6, 7)); } \
        else { _Pragma("unroll") for (int k = 0; k < 2; ++k) dst[m][k] = *(const PG8_LAS bf16x8*)(lds + PG8_SA(b, h) + aoff + m * 2048 + k * 1024); } } } while (0)
#define PG8_LDB(dst, b, h) do { _Pragma("unroll") for (int n = 0; n < 2; ++n) { \
        if constexpr (FP8) { const u32x4 lo_ = *(const PG8_LAS u32x4*)(lds + PG8_SB(b, h) + boff + n * 2048), hi_ = *(const PG8_LAS u32x4*)(lds + PG8_SB(b, h) + boff + n * 2048 + boff1); \
            dst##8[n] = __builtin_bit_cast(v8i_t, __builtin_shufflevector(lo_, hi_, 0, 1, 2, 3, 4, 5, 6, 7)); } \
        else { _Pragma("unroll") for (int k = 0; k < 2; ++k) dst[n][k] = *(const PG8_LAS bf16x8*)(lds + PG8_SB(b, h) + boff + n * 2048 + k * 1024); } } } while (0)
#define PG8_MMA(ai, bj, At, Bt) do { __builtin_amdgcn_s_setprio(1); \
        if constexpr (FP8) { _Pragma("unroll") for (int m = 0; m < 4; ++m) _Pragma("unroll") for (int n = 0; n < 2; ++n) \
            asm volatile("v_mfma_scale_f32_16x16x128_f8f6f4 %0, %1, %2, %0, %3, %3 op_sel_hi:[0,0,0]" : "+v"(acc[ai][bj][m][n]) : "v"(Bt##8[n]), "v"(At##8[m]), "v"(one8)); } \
        else { _Pragma("unroll") for (int m = 0; m < 4; ++m) _Pragma("unroll") for (int n = 0; n < 2; ++n) _Pragma("unroll") for (int k = 0; k < 2; ++k) \
            acc[ai][bj][m][n] = __builtin_amdgcn_mfma_f32_16x16x32_bf16(Bt[n][k], At[m][k], acc[ai][bj][m][n], 0, 0, 0); } \
        __builtin_amdgcn_s_setprio(0); } while (0)
#define PG8_WAIT_V(n) asm volatile("s_waitcnt vmcnt(" #n ")" ::: "memory")
#define PG8_WAIT_L(n) asm volatile("s_waitcnt lgkmcnt(" #n ")" ::: "memory")
#define PG8_BAR __builtin_amdgcn_s_barrier()
#define PG8_SCHED __builtin_amdgcn_sched_barrier(0)
    Unit cur, nxt; int ui = 0;
    if (!S.next(0, cur)) return;
    f32x4 acc[2][2][4][2];
#pragma unroll
    for (int a = 0; a < 2; ++a)
#pragma unroll
        for (int b = 0; b < 2; ++b)
#pragma unroll
            for (int m = 0; m < 4; ++m)
#pragma unroll
                for (int n = 0; n < 2; ++n) acc[a][b][m][n] = (f32x4){0.f, 0.f, 0.f, 0.f};
    bf16x8 At[4][2], B0[2][2], B1[2][2]; v8i_t At8[4], B08[2], B18[2];
    int one8 = 0x7F7F7F7F; asm volatile("" : "+v"(one8));
    const char* cA = (const char*)g.A + (size_t)cur.pm * hstepA + cur.ao; const char* cB = (const char*)g.Bt + (size_t)cur.pb * tstepB;
    S.a_ready(cur);
    PG8_STAGE(PG8_SB(0, 0), cB, voffB); PG8_STAGE(PG8_SB(0, 1), cB + hstepB, voffB); PG8_STAGE(PG8_SA(0, 0), cA, voffA); PG8_STAGE(PG8_SA(0, 1), cA + hstepA, voffA);
    if (wr == 1) PG8_BAR;
    PG8_WAIT_V(2); PG8_BAR;
    PG8_STAGE(PG8_SB(1, 0), cB + kstep, voffB); PG8_STAGE(PG8_SA(1, 0), cA + kstep, voffA); PG8_STAGE(PG8_SB(1, 1), cB + hstepB + kstep, voffB);
    PG8_WAIT_V(6); PG8_BAR;
    for (;;) {
        const bool has_next = S.next(ui + 1, nxt);
        const char* nA = has_next ? (const char*)g.A + (size_t)nxt.pm * hstepA + nxt.ao : cA; const char* nB = has_next ? (const char*)g.Bt + (size_t)nxt.pb * tstepB : cB;
        for (int t = 0; t < nt; t += 2) {
            const bool last = (t == nt - 2);
            const char* a1 = cA + (size_t)(t + 1) * kstep;
            const char* a2 = last ? nA : cA + (size_t)(t + 2) * kstep; const char* b2 = last ? nB : cB + (size_t)(t + 2) * kstep;
            const char* a3 = a2 + kstep; const char* b3 = b2 + kstep;
            if (last && has_next) S.a_ready(nxt);
            PG8_LDB(B0, 0, 0); PG8_LDB(B1, 0, 1); PG8_SCHED; PG8_LDA(At, 0, 0); PG8_STAGE(PG8_SA(1, 1), a1 + hstepA, voffA);
            PG8_WAIT_V(8); PG8_WAIT_L(0); PG8_BAR; PG8_MMA(0, 0, At, B0); PG8_MMA(0, 1, At, B1); PG8_BAR; PG8_SCHED;
            PG8_LDA(At, 0, 1); PG8_STAGE(PG8_SB(0, 0), b2, voffB); PG8_STAGE(PG8_SB(0, 1), b2 + hstepB, voffB); PG8_STAGE(PG8_SA(0, 0), a2, voffA);
            PG8_WAIT_V(8); PG8_WAIT_L(0); PG8_BAR; PG8_MMA(1, 0, At, B0); PG8_MMA(1, 1, At, B1); PG8_BAR; PG8_SCHED;
            PG8_LDB(B0, 1, 0); PG8_LDB(B1, 1, 1); PG8_SCHED; PG8_LDA(At, 1, 0); PG8_STAGE(PG8_SA(0, 1), a2 + hstepA, voffA);
            PG8_WAIT_V(8); PG8_WAIT_L(0); PG8_BAR; PG8_MMA(0, 0, At, B0); PG8_MMA(0, 1, At, B1); PG8_BAR; PG8_SCHED;
            PG8_LDA(At, 1, 1); PG8_STAGE(PG8_SB(1, 0), b3, voffB); PG8_STAGE(PG8_SB(1, 1), b3 + hstepB, voffB); PG8_STAGE(PG8_SA(1, 0), a3, voffA);
            PG8_WAIT_V(8); PG8_WAIT_L(0); PG8_BAR; PG8_MMA(1, 0, At, B0); PG8_MMA(1, 1, At, B1); PG8_BAR; PG8_SCHED;
        }
        if constexpr (ALIGN_EPI) { if (wr == 0) PG8_BAR; }
        if constexpr (FP8) asm volatile("s_nop 15\n\ts_nop 15" ::: "memory");
        E(acc, cur, wr, wc, fr, fq); S.done(cur);
        if (!has_next) break;
#pragma unroll
        for (int a = 0; a < 2; ++a)
#pragma unroll
            for (int b = 0; b < 2; ++b)
#pragma unroll
                for (int m = 0; m < 4; ++m)
#pragma unroll
                    for (int n = 0; n < 2; ++n) acc[a][b][m][n] = (f32x4){0.f, 0.f, 0.f, 0.f};
        cur = nxt; cA = nA; cB = nB; ++ui;
        if constexpr (ALIGN_EPI) { if (wr == 1) PG8_BAR; }
    }
    PG8_WAIT_V(0);
    if constexpr (!ALIGN_EPI) { if (wr == 0) PG8_BAR; }
    PG8_BAR;
#undef PG8_SA
#undef PG8_SB
#undef PG8_STAGE
#undef PG8_LDA
#undef PG8_LDB
#undef PG8_MMA
#undef PG8_WAIT_V
#undef PG8_WAIT_L
#undef PG8_BAR
#undef PG8_SCHED
}

__device__ __forceinline__ unsigned cvt_pk_bf16(float lo, float hi) { unsigned r; asm volatile("v_cvt_pk_bf16_f32 %0, %1, %2" : "=v"(r) : "v"(lo), "v"(hi)); return r; }
__device__ __forceinline__ u32x4 pack8(const f32x4 v0, const f32x4 v1) { u32x4 w; w.x = cvt_pk_bf16(v0[0], v0[1]); w.y = cvt_pk_bf16(v0[2], v0[3]); w.z = cvt_pk_bf16(v1[0], v1[1]); w.w = cvt_pk_bf16(v1[2], v1[3]); return w; }
__device__ __forceinline__ float clamp448(float x) { return __builtin_amdgcn_fmed3f(x, -448.f, 448.f); }
__device__ __forceinline__ unsigned fp8x4(const f32x4 v) { int w = 0; w = __builtin_amdgcn_cvt_pk_fp8_f32(clamp448(v[0]), clamp448(v[1]), w, false);
    w = __builtin_amdgcn_cvt_pk_fp8_f32(clamp448(v[2]), clamp448(v[3]), w, true); return (unsigned)w; }
__device__ __forceinline__ unsigned q8(float x) { const float s = frcp(1.f + __expf(-x)); return (unsigned)(s * 255.f + 0.5f); }

#define EPI_FENCE() asm volatile("" ::: "memory")
enum { EK_INPROJ = 0, EK_MIX0, EK_MIX1, EK_MIX2, EK_RESID, EK_SWIGLU, EK_MOEDOWN, EK_MLA };
struct Epi {
    static constexpr bool PERM = true;
    int kind;
    void* o0;
    void* o1;
    const void* i0;
    const void* i1;
    int ldo, fin, dry;
    float isc;
    float osc;
    __device__ __forceinline__ void operator()(const f32x4 (&acc)[2][2][4][2], const Unit& u, int wr, int wc, int fr, int fq) const {
        const int row0 = u.pm * HALF + wr * 64 + fr;
        if (dry) { float sink = 0.f;
#pragma unroll
            for (int ai = 0; ai < 2; ++ai)
#pragma unroll
                for (int bj = 0; bj < 2; ++bj)
#pragma unroll
                    for (int m = 0; m < 4; ++m) sink += acc[ai][bj][m][0][0] + acc[ai][bj][m][1][3];
            asm volatile("" :: "v"(sink)); return; }
        if (kind == EK_INPROJ) {
            if (u.pn < 16) { bf16_t* Ym = (bf16_t*)o0; const int col0 = u.pn * BM + wc * 32 + 8 * fq;
#pragma unroll
                for (int ai = 0; ai < 2; ++ai)
#pragma unroll
                    for (int m = 0; m < 4; ++m) { bf16_t* rowp = Ym + (size_t)(row0 + ai * HALF + m * 16) * YW + col0;
#pragma unroll
                        for (int bj = 0; bj < 2; ++bj) gst<u32x4>(rowp + bj * HALF, pack8(acc[ai][bj][m][0], acc[ai][bj][m][1])); }
            } else { unsigned char* Yg = (unsigned char*)o1; const int col0 = (u.pn - 16) * BM + wc * 32 + 8 * fq;
#pragma unroll
                for (int ai = 0; ai < 2; ++ai)
#pragma unroll
                    for (int m = 0; m < 4; ++m) { unsigned char* rowp = Yg + (size_t)(row0 + ai * HALF + m * 16) * NGATE + col0;
#pragma unroll
                        for (int bj = 0; bj < 2; ++bj) { const f32x4 a = acc[ai][bj][m][0], b = acc[ai][bj][m][1]; u32x2 w;
                            w.x = q8(a[0]) | (q8(a[1]) << 8) | (q8(a[2]) << 16) | (q8(a[3]) << 24); w.y = q8(b[0]) | (q8(b[1]) << 8) | (q8(b[2]) << 16) | (q8(b[3]) << 24);
                            gst<u32x2>(rowp + bj * HALF, w); } }
            }
        } else if (kind <= EK_MIX2) {
            bf16_t* Mx = (bf16_t*)o0; const unsigned char* Yg = (const unsigned char*)i0 + (kind - EK_MIX0) * 1024; const bool addp = kind != EK_MIX0;
            const int col0 = u.pn * BM + wc * 32 + 8 * fq; const float s = 1.f / 255.f;
#pragma unroll
            for (int ai = 0; ai < 2; ++ai)
#pragma unroll
                for (int bj = 0; bj < 2; ++bj) { const int col = col0 + bj * HALF; u32x2 gw[4]; u32x4 pv[4];
#pragma unroll
                    for (int m = 0; m < 4; ++m) { const int row = row0 + ai * HALF + m * 16; gw[m] = gld<u32x2>(Yg + (size_t)row * NGATE + col);
                        pv[m] = (u32x4){0u, 0u, 0u, 0u}; if (addp) pv[m] = gld<u32x4>(Mx + (size_t)row * D + col); }
#pragma unroll
                    for (int m = 0; m < 4; ++m) { const int row = row0 + ai * HALF + m * 16; f32x4 a = acc[ai][bj][m][0], b = acc[ai][bj][m][1]; const u32x2 g = gw[m]; const u32x4 p = pv[m];
                        a[0] = a[0] * ((float)(g.x & 255u) * s) + bflo(p.x); a[1] = a[1] * ((float)((g.x >> 8) & 255u) * s) + bfhi(p.x); a[2] = a[2] * ((float)((g.x >> 16) & 255u) * s) + bflo(p.y); a[3] = a[3] * ((float)(g.x >> 24) * s) + bfhi(p.y);
                        b[0] = b[0] * ((float)(g.y & 255u) * s) + bflo(p.z); b[1] = b[1] * ((float)((g.y >> 8) & 255u) * s) + bfhi(p.z); b[2] = b[2] * ((float)((g.y >> 16) & 255u) * s) + bflo(p.w); b[3] = b[3] * ((float)(g.y >> 24) * s) + bfhi(p.w);
                        gst<u32x4>(Mx + (size_t)row * D + col, pack8(a, b)); }
                    EPI_FENCE(); }
        } else if (kind == EK_RESID) {
            bf16_t* H = (bf16_t*)o0; const int col0 = u.pn * BM + wc * 32 + 8 * fq;
#pragma unroll
            for (int ai = 0; ai < 2; ++ai)
#pragma unroll
                for (int bj = 0; bj < 2; ++bj) { u32x4 x[4];
#pragma unroll
                    for (int m = 0; m < 4; ++m) x[m] = gld<u32x4>(H + (size_t)(row0 + ai * HALF + m * 16) * D + col0 + bj * HALF);
#pragma unroll
                    for (int m = 0; m < 4; ++m) { const f32x4 a = acc[ai][bj][m][0] * isc + (f32x4){bflo(x[m].x), bfhi(x[m].x), bflo(x[m].y), bfhi(x[m].y)}, b = acc[ai][bj][m][1] * isc + (f32x4){bflo(x[m].z), bfhi(x[m].z), bflo(x[m].w), bfhi(x[m].w)};
                        gst<u32x4>(H + (size_t)(row0 + ai * HALF + m * 16) * D + col0 + bj * HALF, pack8(a, b)); }
                    EPI_FENCE(); }
        } else if (kind == EK_SWIGLU) {
            bf16_t* O = (bf16_t*)o0; const int col0 = u.pn * HALF + wc * 32 + 8 * fq; const float c1 = -1.4426950408889634f * isc, c2 = isc * isc * (osc > 0.f ? osc : 1.f);
#pragma unroll
            for (int ai = 0; ai < 2; ++ai)
#pragma unroll
                for (int m = 0; m < 4; ++m) { f32x4 h[2];
#pragma unroll
                    for (int n = 0; n < 2; ++n)
#pragma unroll
                        for (int e = 0; e < 4; ++e) { const float ga = acc[ai][0][m][n][e], ua = acc[ai][1][m][n][e];
                            h[n][e] = ga * ua * c2 * frcp(1.f + __builtin_amdgcn_exp2f(ga * c1)); }
                    if (osc > 0.f) { u32x2 w8; w8.x = fp8x4(h[0]); w8.y = fp8x4(h[1]); gst<u32x2>((unsigned char*)o0 + (size_t)(row0 + ai * HALF + m * 16) * ldo + col0, w8); }
                    else gst<u32x4>(O + (size_t)(row0 + ai * HALF + m * 16) * ldo + col0, pack8(h[0], h[1])); }
        } else if (kind == EK_MLA) {
            bf16_t* Qb = (bf16_t*)o0; bf16_t* Kb = (bf16_t*)o1; bf16_t* Vb = (bf16_t*)i0;
#pragma unroll
            for (int ai = 0; ai < 2; ++ai)
#pragma unroll
                for (int m = 0; m < 4; ++m) { const size_t row = (size_t)(row0 + ai * HALF + m * 16);
#pragma unroll
                    for (int bj = 0; bj < 2; ++bj) { const u32x4 w = pack8(acc[ai][bj][m][0], acc[ai][bj][m][1]);
                        const int pn_ = u.pn + fin;
                        if (pn_ < 3) gst<u32x4>(Qb + row * QKW + pn_ * BM + bj * HALF + wc * 32 + 8 * fq, w);
                        else { const int c = (pn_ - 3) * BM + bj * HALF + wc * 32 + 8 * fq, hh = c >> 7, d = c & 127;
                            if (d < 64) gst<u32x4>(Kb + row * QKW + hh * 96 + d, w); else gst<u32x4>(Vb + row * VW + hh * 64 + d - 64, w); } } }
        } else {
            bf16_t* H = (bf16_t*)o0; float* out = (float*)o1; const int* slot_tok = (const int*)i0; const float* slot_w = (const float*)i1;
            const int col0 = u.pn * BM + wc * 32 + 8 * fq;
#pragma unroll
            for (int ai = 0; ai < 2; ++ai) { int tk[4]; float wv[4];
#pragma unroll
                for (int m = 0; m < 4; ++m) { const int slot = row0 + ai * HALF + m * 16; tk[m] = gld<int>(slot_tok + slot); wv[m] = gld<float>(slot_w + slot) * osc; }
#pragma unroll
                for (int bj = 0; bj < 2; ++bj) { u32x4 x[4];
#pragma unroll
                    for (int m = 0; m < 4; ++m) { const int t_ = tk[m] < 0 ? 0 : tk[m]; x[m] = gld<u32x4>(H + (size_t)t_ * D + col0 + bj * HALF); }
#pragma unroll
                    for (int m = 0; m < 4; ++m) if (tk[m] >= 0) {
                        const f32x4 a = acc[ai][bj][m][0] * wv[m] + (f32x4){bflo(x[m].x), bfhi(x[m].x), bflo(x[m].y), bfhi(x[m].y)}, b = acc[ai][bj][m][1] * wv[m] + (f32x4){bflo(x[m].z), bfhi(x[m].z), bflo(x[m].w), bfhi(x[m].w)};
                        if (fin) { const int bb = tk[m] / LP, p = tk[m] - bb * LP; f32x4* q = (f32x4*)(out + ((size_t)bb * SEQ + (p - 128)) * D + col0 + bj * HALF); gst<f32x4>(q, a); gst<f32x4>(q + 1, b); }
                        else gst<u32x4>(H + (size_t)tk[m] * D + col0 + bj * HALF, pack8(a, b)); }
                    EPI_FENCE(); } }
        }
    }
};
}

#define XB_TMO      128
#define XB_XCNT(j)  (256  + 64 * (j))
#define XB_XSUB(j)  (1280 + 64 * (j))
#define XB_XGEN(j)  (2304 + 64 * (j))
#define XB_TOP      3328
#define XB_TOPGEN   3392
#define XCD_BAR_WORDS 3456
#define XB_SPIN_CAP (1u << 25)
__device__ __forceinline__ unsigned xb_ld(unsigned* p)              { return __hip_atomic_load(p, __ATOMIC_RELAXED, __HIP_MEMORY_SCOPE_AGENT); }
__device__ __forceinline__ unsigned xb_add(unsigned* p, unsigned v) { return __hip_atomic_fetch_add(p, v, __ATOMIC_RELAXED, __HIP_MEMORY_SCOPE_AGENT); }
__device__ __forceinline__ unsigned xb_xcc_id() { return (unsigned)__builtin_amdgcn_s_getreg((3 << 11) | 20) & 0xFu; }
#define XB_SPIN(cond, bar) do { unsigned _sp = 0; while (cond) { __builtin_amdgcn_s_sleep(1); \
    if ((++_sp & 255u) == 0u) { if (xb_ld(&(bar)[XB_TMO])) break; if (_sp > XB_SPIN_CAP) { atomicAdd(&(bar)[XB_TMO], 1u); break; } } } } while (0)
struct XcdBarrier { unsigned* bar; unsigned x; volatile LAS unsigned* st; };
__device__ __forceinline__ XcdBarrier xcd_barrier_post(unsigned* bar, volatile LAS unsigned* st) {
    XcdBarrier b; b.bar = bar; b.x = xb_xcc_id(); b.st = st;
    if (threadIdx.x == 0) (void)xb_add(&bar[XB_XCNT(b.x)], 1u);
    return b;
}
__device__ __forceinline__ void xcd_barrier_complete(unsigned* bar, unsigned x, unsigned& nloc, unsigned& nx) {
    const unsigned G = gridDim.x * gridDim.y * gridDim.z;
    unsigned sum, cnt, mine, sp = 0u;
    for (;;) {
        sum = 0u; cnt = 0u; mine = 0u;
#pragma unroll
        for (unsigned j = 0; j < 16; ++j) { const unsigned c = xb_ld(&bar[XB_XCNT(j)]); sum += c; cnt += (c > 0u) ? 1u : 0u; mine = (j == x) ? c : mine; }
        if (sum == G) break;
        __builtin_amdgcn_s_sleep(1);
        if ((++sp & 255u) == 0u) { if (xb_ld(&bar[XB_TMO])) break; if (sp > XB_SPIN_CAP) { atomicAdd(&bar[XB_TMO], 1u); break; } }
    }
    nloc = mine > 0u ? mine : 1u; nx = cnt > 0u ? cnt : 1u;
}
__device__ __forceinline__ void xcd_barrier(const XcdBarrier& b) {
    asm volatile("s_waitcnt vmcnt(0)" ::: "memory");
    __syncthreads();
    if (threadIdx.x == 0) {
        unsigned* bar = b.bar;
        __builtin_amdgcn_s_waitcnt(0);
        unsigned nloc = b.st[0], nx = b.st[1];
        if (nloc == 0u) { xcd_barrier_complete(bar, b.x, nloc, nx); b.st[0] = nloc; b.st[1] = nx; }
        const unsigned old = xb_add(&bar[XB_XSUB(b.x)], 1u);
        const unsigned gen = old / nloc;
        if (old + 1u == (gen + 1u) * nloc) {
            __builtin_amdgcn_fence(__ATOMIC_RELEASE, "agent");
            asm volatile("s_waitcnt vmcnt(0)" ::: "memory");
            const unsigned og = xb_add(&bar[XB_TOP], 1u);
            const unsigned tg = og / nx;
            if (og + 1u == (tg + 1u) * nx) xb_add(&bar[XB_TOPGEN], 1u);
            else XB_SPIN(xb_ld(&bar[XB_TOPGEN]) == tg, bar);
            __builtin_amdgcn_fence(__ATOMIC_ACQUIRE, "agent");
            xb_add(&bar[XB_XGEN(b.x)], 1u);
            asm volatile("s_waitcnt vmcnt(0)" ::: "memory");
        } else {
            XB_SPIN(xb_ld(&bar[XB_XGEN(b.x)]) == gen, bar);
            __builtin_amdgcn_fence(__ATOMIC_ACQUIRE, "agent");
            asm volatile("s_waitcnt vmcnt(0)" ::: "memory");
        }
    }
    __syncthreads();
}

struct Args { const float* in[28]; float* out; unsigned char* ws; int ph_lo, ph_hi; };
struct Frame {
    LAS unsigned char* lds; unsigned char* ws; unsigned char* dout;
    int tid, lane, wave, G, bid, gw, NGW, dry;
};

template <bool F8>
__device__ __forceinline__ void transpose_tile(const float* W, size_t ldw, int k0, int ncol0, int nvalid, bf16* WT, size_t ldt, int drow0, int dk0, const float* gain, float scale, LAS float* scr, int lane) {
    const int n_ = lane & 31;
    float tv[32];
#pragma unroll
    for (int i = 0; i < 32; ++i) { const int kk = 2 * i + (lane >> 5); tv[i] = 0.f; if (n_ < nvalid) tv[i] = *(const GAS float*)gp(W + (size_t)(k0 + kk) * ldw + ncol0 + n_); }
    { const float* gsrc = gain ? gain : W;
      const bool hasg = gain != nullptr;
#pragma unroll
      for (int i = 0; i < 32; ++i) { const float gv = *(const GAS float*)gp(gsrc + k0 + 2 * i + (lane >> 5)); tv[i] *= hasg ? gv : 1.f; } }
#pragma unroll
    for (int i = 0; i < 32; ++i) scr[(2 * i + (lane >> 5)) * 33 + n_] = tv[i] * scale;
    WAVE_SYNC();
    const int c = lane & 7;
#pragma unroll
    for (int j = 0; j < 4; ++j) { const LAS float* s = scr + (8 * c) * 33 + (lane >> 3) + 8 * j;
#pragma unroll
        for (int q = 0; q < 8; ++q) tv[8 * j + q] = s[q * 33]; }
#pragma unroll
    for (int j = 0; j < 4; ++j) { const int n = (lane >> 3) + 8 * j; const float* s = tv + 8 * j;
        if (F8) { u32x2 o; o.x = pg8::fp8x4((f32x4){s[0], s[1], s[2], s[3]}); o.y = pg8::fp8x4((f32x4){s[4], s[5], s[6], s[7]});
            if (n < nvalid) *(GAS u32x2*)gpw((u32x2*)((unsigned char*)WT + (size_t)(drow0 + n) * ldt + dk0 + 8 * c)) = o; }
        else { u32x4 o; o.x = pk2(s[0], s[1]); o.y = pk2(s[2], s[3]); o.z = pk2(s[4], s[5]); o.w = pk2(s[6], s[7]);
            if (n < nvalid) *(GAS u32x4*)gpw((u32x4*)(WT + (size_t)(drow0 + n) * ldt + dk0 + 8 * c)) = o; } }
    WAVE_SYNC();
}
template <int MODE, bool F8 = false>
__device__ __forceinline__ void conv_matrix(const Frame& F, const float* W, int K, int Ncols, size_t ldw, int ncol_base, bf16* WT, size_t ldt, int drow_base, const float* gain, int dk_base = 0, float scale = 1.f) {
    LAS float* scr = (LAS float*)(F.lds + F.wave * 16384);
    const int nkb = K / 64, nnb = (Ncols + 31) / 32, ntile = nkb * nnb;
    for (int it = F.gw; it < ntile; it += F.NGW) {
        const int kb = it / nnb, nb = it % nnb, n0 = nb * 32, nvalid = (Ncols - n0) < 32 ? (Ncols - n0) : 32;
        int drow0 = drow_base + n0, dk0 = dk_base + kb * 64;
        if (MODE == 1) drow0 = 256 * (n0 / 128) + (n0 % 128) + drow_base;
        if (MODE == 2) dk0 = kb * 96;
        transpose_tile<F8>(W, ldw, kb * 64, ncol_base + n0, nvalid, WT, ldt, drow0, dk0, gain, scale, scr, F.lane);
    }
}
__device__ __forceinline__ void zero_fill16(const Frame& F, void* p, size_t bytes) {
    u32x4* q = (u32x4*)p; const size_t n = bytes / 16;
    const u32x4 z4 = zero4();
    for (size_t i = (size_t)F.bid * NTHREADS + F.tid; i < n; i += (size_t)F.G * NTHREADS) q[i] = z4;
}
__device__ __forceinline__ void convert_layer_weights(const Frame& F, int layer) {
    unsigned char* wl = F.ws + WS_WL;
    bf16* WinT = (bf16*)(wl + WL_IN); bf16* uq = (bf16*)(wl + WL_UQKV);
    const float* w_in = inptr(3) + (size_t)layer * D * IN_COLS;
    LAS float* scr = (LAS float*)(F.lds + F.wave * 16384);
    constexpr int T0 = 16 * 126, T1 = T0 + 16 * 96, T2 = T1 + 4 * 24, T3 = T2 + 2 * 32, T4 = T3 + 8 * 32, T5 = T4 + 8 * 32, T6 = T5 + 8 * 32, T7 = T6 + 16 * 32;
    for (int it = F.gw; it < T7; it += F.NGW) {
        const float* W; const float* gain = nullptr; bf16* WT; int Ncols, ldw, ncol_base = 0, ldt, drow_base = 0, nnb, t;
        if (it < T0)      { t = it;      W = w_in; Ncols = C_END; ldw = IN_COLS; WT = WinT; ldt = D; nnb = 126; }
        else if (it < T1) { t = it - T0; W = w_in; Ncols = NGATE; ldw = IN_COLS; ncol_base = C_END; WT = WinT; ldt = D; drow_base = YW; nnb = 96; }
        else if (it < T2) { t = it - T1; W = inptr(5) + (size_t)layer * 256 * 768; Ncols = 768; ldw = 768; WT = uq; ldt = 256; gain = inptr(4) + layer * 256; nnb = 24; }
        else if (it < T3) { t = it - T2; W = inptr(7) + (size_t)layer * 128 * 1024; Ncols = 1024; ldw = 1024; WT = uq; ldt = 256; drow_base = 768; gain = inptr(6) + layer * 128; nnb = 32; }
        else if (it < T4) { t = it - T3; W = inptr(15) + (size_t)layer * 512 * 1024; Ncols = 1024; ldw = 1024; WT = (bf16*)(wl + WL_OM); ldt = 512; nnb = 32; }
        else if (it < T5) { t = it - T4; W = inptr(16) + (size_t)layer * 512 * 1024; Ncols = 1024; ldw = 1024; WT = (bf16*)(wl + WL_OG); ldt = 512; nnb = 32; }
        else if (it < T6) { t = it - T5; W = inptr(17) + (size_t)layer * 512 * 1024; Ncols = 1024; ldw = 1024; WT = (bf16*)(wl + WL_OH); ldt = 512; nnb = 32; }
        else              { t = it - T6; W = inptr(18) + (size_t)layer * 1024 * 1024; Ncols = 1024; ldw = 1024; WT = (bf16*)(wl + WL_OUT); ldt = 1024; nnb = 32; }
        const int kb = t / nnb, n0 = (t % nnb) * 32, nvalid = (Ncols - n0) < 32 ? (Ncols - n0) : 32;
        transpose_tile<false>(W, (size_t)ldw, kb * 64, ncol_base + n0, nvalid, WT, (size_t)ldt, drow_base + n0, kb * 64, gain, 1.f, scr, F.lane);
    }
    zero_fill16(F, WinT + (size_t)C_END * D, (size_t)(YW - C_END) * D * 2);
    { const u32x4 z4 = zero4();
      for (int i = F.bid * NTHREADS + F.tid; i < 1024 * 16; i += F.G * NTHREADS) { const int row = 768 + (i >> 4), c = 16 + (i & 15); *(u32x4*)(uq + (size_t)row * 256 + 8 * c) = z4; } }
}

__device__ __forceinline__ float row_rstd(const Frame& F, const f32x4 (&v)[4]) {
    float s = 0.f;
#pragma unroll
    for (int j = 0; j < 4; ++j) s += (v[j].x * v[j].x + v[j].y * v[j].y) + (v[j].z * v[j].z + v[j].w * v[j].w);
    return frsq(wave_sum(F.lane, s) * (1.f / D) + EPS);
}
__device__ __forceinline__ void store_row_bf16(bf16* orow, const f32x4 (&v)[4], float rstd, const float* gain, int lane) {
    unsigned long long* o8 = (unsigned long long*)orow + lane;
#pragma unroll
    for (int j = 0; j < 4; ++j) { const f32x4 g = gld<f32x4>((const f32x4*)gain + lane + 64 * j);
        gst<u32x2>(o8 + 64 * j, (u32x2){pk2(v[j].x * rstd * g.x, v[j].y * rstd * g.y), pk2(v[j].z * rstd * g.z, v[j].w * rstd * g.w)}); }
}
__device__ __forceinline__ void store_row_bf16g(bf16* orow, const f32x4 (&v)[4], float rstd, const f32x4 (&g)[4], int lane) {
    unsigned long long* o8 = (unsigned long long*)orow + lane;
#pragma unroll
    for (int j = 0; j < 4; ++j) gst<u32x2>(o8 + 64 * j, (u32x2){pk2(v[j].x * rstd * g[j].x, v[j].y * rstd * g[j].y), pk2(v[j].z * rstd * g[j].z, v[j].w * rstd * g[j].w)});
}
__device__ __forceinline__ void store_row_fp8(unsigned char* orow, const f32x4 (&v)[4], float rstd, const float* gain, float scale, int lane) {
    unsigned* o4 = (unsigned*)orow + lane;
#pragma unroll
    for (int j = 0; j < 4; ++j) { const f32x4 g = gld<f32x4>((const f32x4*)gain + lane + 64 * j); const float sc = rstd * scale;
        gst<unsigned>(o4 + 64 * j, pg8::fp8x4((f32x4){v[j].x * sc * g.x, v[j].y * sc * g.y, v[j].z * sc * g.z, v[j].w * sc * g.w})); }
}
__device__ __forceinline__ void load_h_row(const bf16* hrow, int lane, f32x4 (&v)[4]) {
#pragma unroll
    for (int j = 0; j < 4; ++j) { const u32x2 w = *(const GAS u32x2*)gp((const u32x2*)hrow + lane + 64 * j); v[j] = (f32x4){bflo(w.x), bfhi(w.x), bflo(w.y), bfhi(w.y)}; }
}
__device__ __forceinline__ void store_h_row(bf16* hrow, int lane, const f32x4 (&v)[4]) {
#pragma unroll
    for (int j = 0; j < 4; ++j) { u32x2 w; w.x = pk2(v[j].x, v[j].y); w.y = pk2(v[j].z, v[j].w); gst<u32x2>((u32x2*)hrow + lane + 64 * j, w); }
}
__device__ __forceinline__ void phase_init_rows(const Frame& F, const float* gain) {
    bf16* H = (bf16*)(F.ws + WS_H); bf16* U = (bf16*)(F.dout + DO_U);
    const float* x = inptr(0); const float* meta = inptr(1);
    f32x4 gn[4];
#pragma unroll
    for (int j = 0; j < 4; ++j) gn[j] = gld<f32x4>((const f32x4*)gain + F.lane + 64 * j);
    f32x4 vr[2][4];
    auto issue = [&](int q, int r_) { const int r = r_ < M ? r_ : F.gw; const int b = r / LP, p = r - b * LP;
        const float* src = (p < 128) ? meta + (size_t)(p < PADL ? 0 : p - PADL) * D : x + ((size_t)b * SEQ + (p - 128)) * D;
#pragma unroll
        for (int j = 0; j < 4; ++j) vr[q][j] = *(const GAS f32x4*)gp((const f32x4*)src + F.lane + 64 * j); };
    issue(0, F.gw); issue(1, F.gw + F.NGW);
    for (int r0 = F.gw; r0 < M; r0 += 2 * F.NGW)
#pragma unroll
        for (int q = 0; q < 2; ++q) { const int r = r0 + q * F.NGW; if (r >= M) break;
            f32x4 v[4]; const int p = r % LP;
#pragma unroll
            for (int j = 0; j < 4; ++j) { v[j] = vr[q][j]; if (p < PADL) v[j] = (f32x4){0.f, 0.f, 0.f, 0.f}; }
            issue(q, r + 2 * F.NGW);
            store_h_row(H + (size_t)r * D, F.lane, v);
            const float rstd = row_rstd(F, v);
            store_row_bf16g(U + (size_t)r * D, v, rstd, gn, F.lane); }
}
__device__ __forceinline__ void phase_norm_rows(const Frame& F, const float* gain, bf16* U) {
    const bf16* H = (const bf16*)(F.ws + WS_H);
    f32x4 gn[4];
#pragma unroll
    for (int j = 0; j < 4; ++j) gn[j] = gld<f32x4>((const f32x4*)gain + F.lane + 64 * j);
    u32x2 rw[4][4];
#pragma unroll
    for (int q = 0; q < 4; ++q) { const int r = F.gw + q * F.NGW < M ? F.gw + q * F.NGW : F.gw;
#pragma unroll
        for (int j = 0; j < 4; ++j) rw[q][j] = *(const GAS u32x2*)gp((const u32x2*)(H + (size_t)r * D) + F.lane + 64 * j); }
    for (int r0 = F.gw; r0 < M; r0 += 4 * F.NGW)
#pragma unroll
        for (int q = 0; q < 4; ++q) { const int r = r0 + q * F.NGW; if (r >= M) break;
            f32x4 v[4];
#pragma unroll
            for (int j = 0; j < 4; ++j) { const u32x2 w = rw[q][j]; v[j] = (f32x4){bflo(w.x), bfhi(w.x), bflo(w.y), bfhi(w.y)}; }
            { const int rn = r + 4 * F.NGW < M ? r + 4 * F.NGW : r;
#pragma unroll
              for (int j = 0; j < 4; ++j) rw[q][j] = *(const GAS u32x2*)gp((const u32x2*)(H + (size_t)rn * D) + F.lane + 64 * j); }
            const float rstd = row_rstd(F, v);
            store_row_bf16g(U + (size_t)r * D, v, rstd, gn, F.lane); }
}
__device__ __forceinline__ void phase_rope_table(const Frame& F) {
    float* ct = (float*)(F.ws + WS_ROPE); float* st = ct + LP * 16;
    for (int i = F.bid * NTHREADS + F.tid; i < LP * 16; i += F.G * NTHREADS) {
        const int p = i >> 4, k = i & 15; const int pos = p - PADL;
        const float inv = exp2f(-(float)k * 0.83048202372184059f);
        const float ang = (float)(pos < 0 ? 0 : pos) * inv;
        const float c_hi = 0.15915494309189535f;
        const float c_lo = 6.420638326565253e-09f;
        const float t_hi = ang * c_hi; const float e = fmaf(ang, c_hi, -t_hi);
        float fr = t_hi - rintf(t_hi); fr += e + ang * c_lo;
        ct[i] = __builtin_amdgcn_cosf(fr); st[i] = __builtin_amdgcn_sinf(fr);
    }
}

namespace att {
typedef float f32x16 __attribute__((ext_vector_type(16)));
typedef short s16x4 __attribute__((ext_vector_type(4)));
typedef short v4i16_t __attribute__((ext_vector_type(4)));
constexpr int KS = 208, VS = 192, KBUF = 64 * KS, VBUF = 64 * VS, BUF = KBUF + VBUF;
constexpr int NUNIT = BATCH * 8 * 33;
__device__ __forceinline__ int crow(int r, int hi) { return (r & 3) + 8 * (r >> 2) + 4 * hi; }
__device__ __forceinline__ unsigned cvtpk(float lo, float hi) { unsigned r; asm volatile("v_cvt_pk_bf16_f32 %0, %1, %2" : "=v"(r) : "v"(lo), "v"(hi)); return r; }
__device__ __forceinline__ s16x4 vtr(const LAS unsigned char* p) { return __builtin_bit_cast(s16x4, __builtin_amdgcn_ds_read_tr16_b64_v4i16((LAS v4i16_t*)p)); }
__device__ __forceinline__ float xhalf_max(float m) { auto rr = __builtin_amdgcn_permlane32_swap(__float_as_uint(m), __float_as_uint(m), false, false); return fmaxf(__uint_as_float(rr[0]), __uint_as_float(rr[1])); }
__device__ __forceinline__ float xhalf_sum(float m) { auto rr = __builtin_amdgcn_permlane32_swap(__float_as_uint(m), __float_as_uint(m), false, false); return __uint_as_float(rr[0]) + __uint_as_float(rr[1]); }

__device__ __forceinline__ void unit(const Frame& F, int b, int h, int qb) {
    const int tid = F.tid, lane = F.lane, wave = F.wave, r32 = lane & 31, hi = lane >> 5;
    bf16* Q = (bf16*)(F.dout + DO_Q); const bf16* Kg = (const bf16*)(F.dout + DO_K) + (size_t)b * LP * QKW + h * 96; const bf16* Vg = (const bf16*)(F.ws + WS_V) + (size_t)b * LP * VW + h * 64;
    const int pw = 256 * qb + 32 * wave;
    const int Tl = (4 * qb + 3) < 129 ? (4 * qb + 3) : 129;
    const int twr = pw >> 6;
    const int tw = (pw >= LP) ? 0 : (twr < 129 ? twr : 129);
    const int qp = pw + r32, qpc = qp < LP ? qp : LP - 1;
    bf16x8 qf[6];
    { const bf16* qrow = Q + ((size_t)b * LP + qpc) * QKW + h * 96 + 8 * hi;
#pragma unroll
      for (int ks = 0; ks < 6; ++ks) qf[ks] = *(const GAS bf16x8*)gp(qrow + 16 * ks); }
    const int kr0 = tid / 12, kc0 = tid % 12, kr1 = (512 + tid) / 12, kc1 = (512 + tid) % 12, vr = tid >> 3, vc = tid & 7;
    const bf16* kg0 = Kg + (size_t)kr0 * QKW + kc0 * 8; const bf16* kg1 = Kg + (size_t)kr1 * QKW + kc1 * 8; const bf16* vg = Vg + (size_t)vr * VW + vc * 8;
    LAS unsigned char* lds = F.lds;
    const int kl0 = kr0 * KS + kc0 * 16, kl1 = kr1 * KS + kc1 * 16, vl = KBUF + vr * VS + vc * 16;
    const int koff = r32 * KS + 16 * hi;
    const int voff = KBUF + (4 * hi + ((lane & 15) >> 2)) * VS + (16 * ((lane >> 4) & 1) + 4 * (lane & 3)) * 2;
    u32x4 kA0, kA1 = zero4(), vA;
#define ATT_LOAD(k0_, k1_, v_, tt) do { const int tc_ = (tt) <= Tl ? (tt) : Tl; const size_t ko_ = (size_t)(64 * tc_) * QKW, vo_ = (size_t)(64 * tc_) * VW; \
        k0_ = *(const GAS u32x4*)gp(kg0 + ko_); if (tid < 256) k1_ = *(const GAS u32x4*)gp(kg1 + ko_); v_ = *(const GAS u32x4*)gp(vg + vo_); } while (0)
#define ATT_WRITE(k0_, k1_, v_, bufi) do { LAS unsigned char* nb_ = lds + (bufi) * BUF; *(LAS u32x4*)(nb_ + kl0) = k0_; if (tid < 256) *(LAS u32x4*)(nb_ + kl1) = k1_; *(LAS u32x4*)(nb_ + vl) = v_; } while (0)
#define ATT_QK(P0, P1, bufi) do { const LAS unsigned char* kq_ = lds + (bufi) * BUF + koff; \
        _Pragma("unroll") for (int ks = 0; ks < 6; ++ks) { const bf16x8 a0 = *(const LAS bf16x8*)(kq_ + 32 * ks), a1 = *(const LAS bf16x8*)(kq_ + 32 * KS + 32 * ks); \
            P0 = __builtin_amdgcn_mfma_f32_32x32x16_bf16(a0, qf[ks], P0, 0, 0, 0); P1 = __builtin_amdgcn_mfma_f32_32x32x16_bf16(a1, qf[ks], P1, 0, 0, 0); } } while (0)
#define ATT_MASK(P0, P1, tt) do { const int kbase = 64 * (tt) + 4 * hi; \
        _Pragma("unroll") for (int r = 0; r < 16; ++r) { const int key = kbase + (r & 3) + 8 * (r >> 2); \
            if (key > qp || key < PADL) P0[r] = -1e30f; if (key + 32 > qp || key + 32 < PADL) P1[r] = -1e30f; } } while (0)
    ATT_LOAD(kA0, kA1, vA, 1); ATT_WRITE(kA0, kA1, vA, 0);
    ATT_LOAD(kA0, kA1, vA, 2); ATT_WRITE(kA0, kA1, vA, 1);
    __syncthreads();
    float m = -1e30f, l = 0.f; f32x16 o0 = {}, o1 = {}, p0 = {}, p1 = {};
    if (tw >= 1) { ATT_QK(p0, p1, 0); ATT_MASK(p0, p1, 1); }
    int cur = 0;
    for (int t = 1; t <= Tl; ++t) {
        ATT_LOAD(kA0, kA1, vA, t + 2);
        const int nx1 = cur == 2 ? 0 : cur + 1, nx2 = nx1 == 2 ? 0 : nx1 + 1;
        if (t <= tw) {
            const LAS unsigned char* kb = lds + cur * BUF; const LAS unsigned char* kq_ = lds + nx1 * BUF + koff;
            bf16x8 kf0[3], kf1[3];
#pragma unroll
            for (int ks = 0; ks < 3; ++ks) { kf0[ks] = *(const LAS bf16x8*)(kq_ + 32 * ks); kf1[ks] = *(const LAS bf16x8*)(kq_ + 32 * KS + 32 * ks); }
            __builtin_amdgcn_sched_barrier(0);
            float rm = fmaxf(p0[0], p1[0]);
#pragma unroll
            for (int r = 1; r < 16; ++r) rm = fmaxf(rm, fmaxf(p0[r], p1[r]));
            rm = xhalf_max(rm);
            const float mn = fmaxf(m, rm), alpha = __builtin_amdgcn_exp2f(m - mn); m = mn;
            __builtin_amdgcn_sched_barrier(0);
            f32x16 n0 = {}, n1 = {};
#pragma unroll
            for (int ks = 0; ks < 3; ++ks) { n0 = __builtin_amdgcn_mfma_f32_32x32x16_bf16(kf0[ks], qf[ks], n0, 0, 0, 0); n1 = __builtin_amdgcn_mfma_f32_32x32x16_bf16(kf1[ks], qf[ks], n1, 0, 0, 0); }
            __builtin_amdgcn_sched_barrier(0);
#pragma unroll
            for (int ks = 0; ks < 3; ++ks) { kf0[ks] = *(const LAS bf16x8*)(kq_ + 32 * (ks + 3)); kf1[ks] = *(const LAS bf16x8*)(kq_ + 32 * KS + 32 * (ks + 3)); }
            __builtin_amdgcn_sched_barrier(0);
            float ls = 0.f;
#pragma unroll
            for (int r = 0; r < 16; ++r) { p0[r] = __builtin_amdgcn_exp2f(p0[r] - mn); ls += p0[r]; }
            __builtin_amdgcn_sched_barrier(0);
#pragma unroll
            for (int ks = 0; ks < 3; ++ks) { n0 = __builtin_amdgcn_mfma_f32_32x32x16_bf16(kf0[ks], qf[ks + 3], n0, 0, 0, 0); n1 = __builtin_amdgcn_mfma_f32_32x32x16_bf16(kf1[ks], qf[ks + 3], n1, 0, 0, 0); }
            __builtin_amdgcn_sched_barrier(0);
            s16x4 vlo[8], vhi[8];
#pragma unroll
            for (int s_ = 0; s_ < 4; ++s_)
#pragma unroll
                for (int d0 = 0; d0 < 2; ++d0) { const LAS unsigned char* vp = kb + voff + (32 * (s_ >> 1) + 16 * (s_ & 1)) * VS + 64 * d0; vlo[2 * s_ + d0] = vtr(vp); vhi[2 * s_ + d0] = vtr(vp + 8 * VS); }
            __builtin_amdgcn_sched_barrier(0);
#pragma unroll
            for (int r = 0; r < 16; ++r) { p1[r] = __builtin_amdgcn_exp2f(p1[r] - mn); ls += p1[r]; }
            l = l * alpha + ls;
            if (!__all(alpha == 1.f)) {
#pragma unroll
                for (int r = 0; r < 16; ++r) { o0[r] *= alpha; o1[r] *= alpha; } }
            bf16x8 pb[4];
#pragma unroll
            for (int s_ = 0; s_ < 4; ++s_) { u32x4 w;
                if (s_ < 2) { w.x = cvtpk(p0[8 * s_], p0[8 * s_ + 1]); w.y = cvtpk(p0[8 * s_ + 2], p0[8 * s_ + 3]); w.z = cvtpk(p0[8 * s_ + 4], p0[8 * s_ + 5]); w.w = cvtpk(p0[8 * s_ + 6], p0[8 * s_ + 7]); }
                else { const int q_ = 8 * (s_ - 2); w.x = cvtpk(p1[q_], p1[q_ + 1]); w.y = cvtpk(p1[q_ + 2], p1[q_ + 3]); w.z = cvtpk(p1[q_ + 4], p1[q_ + 5]); w.w = cvtpk(p1[q_ + 6], p1[q_ + 7]); }
                pb[s_] = __builtin_bit_cast(bf16x8, w); }
#pragma unroll
            for (int s_ = 0; s_ < 4; ++s_) {
                const bf16x8 af0 = (bf16x8){vlo[2 * s_][0], vlo[2 * s_][1], vlo[2 * s_][2], vlo[2 * s_][3], vhi[2 * s_][0], vhi[2 * s_][1], vhi[2 * s_][2], vhi[2 * s_][3]};
                const bf16x8 af1 = (bf16x8){vlo[2 * s_ + 1][0], vlo[2 * s_ + 1][1], vlo[2 * s_ + 1][2], vlo[2 * s_ + 1][3], vhi[2 * s_ + 1][0], vhi[2 * s_ + 1][1], vhi[2 * s_ + 1][2], vhi[2 * s_ + 1][3]};
                o0 = __builtin_amdgcn_mfma_f32_32x32x16_bf16(af0, pb[s_], o0, 0, 0, 0); o1 = __builtin_amdgcn_mfma_f32_32x32x16_bf16(af1, pb[s_], o1, 0, 0, 0); }
            if (t + 1 == twr) ATT_MASK(n0, n1, t + 1);
            p0 = n0; p1 = n1;
        }
        ATT_WRITE(kA0, kA1, vA, nx2); __syncthreads(); cur = nx1;
    }
#undef ATT_LOAD
#undef ATT_WRITE
#undef ATT_QK
#undef ATT_MASK
    const float lt = xhalf_sum(l); const float inv = (qp >= PADL && lt > 0.f) ? 1.f / lt : 0.f;
    if (qp < LP && !F.dry) { bf16* orow = (bf16*)(F.ws + WS_O) + ((size_t)b * LP + qp) * 512 + h * 64 + 4 * hi;
#pragma unroll
        for (int g4 = 0; g4 < 4; ++g4) { u32x2 w0, w1;
            w0.x = cvtpk(o0[4 * g4] * inv, o0[4 * g4 + 1] * inv); w0.y = cvtpk(o0[4 * g4 + 2] * inv, o0[4 * g4 + 3] * inv);
            w1.x = cvtpk(o1[4 * g4] * inv, o1[4 * g4 + 1] * inv); w1.y = cvtpk(o1[4 * g4 + 2] * inv, o1[4 * g4 + 3] * inv);
            gst<u32x2>(orow + 8 * g4, w0); gst<u32x2>(orow + 32 + 8 * g4, w1); } }
}
__device__ __forceinline__ void phase(const Frame& F, int layer) {
    const int xg = F.bid & 7;
    unsigned* ctl = (unsigned*)(F.ws + WS_CTL) + CW_ATTQ + 64 * ((2 * layer + F.dry) * 8 + xg);
    volatile LAS int* slot = (volatile LAS int*)(F.lds + MISC_OFF + 64);
    for (;;) {
        if (F.tid == 0) slot[0] = (int)atomicAdd(ctl, 1u);
        __syncthreads();
        const int i = __builtin_amdgcn_readfirstlane(slot[0]);
        __syncthreads();
        if (i >= NUNIT / 8) break;
        const int qb = 32 - (i >> 2), bh = 4 * xg + (i & 3);
        unit(F, bh >> 3, bh & 7, qb);
    }
}
}

namespace mla {
__device__ __forceinline__ void fix(const Frame& F, int layer) {
    const bf16* Ym = (const bf16*)(F.ws + WS_YM);
    bf16* Q = (bf16*)(F.dout + DO_Q); bf16* Kb = (bf16*)(F.dout + DO_K); bf16* V = (bf16*)(F.ws + WS_V);
    const float* qn = inptr(8) + layer * 96; const float* kn = inptr(9) + layer * 96;
    const float* ct = (const float*)(F.ws + WS_ROPE); const float* st = ct + LP * 16;
    const int lane = F.lane, h = lane >> 3, sub = lane & 7;
    f32x4 qg0 = *(const GAS f32x4*)gp(qn + 8 * sub), qg1 = *(const GAS f32x4*)gp(qn + 8 * sub + 4), kg0 = *(const GAS f32x4*)gp(kn + 8 * sub), kg1 = *(const GAS f32x4*)gp(kn + 8 * sub + 4);
    const f32x2 qr1 = *(const GAS f32x2*)gp(qn + 64 + 2 * sub), qr2 = *(const GAS f32x2*)gp(qn + 80 + 2 * sub), kr1 = *(const GAS f32x2*)gp(kn + 64 + 2 * sub), kr2 = *(const GAS f32x2*)gp(kn + 80 + 2 * sub);
    struct Ld { u32x2 dqw; unsigned dkw, krw, qa, qb, ka, kb_; u32x4 qw, kw, vw; f32x2 c, sn; };
    auto load_row = [&](int r) { Ld d; const int rc = r < M ? r : F.gw; const int p = rc % LP; const bf16* y = Ym + (size_t)rc * YW;
        const bf16* qrow = Q + (size_t)rc * QKW + h * 96; const bf16* krow = Kb + (size_t)rc * QKW + h * 96; const bf16* vrow = V + (size_t)rc * VW + h * 64;
        d.dqw = *(const GAS u32x2*)gp(y + C_DQ + 4 * lane); d.dkw = *(const GAS unsigned*)gp(y + C_DKV + 2 * lane);
        d.krw = *(const GAS unsigned*)gp(y + C_KR + 2 * (lane & 15));
        d.qw = *(const GAS u32x4*)gp(qrow + 8 * sub); d.qa = *(const GAS unsigned*)gp(qrow + 64 + 2 * sub); d.qb = *(const GAS unsigned*)gp(qrow + 80 + 2 * sub);
        d.kw = *(const GAS u32x4*)gp(krow + 8 * sub); d.vw = *(const GAS u32x4*)gp(vrow + 8 * sub);
        d.ka = *(const GAS unsigned*)gp(y + C_KR + 2 * sub); d.kb_ = *(const GAS unsigned*)gp(y + C_KR + 16 + 2 * sub);
        d.c = *(const GAS f32x2*)gp(ct + (size_t)p * 16 + 2 * sub); d.sn = *(const GAS f32x2*)gp(st + (size_t)p * 16 + 2 * sub); return d; };
    Ld nx = load_row(F.gw);
    for (int r = F.gw; r < M; r += F.NGW) {
        const Ld d = nx; nx = load_row(r + F.NGW);
        bf16* qrow = Q + (size_t)r * QKW + h * 96; bf16* krow = Kb + (size_t)r * QKW + h * 96; bf16* vrow = V + (size_t)r * VW + h * 64;
        const u32x2 dqw = d.dqw; const unsigned dkw = d.dkw, krw = d.krw, qa = d.qa, qb = d.qb, ka = d.ka, kb_ = d.kb_; const u32x4 qw = d.qw, kw = d.kw, vw = d.vw; const f32x2 c = d.c, sn = d.sn;
        const float rsq = frsq(wave_sum(F.lane, bflo(dqw.x) * bflo(dqw.x) + bfhi(dqw.x) * bfhi(dqw.x) + bflo(dqw.y) * bflo(dqw.y) + bfhi(dqw.y) * bfhi(dqw.y)) * (1.f / 256.f) + EPS);
        const float rskv = frsq(wave_sum(F.lane, bflo(dkw) * bflo(dkw) + bfhi(dkw) * bfhi(dkw)) * (1.f / 128.f) + EPS);
        float krs = bflo(krw) * bflo(krw) + bfhi(krw) * bfhi(krw);
        krs = sum16(krs);
        { float e[8] = {bflo(qw.x), bfhi(qw.x), bflo(qw.y), bfhi(qw.y), bflo(qw.z), bfhi(qw.z), bflo(qw.w), bfhi(qw.w)}; float x1[2] = {bflo(qa), bfhi(qa)}, x2[2] = {bflo(qb), bfhi(qb)};
          float ss = 0.f;
#pragma unroll
          for (int i = 0; i < 8; ++i) { e[i] *= rsq; ss += e[i] * e[i]; }
#pragma unroll
          for (int i = 0; i < 2; ++i) { x1[i] *= rsq; x2[i] *= rsq; ss += x1[i] * x1[i] + x2[i] * x2[i]; }
          ss = sum8(ss);
          const float sc = QSCALE * frsq(ss * (1.f / 96.f) + EPS);
          u32x4 w; w.x = pk2(e[0] * sc * qg0[0], e[1] * sc * qg0[1]); w.y = pk2(e[2] * sc * qg0[2], e[3] * sc * qg0[3]); w.z = pk2(e[4] * sc * qg1[0], e[5] * sc * qg1[1]); w.w = pk2(e[6] * sc * qg1[2], e[7] * sc * qg1[3]);
          if (!F.dry) *(GAS u32x4*)gpw(qrow + 8 * sub) = w;
          const float a0 = x1[0] * sc * qr1[0], a1 = x1[1] * sc * qr1[1], b0 = x2[0] * sc * qr2[0], b1 = x2[1] * sc * qr2[1];
          if (!F.dry) *(GAS unsigned*)gpw(qrow + 64 + 2 * sub) = pk2(a0 * c[0] - b0 * sn[0], a1 * c[1] - b1 * sn[1]); if (!F.dry) *(GAS unsigned*)gpw(qrow + 80 + 2 * sub) = pk2(a0 * sn[0] + b0 * c[0], a1 * sn[1] + b1 * c[1]); }
        { float e[8] = {bflo(kw.x), bfhi(kw.x), bflo(kw.y), bfhi(kw.y), bflo(kw.z), bfhi(kw.z), bflo(kw.w), bfhi(kw.w)}; float ss = 0.f;
#pragma unroll
          for (int i = 0; i < 8; ++i) { e[i] *= rskv; ss += e[i] * e[i]; }
          ss = sum8(ss);
          const float sc = frsq((ss + krs) * (1.f / 96.f) + EPS);
          u32x4 w; w.x = pk2(e[0] * sc * kg0[0], e[1] * sc * kg0[1]); w.y = pk2(e[2] * sc * kg0[2], e[3] * sc * kg0[3]); w.z = pk2(e[4] * sc * kg1[0], e[5] * sc * kg1[1]); w.w = pk2(e[6] * sc * kg1[2], e[7] * sc * kg1[3]);
          if (!F.dry) *(GAS u32x4*)gpw(krow + 8 * sub) = w;
          const float a0 = bflo(ka) * sc * kr1[0], a1 = bfhi(ka) * sc * kr1[1], b0 = bflo(kb_) * sc * kr2[0], b1 = bfhi(kb_) * sc * kr2[1];
          if (!F.dry) *(GAS unsigned*)gpw(krow + 64 + 2 * sub) = pk2(a0 * c[0] - b0 * sn[0], a1 * c[1] - b1 * sn[1]); if (!F.dry) *(GAS unsigned*)gpw(krow + 80 + 2 * sub) = pk2(a0 * sn[0] + b0 * c[0], a1 * sn[1] + b1 * c[1]);
          u32x4 wv; wv.x = pk2(bflo(vw.x) * rskv, bfhi(vw.x) * rskv); wv.y = pk2(bflo(vw.y) * rskv, bfhi(vw.y) * rskv); wv.z = pk2(bflo(vw.z) * rskv, bfhi(vw.z) * rskv); wv.w = pk2(bflo(vw.w) * rskv, bfhi(vw.w) * rskv);
          if (!F.dry) *(GAS u32x4*)gpw(vrow + 8 * sub) = wv; }
    }
}
}

constexpr size_t WS_C12 = 551 * MiB;
constexpr int NCHUNK = LP / 64;
__device__ __forceinline__ void phase_lin_prep(const Frame& F, int layer) {
    bf16* Ym = (bf16*)(F.ws + WS_YM); float* c1g = (float*)(F.ws + WS_C12);
    const int lane = F.lane;
    LAS float* bbl = (LAS float*)(F.lds + F.wave * 16384) + lane;
    for (int u = F.gw; u < BATCH * NCHUNK * 12; u += F.NGW) {
        const int chunk = u / 12, sub = u % 12, b = chunk / NCHUNK, n = chunk % NCHUNK;
        const bool HG = sub >= 4; const int h = HG ? (sub - 4) >> 1 : sub; const int i = HG ? ((sub - 4) & 1) * 64 + lane : lane; const int DK = HG ? 128 : 64;
        const int ch = h * DK + i; const int cq = (HG ? C_HQ : C_GQ) + ch, ck = (HG ? C_HF : C_GK) + ch;
        bf16* y0 = Ym + ((size_t)b * LP + 64 * n) * YW;
        const int tpad = PADL - 64 * n;
        float run = 0.f, lb = 0.f;
        unsigned kq[128];
#define LP_ISSUE() do { _Pragma("unroll") for (int t = 0; t < 64; ++t) { const bf16* y = y0 + (size_t)t * YW; kq[t] = gld<bf16>(y + ck); kq[64 + t] = gld<bf16>(y + cq); } } while (0)
        if (!HG) { const float* w_g2 = inptr(10) + (size_t)layer * 16 * 256; const float bg = inptr(11)[layer * 256 + ch]; float wg[16];
#pragma unroll
            for (int rr = 0; rr < 16; ++rr) wg[rr] = gld<float>(w_g2 + rr * 256 + ch);
#pragma unroll 16
            for (int t = 0; t < 64; ++t) { const bf16* y = y0 + (size_t)t * YW; const u32x4 g0 = gld<u32x4>(y + C_GGD), g1 = gld<u32x4>(y + C_GGD + 8);
                const float z = bg + bflo(g0.x) * wg[0] + bfhi(g0.x) * wg[1] + bflo(g0.y) * wg[2] + bfhi(g0.y) * wg[3] + bflo(g0.z) * wg[4] + bfhi(g0.z) * wg[5] + bflo(g0.w) * wg[6] + bfhi(g0.w) * wg[7]
                              + bflo(g1.x) * wg[8] + bfhi(g1.x) * wg[9] + bflo(g1.y) * wg[10] + bfhi(g1.y) * wg[11] + bflo(g1.z) * wg[12] + bfhi(g1.z) * wg[13] + bflo(g1.w) * wg[14] + bfhi(g1.w) * wg[15];
                float lg = -(fmaxf(-z, 0.f) + flog(1.f + __expf(-fabsf(z)))) * (1.f / 16.f);
                if (t < tpad) lg = 0.f;
                run += lg; bbl[64 * t] = run; }
            LP_ISSUE();
        } else { if (layer == 1) { const float* lbp = inptr(13); lb = 1.f / (1.f + __expf(lbp[ch] - lbp[512 + ch])); }
            LP_ISSUE();
#pragma unroll
            for (int t = 0; t < 64; ++t) { const float f = lb + (1.f - lb) * sigmoidf_(bf2f((bf16)kq[t])); float lg = flog(fmaxf(f, 1e-30f));
                kq[t] = __builtin_bit_cast(unsigned, f);
                if (t < tpad) lg = 0.f;
                run += lg; bbl[64 * t] = run; } }
#undef LP_ISSUE
        const float bref = run;
#pragma unroll
        for (int t = 0; t < 64; ++t) { bf16* y = y0 + (size_t)t * YW; float q, k;
            if (!HG) { q = bf2f((bf16)kq[64 + t]) * 0.125f; k = bf2f((bf16)kq[t]); }
            else { q = siluf_(bf2f((bf16)kq[64 + t])); k = 1.f - __builtin_bit_cast(float, kq[t]); }
            if (t < tpad) { q = 0.f; k = 0.f; }
            const float d = fminf(bbl[64 * t] - bref, 80.f);
            if (!F.dry) { gst<bf16>(y + cq, (bf16)f2bf(q * __expf(d))); gst<bf16>(y + ck, (bf16)f2bf(k * __expf(-d))); } }
        if (!F.dry) gst<float>(c1g + chunk * 768 + (HG ? 256 + ch : ch), __expf(bref));
    }
}
namespace lin {
typedef float f32x16 __attribute__((ext_vector_type(16)));
using att::vtr; using att::cvtpk; using att::crow; using att::xhalf_sum; typedef att::s16x4 s16x4;
constexpr int NSEG = 4;
constexpr size_t WS_SLOC = 553 * MiB;
constexpr size_t WS_DTOT = 561 * MiB;
template <int DK, bool HG>
__device__ __forceinline__ void pass1(const Frame& F, int b, int h, int n0, int nc, float* sloc, float* dtot) {
    constexpr int QS = DK * 2 + 16, VSt = 320, QB = 64 * QS, VB = 64 * VSt, CB = DK * 4, BUFB = QB + VB + CB, NI = DK / 32, NO = NI / 2, QCH = DK / 8;
    constexpr int NQC = 64 * QCH, NL = (NQC + 1024) / NTHREADS; static_assert(NQC % NTHREADS == 0 && 2 * BUFB <= RING_BYTES, "pass1 staging");
    const bf16* Ym = (const bf16*)(F.ws + WS_YM); const float* c1g = (const float*)(F.ws + WS_C12);
    const int tid = F.tid, lane = F.lane, wave = F.wave, j = wave & 3, th = wave >> 2, hi = lane >> 5;
    const int ck = (HG ? C_HF : C_GK) + h * DK, cv = (HG ? C_HI : C_GV) + h * 128, cc = (HG ? 256 : 0) + h * DK;
    LAS unsigned char* lds = F.lds;
    unsigned gsrc[NL]; int ldst[NL];
#pragma unroll
    for (int k = 0; k < NL; ++k) { const int reg = (NTHREADS * k) / NQC;
        if (reg < 1) { const int e2 = tid + NTHREADS * k, r = e2 / QCH, c = e2 % QCH; gsrc[k] = (unsigned)(r * YW + ck + 8 * c); ldst[k] = r * QS + 16 * c; }
        else { const int e3 = tid + NTHREADS * k - NQC, r = e3 >> 4, c = e3 & 15; gsrc[k] = (unsigned)(r * YW + cv + 8 * c); ldst[k] = QB + r * VSt + 16 * c; } }
    const size_t rowb = (size_t)b * LP;
    float S[NO][16];
#pragma unroll
    for (int i = 0; i < NO; ++i)
#pragma unroll
        for (int r = 0; r < 16; ++r) S[i][r] = 0.f;
    f32x4 prod;
    { const size_t ro = (rowb + 64 * n0) * YW; u32x4 st[NL];
#pragma unroll
      for (int k = 0; k < NL; ++k) st[k] = *(const GAS u32x4*)gp(Ym + ro + gsrc[k]);
      const f32x4 cst = *(const GAS f32x4*)gp(c1g + (size_t)(b * NCHUNK + n0) * 768 + cc + 4 * (tid & (DK / 4 - 1)));
#pragma unroll
      for (int k = 0; k < NL; ++k) *(LAS u32x4*)(lds + ldst[k]) = st[k];
      if (tid < DK / 4) *(LAS f32x4*)(lds + QB + VB + 16 * tid) = cst;
      prod = cst; }
    __syncthreads();
    const int trq = (lane & 15) >> 2, trc = (16 * ((lane >> 4) & 1) + 4 * (lane & 3)) * 2;
    int cur = 0;
    for (int c = 0; c < nc; ++c) {
        const bool more = c + 1 < nc; const int nn = n0 + c + (more ? 1 : 0); const size_t ron = (rowb + 64 * nn) * YW; LAS unsigned char* nb = lds + (cur ^ 1) * BUFB;
        u32x4 st[NL];
#pragma unroll
        for (int k = 0; k < NL; ++k) st[k] = *(const GAS u32x4*)gp(Ym + ron + gsrc[k]);
        const f32x4 cst = *(const GAS f32x4*)gp(c1g + (size_t)(b * NCHUNK + nn) * 768 + cc + 4 * (tid & (DK / 4 - 1)));
        const LAS unsigned char* kt = lds + cur * BUFB; const LAS unsigned char* vt = kt + QB; const LAS float* c1l = (const LAS float*)(vt + VB);
#pragma unroll
        for (int ii = 0; ii < NO; ++ii) { const int i = th + 2 * ii;
#pragma unroll
            for (int g4 = 0; g4 < 4; ++g4) { const f32x4 dc = *(const LAS f32x4*)(c1l + 32 * i + 8 * g4 + 4 * hi);
#pragma unroll
                for (int e = 0; e < 4; ++e) S[ii][4 * g4 + e] *= dc[e]; }
            f32x16 T = {};
#pragma unroll
            for (int s_ = 0; s_ < 4; ++s_) { const LAS unsigned char* kp = kt + (16 * s_ + 8 * hi + trq) * QS + 64 * i + trc; const LAS unsigned char* vp = vt + (16 * s_ + 8 * hi + trq) * VSt + 64 * j + trc;
                const s16x4 ka = vtr(kp), kb2 = vtr(kp + 4 * QS), va = vtr(vp), vb2 = vtr(vp + 4 * VSt);
                T = __builtin_amdgcn_mfma_f32_32x32x16_bf16((bf16x8){ka[0], ka[1], ka[2], ka[3], kb2[0], kb2[1], kb2[2], kb2[3]}, (bf16x8){va[0], va[1], va[2], va[3], vb2[0], vb2[1], vb2[2], vb2[3]}, T, 0, 0, 0); }
#pragma unroll
            for (int r = 0; r < 16; ++r) S[ii][r] += T[r]; }
#pragma unroll
        for (int k = 0; k < NL; ++k) *(LAS u32x4*)(nb + ldst[k]) = st[k];
        if (tid < DK / 4) *(LAS f32x4*)(nb + QB + VB + 16 * tid) = cst;
        if (more) prod = prod * cst;
        __syncthreads();
        cur ^= 1;
    }
#pragma unroll
    for (int ii = 0; ii < NO; ++ii) { const int i = th + 2 * ii;
#pragma unroll
        for (int r = 0; r < 16; ++r) *(GAS float*)gpw(sloc + (size_t)(((i * 4 + j) * 16 + r) * 64 + lane)) = S[ii][r]; }
    if (tid < DK / 4) *(GAS f32x4*)gpw((f32x4*)dtot + tid) = prod;
}
template <int DK, bool HG>
__device__ __forceinline__ void unit(const Frame& F, int layer, int b, int h, int seg, int uidx) {
    const int n0 = seg == 0 ? 1 : 34 + 32 * (seg - 1), nc = seg == 0 ? 33 : 32, nend = n0 + nc;
    float* slocb = (float*)(F.ws + WS_SLOC) + (size_t)uidx * NSEG * 16384; float* dtotb = (float*)(F.ws + WS_DTOT) + (size_t)uidx * NSEG * 128;
    unsigned* cnt = (unsigned*)(F.ws + WS_CTL) + CW_LINC + 64 * ((2 * layer + F.dry) * 32 + uidx);
    pass1<DK, HG>(F, b, h, n0, nc, slocb + (size_t)seg * 16384, dtotb + seg * 128);
    asm volatile("s_waitcnt vmcnt(0)" ::: "memory");
    __syncthreads();
    if (F.tid == 0) { __builtin_amdgcn_fence(__ATOMIC_RELEASE, "agent"); asm volatile("s_waitcnt vmcnt(0)" ::: "memory"); (void)xb_add(cnt, 1u);
        if (seg > 0) { unsigned sp = 0; while (xb_ld(cnt) < (unsigned)NSEG) { __builtin_amdgcn_s_sleep(2); if (++sp > (1u << 22)) break; }
            __builtin_amdgcn_fence(__ATOMIC_ACQUIRE, "agent"); asm volatile("s_waitcnt vmcnt(0)" ::: "memory"); } }
    __syncthreads();
    constexpr int QS = DK * 2 + 16, VSt = 320, QB = 64 * QS, VB = 64 * VSt, CB = DK * 4, BUFB = 2 * QB + VB + CB, XCO = BUFB, SSO = XCO + 32768, ONO = SSO + 1024, NI = DK / 32, NO = NI / 2, QCH = DK / 8;
    static_assert(ONO + 512 <= RING_BYTES, "lin LDS");
    constexpr int NQC = 64 * QCH, NLD = (2 * NQC + 1024) / NTHREADS; static_assert(NQC % NTHREADS == 0, "staging regions");
    bf16* Ym = (bf16*)(F.ws + WS_YM); const float* c1g = (const float*)(F.ws + WS_C12);
    const int tid = F.tid, lane = F.lane, wave = F.wave, j = wave & 3, th = wave >> 2, r32 = lane & 31, hi = lane >> 5;
    const int cq = (HG ? C_HQ : C_GQ) + h * DK, ck = (HG ? C_HF : C_GK) + h * DK, cv = (HG ? C_HI : C_GV) + h * 128, cg = (HG ? C_HG : C_GR) + h * 128, cc = (HG ? 256 : 0) + h * DK;
    LAS unsigned char* lds = F.lds;
    unsigned gsrc[NLD]; int ldst[NLD];
#pragma unroll
    for (int k = 0; k < NLD; ++k) { const int reg = (NTHREADS * k) / NQC;
        if (reg < 2) { const int e2 = tid + NTHREADS * k - reg * NQC, r = e2 / QCH, c = e2 % QCH; gsrc[k] = (unsigned)(r * YW + (reg == 0 ? cq : ck) + 8 * c); ldst[k] = reg * QB + r * QS + 16 * c; }
        else { const int e3 = tid + NTHREADS * k - 2 * NQC, r = e3 >> 4, c = e3 & 15; gsrc[k] = (unsigned)(r * YW + cv + 8 * c); ldst[k] = 2 * QB + r * VSt + 16 * c; } }
    const size_t rowb = (size_t)b * LP;
    if (tid < 128) ((LAS float*)(lds + ONO))[tid] = (inptr(HG ? 14 : 12) + layer * 128)[tid];
    float S[NO][16];
#pragma unroll
    for (int i = 0; i < NO; ++i)
#pragma unroll
        for (int r = 0; r < 16; ++r) S[i][r] = 0.f;
#pragma unroll 1
    for (int g = 0; g < seg; ++g) {
#pragma unroll
        for (int ii = 0; ii < NO; ++ii) { const int i = th + 2 * ii;
#pragma unroll
            for (int g4 = 0; g4 < 4; ++g4) { const f32x4 dd = *(const GAS f32x4*)gp(dtotb + g * 128 + 32 * i + 8 * g4 + 4 * hi);
#pragma unroll
                for (int e = 0; e < 4; ++e) { const int r = 4 * g4 + e; S[ii][r] = dd[e] * S[ii][r] + *(const GAS float*)gp(slocb + (size_t)g * 16384 + ((i * 4 + j) * 16 + r) * 64 + lane); } } } }
    { const size_t ro = (rowb + 64 * n0) * YW;
#pragma unroll
      for (int k = 0; k < NLD; ++k) { const u32x4 v = *(const GAS u32x4*)gp(Ym + ro + gsrc[k]); *(LAS u32x4*)(lds + ldst[k]) = v; }
      if (tid < DK / 4) { const f32x4 cst = *(const GAS f32x4*)gp(c1g + (size_t)(b * NCHUNK + n0) * 768 + cc + 4 * tid); *(LAS f32x4*)(lds + 2 * QB + VB + 16 * tid) = cst; } }
    __syncthreads();
    const LAS unsigned char* qt = lds; const LAS unsigned char* kt = qt + QB; const LAS unsigned char* vt = kt + QB; const LAS float* c1l = (const LAS float*)(vt + VB);
    const int trq = (lane & 15) >> 2, trc = (16 * ((lane >> 4) & 1) + 4 * (lane & 3)) * 2;
    for (int n = n0; n < nend; ++n) {
        const int nn = n + 1 < nend ? n + 1 : n; const size_t ron = (rowb + 64 * nn) * YW;
        u32x4 st[NLD];
#pragma unroll
        for (int k = 0; k < NLD; ++k) st[k] = *(const GAS u32x4*)gp(Ym + ron + gsrc[k]);
        const f32x4 cst = *(const GAS f32x4*)gp(c1g + (size_t)(b * NCHUNK + nn) * 768 + cc + 4 * (tid & (DK / 4 - 1)));
        bf16* yrow = Ym + (rowb + 64 * n + 32 * th + r32) * YW;
        u32x2 gt[4];
#pragma unroll
        for (int g4 = 0; g4 < 4; ++g4) gt[g4] = *(const GAS u32x2*)gp(yrow + cg + 32 * j + 8 * g4 + 4 * hi);
        f32x16 o = {};
#pragma unroll
        for (int jb = 0; jb < 2; ++jb) { f32x16 AT = {};
#pragma unroll
            for (int ks = 0; ks < DK / 16; ++ks) { const bf16x8 bq = *(const LAS bf16x8*)(qt + (32 * th + r32) * QS + 32 * ks + 16 * hi);
                const bf16x8 ak = *(const LAS bf16x8*)(kt + (32 * jb + r32) * QS + 32 * ks + 16 * hi);
                AT = __builtin_amdgcn_mfma_f32_32x32x16_bf16(ak, bq, AT, 0, 0, 0); }
            int tq = 32 * th + r32 - 32 * jb;
            asm volatile("" : "+v"(tq));
#pragma unroll
            for (int r = 0; r < 16; ++r) AT[r] = (crow(r, hi) > tq) ? 0.f : AT[r];
#pragma unroll
            for (int sp = 0; sp < 2; ++sp) { u32x4 w; w.x = cvtpk(AT[8 * sp], AT[8 * sp + 1]); w.y = cvtpk(AT[8 * sp + 2], AT[8 * sp + 3]); w.z = cvtpk(AT[8 * sp + 4], AT[8 * sp + 5]); w.w = cvtpk(AT[8 * sp + 6], AT[8 * sp + 7]);
                const LAS unsigned char* vp = vt + (32 * jb + 16 * sp + 4 * hi + trq) * VSt + 64 * j + trc;
                const s16x4 lo = vtr(vp), h4 = vtr(vp + 8 * VSt);
                o = __builtin_amdgcn_mfma_f32_32x32x16_bf16((bf16x8){lo[0], lo[1], lo[2], lo[3], h4[0], h4[1], h4[2], h4[3]}, __builtin_bit_cast(bf16x8, w), o, 0, 0, 0); }
            __builtin_amdgcn_sched_barrier(0); }
        f32x16 op = {};
#pragma unroll
        for (int ii = 0; ii < NO; ++ii) { const int i = th + 2 * ii;
#pragma unroll
            for (int g4 = 0; g4 < 4; ++g4) { const f32x4 dc = *(const LAS f32x4*)(c1l + 32 * i + 8 * g4 + 4 * hi);
#pragma unroll
                for (int e = 0; e < 4; ++e) S[ii][4 * g4 + e] *= dc[e]; }
#pragma unroll
            for (int sp = 0; sp < 2; ++sp) { u32x4 w; w.x = cvtpk(S[ii][8 * sp], S[ii][8 * sp + 1]); w.y = cvtpk(S[ii][8 * sp + 2], S[ii][8 * sp + 3]); w.z = cvtpk(S[ii][8 * sp + 4], S[ii][8 * sp + 5]); w.w = cvtpk(S[ii][8 * sp + 6], S[ii][8 * sp + 7]);
                const LAS unsigned char* qo_ = qt + (32 * th + r32) * QS + (32 * i + 16 * sp + 4 * hi) * 2; const LAS unsigned char* qp_ = qt + (32 * (th ^ 1) + r32) * QS + (32 * i + 16 * sp + 4 * hi) * 2;
                const u32x2 b0 = *(const LAS u32x2*)qo_, b1 = *(const LAS u32x2*)(qo_ + 16), c0 = *(const LAS u32x2*)qp_, c1 = *(const LAS u32x2*)(qp_ + 16);
                o = __builtin_amdgcn_mfma_f32_32x32x16_bf16(__builtin_bit_cast(bf16x8, w), __builtin_bit_cast(bf16x8, (u32x4){b0.x, b0.y, b1.x, b1.y}), o, 0, 0, 0);
                op = __builtin_amdgcn_mfma_f32_32x32x16_bf16(__builtin_bit_cast(bf16x8, w), __builtin_bit_cast(bf16x8, (u32x4){c0.x, c0.y, c1.x, c1.y}), op, 0, 0, 0); }
            f32x16 T = {};
#pragma unroll
            for (int s_ = 0; s_ < 4; ++s_) { const LAS unsigned char* kp = kt + (16 * s_ + 8 * hi + trq) * QS + 64 * i + trc; const LAS unsigned char* vp = vt + (16 * s_ + 8 * hi + trq) * VSt + 64 * j + trc;
                const s16x4 ka = vtr(kp), kb2 = vtr(kp + 4 * QS), va = vtr(vp), vb2 = vtr(vp + 4 * VSt);
                T = __builtin_amdgcn_mfma_f32_32x32x16_bf16((bf16x8){ka[0], ka[1], ka[2], ka[3], kb2[0], kb2[1], kb2[2], kb2[3]}, (bf16x8){va[0], va[1], va[2], va[3], vb2[0], vb2[1], vb2[2], vb2[3]}, T, 0, 0, 0); }
#pragma unroll
            for (int r = 0; r < 16; ++r) S[ii][r] += T[r];
            __builtin_amdgcn_sched_barrier(0); }
        { LAS float* xo = (LAS float*)(lds + XCO) + wave * 1024 + lane;
#pragma unroll
          for (int r = 0; r < 16; ++r) xo[64 * r] = op[r]; }
        __syncthreads();
        { const LAS float* xi = (const LAS float*)(lds + XCO) + (wave ^ 4) * 1024 + lane;
#pragma unroll
          for (int r = 0; r < 16; ++r) o[r] += xi[64 * r]; }
        float ssq = 0.f;
#pragma unroll
        for (int r = 0; r < 16; ++r) ssq += o[r] * o[r];
        ssq = xhalf_sum(ssq);
        LAS float* ssb = (LAS float*)(lds + SSO);
        if (hi == 0) ssb[(th * 4 + j) * 32 + r32] = ssq;
#pragma unroll
        for (int k = 0; k < NLD; ++k) *(LAS u32x4*)(lds + ldst[k]) = st[k];
        if (tid < DK / 4) *(LAS f32x4*)(lds + 2 * QB + VB + 16 * tid) = cst;
        __syncthreads();
        const float tot = ssb[(th * 4 + 0) * 32 + r32] + ssb[(th * 4 + 1) * 32 + r32] + ssb[(th * 4 + 2) * 32 + r32] + ssb[(th * 4 + 3) * 32 + r32];
        const float rstd = frsq(tot * (1.f / 128.f) + EPS);
#pragma unroll
        for (int g4 = 0; g4 < 4; ++g4) { const f32x4 on = *(const LAS f32x4*)(lds + ONO + (32 * j + 8 * g4 + 4 * hi) * 4);
            const float v0 = o[4 * g4] * rstd * on[0] * siluf_(bflo(gt[g4].x)), v1 = o[4 * g4 + 1] * rstd * on[1] * siluf_(bfhi(gt[g4].x));
            const float v2 = o[4 * g4 + 2] * rstd * on[2] * siluf_(bflo(gt[g4].y)), v3 = o[4 * g4 + 3] * rstd * on[3] * siluf_(bfhi(gt[g4].y));
            u32x2 w; w.x = cvtpk(v0, v1); w.y = cvtpk(v2, v3); if (!F.dry) *(GAS u32x2*)gpw(yrow + cv + 32 * j + 8 * g4 + 4 * hi) = w; }
    }
    __syncthreads();
}
}
__device__ __forceinline__ void phase_linattn(const Frame& F, int layer) {
    if (F.bid < 32 * lin::NSEG) { const int seg = F.bid >> 5, u = F.bid & 31, br = u >> 4, b = (u >> 2) & 3, h = u & 3;
        if (br == 0) lin::unit<64, false>(F, layer, b, h, seg, u); else lin::unit<128, true>(F, layer, b, h, seg, u); }
}

__device__ __forceinline__ void phase_route(const Frame& F, const float* gain) {
    const bf16* H = (const bf16*)(F.ws + WS_H); const float* wr_ = inptr(23); const float* br_ = inptr(24);
    int* asg_e = (int*)(F.ws + WS_SMALL + SM_ASG_E); int* asg_i = (int*)(F.ws + WS_SMALL + SM_ASG_I); float* asg_w = (float*)(F.ws + WS_SMALL + SM_ASG_W);
    unsigned* ctl = (unsigned*)(F.ws + WS_CTL);
    f32x4 wa[4][4], wc[4][4];
#pragma unroll
    for (int j = 0; j < 4; ++j) { const f32x4 g = gld<f32x4>((const f32x4*)gain + F.lane + 64 * j); const f32x4* w0 = (const f32x4*)(wr_ + (size_t)(4 * (F.lane + 64 * j)) * 8);
#pragma unroll
        for (int kk = 0; kk < 4; ++kk) { wa[j][kk] = gld<f32x4>(w0 + 2 * kk) * g[kk]; wc[j][kk] = gld<f32x4>(w0 + 2 * kk + 1) * g[kk]; } }
    float brr[8];
#pragma unroll
    for (int e = 0; e < 8; ++e) brr[e] = gld<float>(br_ + e);
    constexpr int NT = BATCH * SEQ;
    int me1 = 0, me2 = 0, mt = -1, kit = 0; float mw1 = 0.f;
    u32x2 rw[4][4];
    const int npw_ = (NT + F.NGW - 1) / F.NGW, tw0 = F.gw * npw_, tw1 = (tw0 + npw_) < NT ? (tw0 + npw_) : NT;
#pragma unroll
    for (int q = 0; q < 4; ++q) { const int tq = tw0 + q < tw1 ? tw0 + q : tw0, b = tq / SEQ, r = b * LP + 128 + (tq - b * SEQ);
#pragma unroll
        for (int j = 0; j < 4; ++j) rw[q][j] = *(const GAS u32x2*)gp((const u32x2*)(H + (size_t)r * D) + F.lane + 64 * j); }
    for (int t0 = tw0; t0 < tw1; t0 += 4)
#pragma unroll
    for (int q = 0; q < 4; ++q) { const int t = t0 + q; if (t >= tw1) break;
        f32x4 v[4];
#pragma unroll
        for (int j = 0; j < 4; ++j) { const u32x2 w = rw[q][j]; v[j] = (f32x4){bflo(w.x), bfhi(w.x), bflo(w.y), bfhi(w.y)}; }
        { const int tn = t + 4 < tw1 ? t + 4 : t, b = tn / SEQ, r = b * LP + 128 + (tn - b * SEQ);
#pragma unroll
          for (int j = 0; j < 4; ++j) rw[q][j] = *(const GAS u32x2*)gp((const u32x2*)(H + (size_t)r * D) + F.lane + 64 * j); }
        const float rstd = row_rstd(F, v);
        float lg[8];
#pragma unroll
        for (int e = 0; e < 8; ++e) lg[e] = 0.f;
#pragma unroll
        for (int j = 0; j < 4; ++j) {
#pragma unroll
            for (int kk = 0; kk < 4; ++kk) { const float uu = v[j][kk] * rstd; const f32x4 a = wa[j][kk], c = wc[j][kk];
                lg[0] += uu * a.x; lg[1] += uu * a.y; lg[2] += uu * a.z; lg[3] += uu * a.w; lg[4] += uu * c.x; lg[5] += uu * c.y; lg[6] += uu * c.z; lg[7] += uu * c.w; } }
#pragma unroll
        for (int e = 0; e < 8; ++e) lg[e] = wave_sum(F.lane, lg[e]) + brr[e];
        int e1 = 0; float v1 = lg[0];
#pragma unroll
        for (int e = 1; e < 8; ++e) if (lg[e] > v1) { v1 = lg[e]; e1 = e; }
        int e2 = -1; float v2 = -INFINITY;
#pragma unroll
        for (int e = 0; e < 8; ++e) if (e != e1 && lg[e] > v2) { v2 = lg[e]; e2 = e; }
        const float w1 = 1.f / (1.f + __expf(v2 - v1)), w2 = 1.f - w1;
        if (F.lane == kit) { me1 = e1; me2 = e2; mw1 = w1; mt = t; }
        ++kit; (void)w2;
    }
    const int npw = (NT + F.NGW - 1) / F.NGW, K = NWAVES * npw;
    LAS int* le = (LAS int*)F.lds; LAS int* lt = le + 1024; LAS float* lw = (LAS float*)(le + 1536); LAS unsigned* lbase = (LAS unsigned*)(le + 2048);
    __syncthreads();
    if (F.lane < npw) { const int k = F.wave * npw + F.lane; le[k] = mt >= 0 ? me1 : -1; le[512 + k] = mt >= 0 ? me2 : -1; lt[k] = mt; lw[k] = mw1; }
    __syncthreads();
    int my_e[2] = {-1, -1}, my_r[2] = {0, 0}, my_k[2] = {0, 0};
#pragma unroll
    for (int q = 0; q < 2; ++q) { const int x = F.tid + q * NTHREADS; if (x < 2 * K) { const int rk = x / K, k = x - rk * K; const int e = le[rk * 512 + k]; int cnt = 0, rnk = 0;
            for (int k2 = 0; k2 < K; ++k2) { const int ee = le[rk * 512 + k2]; cnt += (ee == e) ? 1 : 0; rnk += (ee == e && k2 < k) ? 1 : 0; }
            my_e[q] = e; my_r[q] = rnk; my_k[q] = x;
            if (e >= 0 && rnk == 0 && !F.dry) lbase[rk * 8 + e] = atomicAdd(ctl + CW_CNT + 64 * (rk * 8 + e), (unsigned)cnt); } }
    __syncthreads();
#pragma unroll
    for (int q = 0; q < 2; ++q) if (my_e[q] >= 0 && !F.dry) { const int x = my_k[q], rk = x / K, k = x - rk * K, t = lt[k]; const float w1 = lw[k];
        asg_e[rk * 32768 + t] = my_e[q]; asg_i[rk * 32768 + t] = (int)(lbase[rk * 8 + my_e[q]] + (unsigned)my_r[q]); asg_w[rk * 32768 + t] = rk ? 1.f - w1 : w1; }
    __syncthreads();
}
__device__ __forceinline__ void phase_scatter(const Frame& F, const float* gain) {
    const bf16* H = (const bf16*)(F.ws + WS_H);
    const int* asg_e = (const int*)(F.ws + WS_SMALL + SM_ASG_E); const int* asg_i = (const int*)(F.ws + WS_SMALL + SM_ASG_I); const float* asg_w = (const float*)(F.ws + WS_SMALL + SM_ASG_W);
    int* slot_tok = (int*)(F.ws + WS_SMALL + SM_SLOT_TOK); float* slot_w = (float*)(F.ws + WS_SMALL + SM_SLOT_W);
    int* tile_e = (int*)(F.ws + WS_SMALL + SM_TILE_E); int* ntl = (int*)(F.ws + WS_SMALL + SM_NT);
    unsigned* ctl = (unsigned*)(F.ws + WS_CTL);
    unsigned char* xb[2] = {F.ws + WS_XB, F.ws + WS_XB + (size_t)MOE_ROWS * D};
    LAS int* tb = (LAS int*)(F.lds + TAB_OFF);
    if (F.tid < 16) tb[16 + F.tid] = (int)xb_ld(ctl + CW_CNT + 64 * F.tid);
    __syncthreads();
    if (F.tid == 0) {
#pragma unroll 1
        for (int rk = 0; rk < 2; ++rk) { int t = 0;
#pragma unroll 1
            for (int e = 0; e < 8; ++e) { tb[rk * 8 + e] = t; const int nt_ = (tb[16 + rk * 8 + e] + 255) >> 8;
                if (F.bid == 0) {
#pragma unroll 1
                    for (int q = 0; q < nt_; ++q) tile_e[rk * 256 + t + q] = e; }
                t += nt_; }
            if (F.bid == 0) ntl[rk] = t; } }
    __syncthreads();
    for (int g = 0; g < 16; ++g) { const int rk = g >> 3, cnt = tb[16 + g], base = tb[g] * 256, end = base + ((cnt + 255) >> 8) * 256;
        for (int s = base + cnt + F.gw; s < end; s += F.NGW) { if (F.lane == 0) { slot_tok[rk * MOE_ROWS + s] = -1; slot_w[rk * MOE_ROWS + s] = 0.f; }
            u32x4* xr = (u32x4*)(xb[rk] + (size_t)s * D); xr[F.lane] = zero4(); } }
    constexpr int NT = BATCH * SEQ;
    const int npw = (NT + F.NGW - 1) / F.NGW, tw0 = F.gw * npw, tw1 = (tw0 + npw) < NT ? (tw0 + npw) : NT;
    int ae[2], ai[2]; float aw[2];
    { const int tl = tw0 + F.lane < tw1 ? tw0 + F.lane : (tw0 < NT ? tw0 : 0);
#pragma unroll
      for (int rk = 0; rk < 2; ++rk) { ae[rk] = gld<int>(asg_e + rk * 32768 + tl); ai[rk] = gld<int>(asg_i + rk * 32768 + tl); aw[rk] = gld<float>(asg_w + rk * 32768 + tl); } }
    f32x4 gn[4];
#pragma unroll
    for (int j = 0; j < 4; ++j) gn[j] = gld<f32x4>((const f32x4*)gain + F.lane + 64 * j);
    u32x2 rw[4][4];
#pragma unroll
    for (int q = 0; q < 4; ++q) { const int tq = tw0 + q < tw1 ? tw0 + q : (tw0 < NT ? tw0 : 0), b = tq / SEQ, r = b * LP + 128 + (tq - b * SEQ);
#pragma unroll
        for (int j = 0; j < 4; ++j) rw[q][j] = *(const GAS u32x2*)gp((const u32x2*)(H + (size_t)r * D) + F.lane + 64 * j); }
    for (int t0 = tw0; t0 < tw1; t0 += 4)
#pragma unroll
    for (int q = 0; q < 4; ++q) { const int t = t0 + q; if (t >= tw1) break;
        const int b = t / SEQ, r = b * LP + 128 + (t - b * SEQ), k = t - tw0;
        f32x4 v[4];
#pragma unroll
        for (int j = 0; j < 4; ++j) { const u32x2 w = rw[q][j]; v[j] = (f32x4){bflo(w.x), bfhi(w.x), bflo(w.y), bfhi(w.y)}; }
        { const int tn = t + 4 < tw1 ? t + 4 : t, bn = tn / SEQ, rn = bn * LP + 128 + (tn - bn * SEQ);
#pragma unroll
          for (int j = 0; j < 4; ++j) rw[q][j] = *(const GAS u32x2*)gp((const u32x2*)(H + (size_t)rn * D) + F.lane + 64 * j); }
        const float rstd = row_rstd(F, v);
#pragma unroll
        for (int rk = 0; rk < 2; ++rk) { const int e = __builtin_amdgcn_readlane(ae[rk], k), s = tb[rk * 8 + e] * 256 + __builtin_amdgcn_readlane(ai[rk], k);
            const float wgt = __builtin_bit_cast(float, __builtin_amdgcn_readlane(__builtin_bit_cast(int, aw[rk]), k)); const float sc = rstd * XB_SCALE;
            unsigned* o4 = (unsigned*)(xb[rk] + (size_t)s * D) + F.lane;
#pragma unroll
            for (int j = 0; j < 4; ++j) gst<unsigned>(o4 + 64 * j, pg8::fp8x4((f32x4){v[j].x * sc * gn[j].x, v[j].y * sc * gn[j].y, v[j].z * sc * gn[j].z, v[j].w * sc * gn[j].w}));
            if (F.lane == 0) { gst<int>(slot_tok + rk * MOE_ROWS + s, r); gst<float>(slot_w + rk * MOE_ROWS + s, wgt); } }
    }
}
__device__ __forceinline__ void convert_expert_weights(const Frame& F) {
    unsigned char* GU = F.ws + WS_WEXP; unsigned char* DT = F.ws + WS_WEXP + (size_t)8 * 7168 * 1024;
    LAS float* scr = (LAS float*)(F.lds + F.wave * 16384);
    for (int it = F.gw; it < NEXP * 3 * 1792; it += F.NGW) {
        const int e = it / 5376, r = it - e * 5376, m = r / 1792, t = r - m * 1792;
        if (m < 2) { const int kb = t / 112, n0 = (t % 112) * 32; const float* W = inptr(m == 0 ? 25 : 26) + (size_t)e * D * DEXP;
            transpose_tile<true>(W, (size_t)DEXP, kb * 64, n0, 32, (bf16*)(GU + (size_t)e * 7168 * 1024), (size_t)D, 256 * (n0 / 128) + (n0 % 128) + 128 * m, kb * 64, nullptr, WU_SCALE, scr, F.lane); }
        else { const int kb = t / 32, n0 = (t % 32) * 32; const float* W = inptr(27) + (size_t)e * DEXP * D;
            transpose_tile<true>(W, (size_t)D, kb * 64, n0, 32, (bf16*)(DT + (size_t)e * 1024 * DEXP), (size_t)DEXP, n0, kb * 64, nullptr, WD_SCALE, scr, F.lane); }
    }
}
__device__ __forceinline__ void convert_ffn_weights(const Frame& F) {
    bf16* GU = (bf16*)(F.ws + WS_WFF); bf16* DT = GU + (size_t)2 * DFF * D;
    conv_matrix<1>(F, inptr(20), D, DFF, DFF, 0, GU, D, 0, nullptr);
    conv_matrix<1>(F, inptr(21), D, DFF, DFF, 0, GU, D, 128, nullptr);
    conv_matrix<0>(F, inptr(22), DFF, D, D, 0, DT, DFF, 0, nullptr);
}

namespace sk {
constexpr int CW_ERR = 32768;
constexpr size_t WS_DBG = 110 * MiB;
template <int NACC>
__device__ __forceinline__ void dot16(const bf16* A, size_t lda, const bf16* W0, const bf16* W1, size_t ldb, int nk, int lane, f32x4 (&acc)[NACC]) {
    const int i = lane & 15, kq = lane >> 4;
    const bf16* ap = A + (size_t)i * lda + 8 * kq; const bf16* w0 = W0 + (size_t)i * ldb + 8 * kq; const bf16* w1 = W1 + (size_t)i * ldb + 8 * kq;
#pragma unroll 1
    for (int s = 0; s < nk; s += 4) {
        bf16x8 a[4], b0[4], b1[4];
#pragma unroll
        for (int q = 0; q < 4; ++q) { const int ss = (s + q < nk) ? s + q : s;
            a[q] = *(const GAS bf16x8*)gp((const bf16x8*)(ap + 32 * ss)); b0[q] = *(const GAS bf16x8*)gp((const bf16x8*)(w0 + 32 * ss));
            if (NACC == 2) b1[q] = *(const GAS bf16x8*)gp((const bf16x8*)(w1 + 32 * ss)); }
#pragma unroll
        for (int q = 0; q < 4; ++q) if (s + q < nk) { acc[0] = __builtin_amdgcn_mfma_f32_16x16x32_bf16(b0[q], a[q], acc[0], 0, 0, 0);
            if (NACC == 2) acc[1] = __builtin_amdgcn_mfma_f32_16x16x32_bf16(b1[q], a[q], acc[1], 0, 0, 0); }
    }
}
template <int NACC>
__device__ __forceinline__ void reduce8(const Frame& F, f32x4 (&acc)[NACC]) {
    LAS f32x4* red = (LAS f32x4*)F.lds;
#pragma unroll
    for (int a = 0; a < NACC; ++a) red[(a * 8 + F.wave) * 64 + F.lane] = acc[a];
    __syncthreads();
    if (F.wave == 0) {
#pragma unroll
        for (int a = 0; a < NACC; ++a) { f32x4 s = red[(a * 8) * 64 + F.lane];
#pragma unroll
            for (int w = 1; w < 8; ++w) s += red[(a * 8 + w) * 64 + F.lane];
            acc[a] = s; } }
}
struct Cnt { unsigned n, e; };
__device__ __forceinline__ void chk(Cnt& C, float mine, float ref, float rel, float ab) {
#ifdef SK_EXACT
    rel = 0.f; ab = 0.f;
#endif
    C.n += 1u; if (!(fabsf(mine - ref) <= rel * fmaxf(fabsf(mine), fabsf(ref)) + ab)) C.e += 1u;
}
__device__ __forceinline__ void flush(const Frame& F, const Cnt& C) {
    unsigned* ctl = (unsigned*)(F.ws + WS_CTL);
    if (C.n) atomicAdd(ctl + CW_ERR + 64, C.n);
    if (C.e) atomicAdd(ctl + CW_ERR, C.e);
}
__device__ __forceinline__ u32x2 pack4(const f32x4 v) { u32x2 w; w.x = pg8::cvt_pk_bf16(v[0], v[1]); w.y = pg8::cvt_pk_bf16(v[2], v[3]); return w; }
template <bool CHECK>
__device__ __forceinline__ void put4(const Frame& F, Cnt& C, bf16* dst, size_t rs, const f32x4 v, int nb, float rel, float ab) {
    const u32x2 w = pack4(v);
#pragma unroll
    for (int b = 0; b < 4; ++b) if (b < nb) { u32x2* p = (u32x2*)(dst + (size_t)b * LP * rs);
        if (CHECK) { const u32x2 m = gld<u32x2>(p); chk(C, bflo(w.x), bflo(m.x), rel, ab); chk(C, bfhi(w.x), bfhi(m.x), rel, ab); chk(C, bflo(w.y), bflo(m.y), rel, ab); chk(C, bfhi(w.y), bfhi(m.y), rel, ab); }
        else if (!F.dry) gst<u32x2>(p, w); }
}
template <bool CHECK>
__device__ __forceinline__ void inproj(const Frame& F) { Cnt C{0u, 0u};
    const bf16* U = (const bf16*)(F.dout + DO_U) + (size_t)PADL * D; const bf16* W = (const bf16*)(F.ws + WS_WL + WL_IN);
    bf16* Ym = (bf16*)(F.ws + WS_YM); unsigned char* Yg = F.ws + WS_YG;
    if (!CHECK && !F.dry) { const u32x4 z4 = zero4();
        for (int idx = F.bid * NTHREADS + F.tid; idx < BATCH * PADL * (YW / 8); idx += F.G * NTHREADS) { const int row = idx / (YW / 8), c8 = idx % (YW / 8), b = row / PADL, p = row % PADL;
            gst<u32x4>(Ym + ((size_t)b * LP + p) * YW + 8 * c8, z4); } }
    for (int g = F.bid; g < 251 + 192; g += F.G) {
        const int wrow = g < 251 ? 16 * g : YW + 16 * (g - 251);
        f32x4 acc[1] = {(f32x4){0.f, 0.f, 0.f, 0.f}};
        dot16<1>(U + 128 * F.wave, D, W + (size_t)wrow * D + 128 * F.wave, W, D, 4, F.lane, acc);
        reduce8<1>(F, acc);
        if (F.wave == 0) { const int i = F.lane & 15, c = 4 * (F.lane >> 4);
            if (g < 251) put4<CHECK>(F, C, Ym + (size_t)(PADL + i) * YW + 16 * g + c, YW, acc[0], 4, 0.01f, 1e-3f);
            else { const unsigned w = pg8::q8(acc[0][0]) | (pg8::q8(acc[0][1]) << 8) | (pg8::q8(acc[0][2]) << 16) | (pg8::q8(acc[0][3]) << 24);
                unsigned* p = (unsigned*)(Yg + (size_t)(PADL + i) * NGATE + 16 * (g - 251) + c);
                if (CHECK) { const unsigned m = *p;
#pragma unroll
                    for (int e = 0; e < 4; ++e) chk(C, (float)((w >> (8 * e)) & 255u), (float)((m >> (8 * e)) & 255u), 0.f, 1.f); }
                else if (!F.dry) *p = w; } }
        __syncthreads();
    }
    if (CHECK) flush(F, C);
}
template <bool CHECK>
__device__ __forceinline__ void mlaprep(const Frame& F) { Cnt C{0u, 0u};
    const bf16* Ym0 = (const bf16*)(F.ws + WS_YM) + (size_t)PADL * YW; const bf16* W = (const bf16*)(F.ws + WS_WL + WL_UQKV);
    bf16* Q = (bf16*)(F.dout + DO_Q); bf16* Kb = (bf16*)(F.dout + DO_K); bf16* V = (bf16*)(F.ws + WS_V);
    if (!CHECK && !F.dry) { const u32x4 z4 = zero4();
        for (int idx = F.bid * NTHREADS + F.tid; idx < BATCH * PADL * 256; idx += F.G * NTHREADS) { const int row = idx >> 8, c = idx & 255, b = row / PADL, p = row % PADL; const size_t r = (size_t)b * LP + p;
            if (c < 96) gst<u32x4>(Q + r * QKW + 8 * c, z4); else if (c < 192) gst<u32x4>(Kb + r * QKW + 8 * (c - 96), z4); else gst<u32x4>(V + r * VW + 8 * (c - 192), z4); } }
    for (int g = F.bid; g < 48 + 64; g += F.G) {
        const bool kv = g >= 48; const int n0 = kv ? 16 * (g - 48) : 16 * g;
        f32x4 acc[1] = {(f32x4){0.f, 0.f, 0.f, 0.f}};
        dot16<1>(Ym0 + (kv ? C_DKV : C_DQ) + 32 * F.wave, YW, W + (size_t)((kv ? 768 : 0) + n0) * 256 + 32 * F.wave, W, 256, 1, F.lane, acc);
        reduce8<1>(F, acc);
        if (F.wave == 0) { const int i = F.lane & 15, c = n0 + 4 * (F.lane >> 4); const size_t r = (size_t)(PADL + i);
            if (!kv) put4<CHECK>(F, C, Q + r * QKW + c, QKW, acc[0], 4, 0.01f, 1e-3f);
            else { const int hh = c >> 7, d = c & 127;
                if (d < 64) put4<CHECK>(F, C, Kb + r * QKW + hh * 96 + d, QKW, acc[0], 4, 0.01f, 1e-3f); else put4<CHECK>(F, C, V + r * VW + hh * 64 + d - 64, VW, acc[0], 4, 0.01f, 1e-3f); } }
        __syncthreads();
    }
    if (CHECK) flush(F, C);
}
template <bool CHECK>
__device__ __forceinline__ void mix(const Frame& F) { Cnt C{0u, 0u};
    const bf16* Ym0 = (const bf16*)(F.ws + WS_YM) + (size_t)PADL * YW; const bf16* O0 = (const bf16*)(F.ws + WS_O) + (size_t)PADL * 512; const unsigned char* Yg0 = F.ws + WS_YG + (size_t)PADL * NGATE;
    bf16* Mx = (bf16*)(F.dout + DO_MIX); unsigned char* wl = F.ws + WS_WL;
    const int w = F.wave, I = w < 4 ? 0 : (w < 6 ? 1 : 2);
    const bf16* A = I == 0 ? O0 + 128 * w : (I == 1 ? Ym0 + C_GV + 256 * (w - 4) : Ym0 + C_HI + 256 * (w - 6));
    const size_t lda = I == 0 ? 512 : YW, ldb = 512; const int nk = I == 0 ? 4 : 8;
    const bf16* Wb = I == 0 ? (const bf16*)(wl + WL_OM) + 128 * w : (I == 1 ? (const bf16*)(wl + WL_OG) + 256 * (w - 4) : (const bf16*)(wl + WL_OH) + 256 * (w - 6));
    for (int g = F.bid; g < 64; g += F.G) {
        f32x4 acc[1] = {(f32x4){0.f, 0.f, 0.f, 0.f}};
        dot16<1>(A, lda, Wb + (size_t)(16 * g) * ldb, Wb, ldb, nk, F.lane, acc);
        const int i = F.lane & 15, c = 16 * g + 4 * (F.lane >> 4);
        const unsigned gw = gld<unsigned>(Yg0 + (size_t)i * NGATE + I * 1024 + c); const float s = 1.f / 255.f;
        acc[0][0] *= (float)(gw & 255u) * s; acc[0][1] *= (float)((gw >> 8) & 255u) * s; acc[0][2] *= (float)((gw >> 16) & 255u) * s; acc[0][3] *= (float)(gw >> 24) * s;
        reduce8<1>(F, acc);
        if (F.wave == 0) put4<CHECK>(F, C, Mx + (size_t)(PADL + i) * D + c, D, acc[0], 1, 0.03f, 3e-3f);
        __syncthreads();
    }
    if (CHECK) flush(F, C);
}
template <bool CHECK>
__device__ __forceinline__ void resid(const Frame& F, const bf16* A0, size_t lda, const bf16* W, int K, const bf16* hold) { Cnt C{0u, 0u};
    bf16* H = (bf16*)(F.ws + WS_H); const int nk = K / 256, k0 = (K / 8) * F.wave;
    for (int g = F.bid; g < 64; g += F.G) {
        f32x4 acc[1] = {(f32x4){0.f, 0.f, 0.f, 0.f}};
        dot16<1>(A0 + k0, lda, W + (size_t)(16 * g) * K + k0, W, (size_t)K, nk, F.lane, acc);
        reduce8<1>(F, acc);
        if (F.wave == 0) { const int i = F.lane & 15, c = 16 * g + 4 * (F.lane >> 4);
            const u32x2 x = gld<u32x2>(hold + (size_t)i * D + c);
            const f32x4 v = acc[0] + (f32x4){bflo(x.x), bfhi(x.x), bflo(x.y), bfhi(x.y)};
            put4<CHECK>(F, C, H + (size_t)(PADL + i) * D + c, D, v, 4, 0.01f, 1e-3f); }
        __syncthreads();
    }
    if (CHECK) flush(F, C);
}
template <bool CHECK>
__device__ __forceinline__ void ffn_up(const Frame& F) { Cnt C{0u, 0u};
    const bf16* U = (const bf16*)(F.dout + DO_U) + (size_t)PADL * D; const bf16* GU = (const bf16*)(F.ws + WS_WFF); bf16* Hm = (bf16*)(F.ws + WS_HMID);
    for (int g = F.bid; g < DFF / 16; g += F.G) {
        const int hc0 = 16 * g, r0 = 256 * (hc0 >> 7) + (hc0 & 127);
        f32x4 acc[2] = {(f32x4){0.f, 0.f, 0.f, 0.f}, (f32x4){0.f, 0.f, 0.f, 0.f}};
        dot16<2>(U + 128 * F.wave, D, GU + (size_t)r0 * D + 128 * F.wave, GU + (size_t)(r0 + 128) * D + 128 * F.wave, D, 4, F.lane, acc);
        reduce8<2>(F, acc);
        if (F.wave == 0) { const int i = F.lane & 15, c = hc0 + 4 * (F.lane >> 4); f32x4 h;
#pragma unroll
            for (int e = 0; e < 4; ++e) { const float gq = acc[0][e], uq = acc[1][e]; h[e] = gq * frcp(1.f + __expf(-gq)) * uq; }
            put4<CHECK>(F, C, Hm + (size_t)(PADL + i) * DFF + c, DFF, h, 1, 0.02f, 1e-3f); }
        __syncthreads();
    }
    if (CHECK) flush(F, C);
}
}

#ifndef SK_ERR_MAX
#define SK_ERR_MAX 200u
#endif
#ifndef SKMODE
#define SKMODE 1
#endif
enum { OP_INIT = 0, OP_INPROJ, OP_MLAPREP, OP_ATTN, OP_LIN, OP_MIX0, OP_MIX1, OP_MIX2, OP_CONV, OP_WOUT, OP_NORM_FFN, OP_FFN_UP, OP_FFN_DOWN, OP_NEXT, OP_ROUTE, OP_SCATTER, OP_MOE_UP, OP_MOE_DOWN, OP_MLAFIX, OP_NOP, OP_MLAPREP2 };
#define SW(op, layer, rh) ((unsigned)(op) | ((unsigned)(layer) << 5) | ((unsigned)(rh) << 6))
#define SWDRY(op, layer, rh) (SW(op, layer, rh) | 256u)
#ifndef STEP_PROGRAM
#define STEP_PROGRAM \
    SW(OP_INIT, 0, 0), \
    SW(OP_INPROJ, 0, 0), SW(OP_MLAPREP, 0, 0), SW(OP_MLAFIX, 0, 0), SW(OP_ATTN, 0, 0), SW(OP_MIX0, 0, 0), SW(OP_MIX1, 0, 0), SW(OP_MIX2, 0, 0), SW(OP_CONV, 0, 0), SW(OP_WOUT, 0, 0), \
    SW(OP_NORM_FFN, 0, 0), SW(OP_FFN_UP, 0, 0), SW(OP_FFN_DOWN, 0, 0), SW(OP_NEXT, 0, 0), \
    SW(OP_INPROJ, 1, 0), SW(OP_MLAPREP, 1, 0), SW(OP_MLAFIX, 1, 0), SW(OP_ATTN, 1, 0), SW(OP_MIX0, 1, 0), SW(OP_MIX1, 1, 0), SW(OP_MIX2, 1, 0), SW(OP_CONV, 1, 0), SW(OP_WOUT, 1, 0), \
    SW(OP_ROUTE, 1, 0), SW(OP_SCATTER, 1, 0), \
    SW(OP_MOE_UP, 1, 0), SW(OP_MOE_DOWN, 1, 0), SW(OP_MOE_UP, 1, 1), SW(OP_MOE_DOWN, 1, 1)
#endif
__device__ __forceinline__ unsigned step_word(int st) {
    constexpr unsigned prog[] = {STEP_PROGRAM};
    unsigned w = 0;
#pragma unroll
    for (int i = 0; i < (int)(sizeof(prog) / sizeof(prog[0])); ++i) w = (st == i) ? prog[i] : w;
    return w;
}
constexpr unsigned step_prog_host[] = {STEP_PROGRAM};
constexpr int NSTEP = (int)(sizeof(step_prog_host) / sizeof(step_prog_host[0]));
__global__ void __launch_bounds__(NTHREADS, 2) fwd_kernel(Args args) {
    extern __shared__ __attribute__((aligned(16))) unsigned char lds_raw[];
    Frame F;
    F.lds = (LAS unsigned char*)lds_raw; F.ws = args.ws; F.dout = (unsigned char*)args.out;
    F.tid = threadIdx.x; F.lane = F.tid & 63; F.wave = __builtin_amdgcn_readfirstlane(F.tid >> 6);
    F.G = gridDim.x; F.bid = blockIdx.x; F.gw = F.bid * NWAVES + F.wave; F.NGW = F.G * NWAVES;
    volatile LAS unsigned* MISC = (volatile LAS unsigned*)(F.lds + MISC_OFF);
    for (int u = F.tid; u < (LDS_BYTES - LDSCTL_OFF) / 4; u += NTHREADS) ((LAS unsigned*)(F.lds + LDSCTL_OFF))[u] = 0u;
    __syncthreads();
    unsigned* ctl = (unsigned*)(F.ws + WS_CTL);
    XcdBarrier bar = xcd_barrier_post(ctl + CW_BAR, MISC + 8);
    const int wave0 = F.wave;
#pragma unroll 1
    for (int st = args.ph_lo; st < args.ph_hi; ++st) {
        { unsigned char* p_ = args.ws; asm volatile("" : "+s"(p_)); F.ws = p_; p_ = (unsigned char*)args.out; asm volatile("" : "+s"(p_)); F.dout = p_;
          int wv_ = wave0; asm volatile("" : "+s"(wv_)); int ln_; asm volatile("v_mbcnt_lo_u32_b32 %0, -1, 0\n\tv_mbcnt_hi_u32_b32 %0, -1, %0" : "=v"(ln_)); int tid_ = wv_ * 64 + ln_; int bid_ = blockIdx.x; asm volatile("" : "+s"(bid_)); int G_ = gridDim.x; asm volatile("" : "+s"(G_));
          unsigned lo_ = 0; asm volatile("" : "+s"(lo_));
          F.lds = (LAS unsigned char*)lds_raw + lo_; F.tid = tid_; F.lane = tid_ & 63; F.wave = __builtin_amdgcn_readfirstlane(tid_ >> 6); F.G = G_; F.bid = bid_; F.gw = bid_ * NWAVES + F.wave; F.NGW = G_ * NWAVES; }
        LAS unsigned char* ring = F.lds;
        int layer, op, rh = 0;
        { const unsigned pw = step_word(st); op = pw & 31; layer = (pw >> 5) & 1; rh = (pw >> 6) & 3; F.dry = (pw >> 8) & 1; }
        bool is_gemm = false, sync_after = true, fp8 = false;
        pg8::Gemm g{nullptr, nullptr, 0, 0, 0}; pg8::Order S{0, 0, 0, F.G, F.bid, 0, 0, 0, (const LAS int*)(F.lds + TAB_OFF), 0, 0, 0, 0}; pg8::Epi E{0, nullptr, nullptr, nullptr, nullptr, 0, 0, F.dry, 1.f, 0.f};
        unsigned char* wl = F.ws + WS_WL;
        constexpr int XM = (SKMODE == 1) ? 1 : 0;
#if SKMODE == 1
        if (op == OP_INPROJ) sk::inproj<false>(F);
        else if (op == OP_MLAPREP) sk::mlaprep<false>(F);
        else if (op == OP_MIX0 && layer == 0) sk::mix<false>(F);
        else if (op == OP_WOUT && layer == 0) sk::resid<false>(F, (const bf16*)(F.dout + DO_MIX) + (size_t)PADL * D, D, (const bf16*)(wl + WL_OUT), D, (const bf16*)(F.ws + WS_H) + (size_t)PADL * D);
        else if (op == OP_FFN_UP) sk::ffn_up<false>(F);
        else if (op == OP_FFN_DOWN) sk::resid<false>(F, (const bf16*)(F.ws + WS_HMID) + (size_t)PADL * DFF, DFF, (const bf16*)(F.ws + WS_WFF) + (size_t)2 * DFF * D, DFF, (const bf16*)(F.ws + WS_H) + (size_t)PADL * D);
#elif SKMODE == 2
        { bool did = true; const bf16* dbg = (const bf16*)(F.ws + sk::WS_DBG);
          if (op == OP_MLAPREP) sk::inproj<true>(F);
          else if (op == OP_MLAFIX) sk::mlaprep<true>(F);
          else if (op == OP_CONV && layer == 0) sk::mix<true>(F);
          else if (op == OP_NORM_FFN) sk::resid<true>(F, (const bf16*)(F.dout + DO_MIX) + (size_t)PADL * D, D, (const bf16*)(wl + WL_OUT), D, dbg);
          else if (op == OP_FFN_DOWN) sk::ffn_up<true>(F);
          else if (op == OP_NEXT) sk::resid<true>(F, (const bf16*)(F.ws + WS_HMID) + (size_t)PADL * DFF, DFF, (const bf16*)(F.ws + WS_WFF) + (size_t)2 * DFF * D, DFF, dbg);
          else did = false;
          if ((op == OP_CONV || op == OP_FFN_UP) && layer == 0 && F.bid == 0) {
              for (int i = F.tid; i < 16 * D / 8; i += NTHREADS) *((u32x4*)(F.ws + sk::WS_DBG) + i) = *((const u32x4*)((const bf16*)(F.ws + WS_H) + (size_t)PADL * D) + i); }
          if (did) xcd_barrier(bar); }
#endif
        switch (op) {
        case OP_INIT:
            convert_layer_weights(F, 0); phase_rope_table(F); phase_init_rows(F, inptr(2)); break;
        case OP_INPROJ:
            is_gemm = true; g = pg8::Gemm{(const bf16*)(F.dout + DO_U), (const bf16*)(wl + WL_IN), D, D, D}; S.nM = XM ? 128 : M / 256; S.xrow = XM; S.nN = 28;
            E.kind = pg8::EK_INPROJ; E.o0 = F.ws + WS_YM; E.o1 = F.ws + WS_YG; break;
        case OP_MLAPREP:
            is_gemm = true; g = pg8::Gemm{(const bf16*)(F.ws + WS_YM) + C_DQ, (const bf16*)(wl + WL_UQKV), 256, YW, 256}; S.nM = XM ? 128 : M / 256; S.xrow = XM; S.nN = 7; S.asplit = 3; S.aoff2 = (C_DKV - C_DQ) * 2;
            E.kind = pg8::EK_MLA; E.o0 = F.dout + DO_Q; E.o1 = F.dout + DO_K; E.i0 = F.ws + WS_V; E.fin = 0; break;
        case OP_MLAPREP2: break;
        case OP_MLAFIX: mla::fix(F, layer); phase_lin_prep(F, layer); break;
        case OP_NOP: break;
        case OP_ATTN: phase_linattn(F, layer); att::phase(F, layer); break;
        case OP_LIN: phase_linattn(F, layer); break;
        case OP_MIX0:
            is_gemm = true; sync_after = false; g = pg8::Gemm{(const bf16*)(F.ws + WS_O), (const bf16*)(wl + WL_OM), 512, 512, 512}; S.nM = (XM || layer) ? 128 : M / 256; S.xrow = (XM || layer) ? 1 : 0; S.nN = 4;
            E.kind = pg8::EK_MIX0; E.o0 = F.dout + DO_MIX; E.i0 = F.ws + WS_YG; break;
        case OP_MIX1:
            is_gemm = true; sync_after = false; g = pg8::Gemm{(const bf16*)(F.ws + WS_YM) + C_GV, (const bf16*)(wl + WL_OG), 512, YW, 512}; S.nM = (XM || layer) ? 128 : M / 256; S.xrow = (XM || layer) ? 1 : 0; S.nN = 4;
            E.kind = pg8::EK_MIX1; E.o0 = F.dout + DO_MIX; E.i0 = F.ws + WS_YG; break;
        case OP_MIX2:
            is_gemm = true; g = pg8::Gemm{(const bf16*)(F.ws + WS_YM) + C_HI, (const bf16*)(wl + WL_OH), 512, YW, 512}; S.nM = (XM || layer) ? 128 : M / 256; S.xrow = (XM || layer) ? 1 : 0; S.nN = 4;
            E.kind = pg8::EK_MIX2; E.o0 = F.dout + DO_MIX; E.i0 = F.ws + WS_YG; break;
        case OP_CONV:
            sync_after = false; if (layer == 0) convert_ffn_weights(F); else convert_expert_weights(F); break;
        case OP_WOUT:
            is_gemm = true; g = pg8::Gemm{(const bf16*)(F.dout + DO_MIX), (const bf16*)(wl + WL_OUT), D, D, D}; S.nM = (XM || layer) ? 128 : M / 256; S.xrow = (XM || layer) ? 1 : 0; S.nN = 4;
            E.kind = pg8::EK_RESID; E.o0 = F.ws + WS_H; break;
        case OP_NORM_FFN: phase_norm_rows(F, inptr(19), (bf16*)(F.dout + DO_U)); break;
        case OP_FFN_UP:
            is_gemm = true; g = pg8::Gemm{(const bf16*)(F.dout + DO_U), (const bf16*)(F.ws + WS_WFF), D, D, D}; S.nM = XM ? 128 : M / 256; S.xrow = XM; S.nN = 22;
            E.kind = pg8::EK_SWIGLU; E.o0 = F.ws + WS_HMID; E.ldo = DFF; break;
        case OP_FFN_DOWN:
            is_gemm = true; g = pg8::Gemm{(const bf16*)(F.ws + WS_HMID), (const bf16*)(F.ws + WS_WFF) + (size_t)2 * DFF * D, DFF, DFF, DFF}; S.nM = XM ? 128 : M / 256; S.xrow = XM; S.nN = 4;
            E.kind = pg8::EK_RESID; E.o0 = F.ws + WS_H; break;
        case OP_NEXT:
            convert_layer_weights(F, 1); phase_norm_rows(F, inptr(2) + D, (bf16*)(F.dout + DO_U)); break;
        case OP_ROUTE: phase_route(F, inptr(19) + D); break;
        case OP_SCATTER: phase_scatter(F, inptr(19) + D); break;
        default: {
            const int rk = rh;
            const int* tile_e = (const int*)(F.ws + WS_SMALL + SM_TILE_E) + rk * 256; const int* ntl = (const int*)(F.ws + WS_SMALL + SM_NT);
            LAS int* te = (LAS int*)(F.lds + TAB_OFF);
            const int nt_ = __builtin_amdgcn_readfirstlane(__hip_atomic_load(ntl + rk, __ATOMIC_RELAXED, __HIP_MEMORY_SCOPE_AGENT));
            for (int i = F.tid; i < 256; i += NTHREADS) te[i] = __hip_atomic_load(tile_e + i, __ATOMIC_RELAXED, __HIP_MEMORY_SCOPE_AGENT);
            const bf16* GU = (const bf16*)(F.ws + WS_WEXP); const bf16* DT = (const bf16*)(F.ws + WS_WEXP + (size_t)8 * 7168 * 1024);
            is_gemm = true; S.nM = nt_; S.grouped = 1;
            fp8 = true;
            if (op == OP_MOE_UP) { g = pg8::Gemm{(const bf16*)(F.ws + WS_XB + (size_t)rk * MOE_ROWS * D), GU, D, D, D}; S.nN = 28; S.tpe = 28; S.boff = 0;
                if (rk == 1) { const int nt0 = __builtin_amdgcn_readfirstlane(__hip_atomic_load(ntl + 0, __ATOMIC_RELAXED, __HIP_MEMORY_SCOPE_AGENT)); const int l3 = nt0 * 4 - 2 * F.G; S.late = (l3 > 0 && l3 < F.G / 2) ? l3 : 0; }
                E.kind = pg8::EK_SWIGLU; E.o0 = F.ws + WS_HQ + (size_t)rk * MOE_ROWS * DEXP; E.ldo = DEXP; E.osc = HQ_SCALE; E.isc = 1.f / (XB_SCALE * WU_SCALE); }
            else { g = pg8::Gemm{(const bf16*)(F.ws + WS_HQ + (size_t)rk * MOE_ROWS * DEXP), DT, DEXP, DEXP, DEXP}; S.nN = 4; S.tpe = 4; S.boff = 0;
                if (rk == 0) sync_after = false;
                E.kind = pg8::EK_MOEDOWN; E.o0 = F.ws + WS_H; E.o1 = F.dout; E.i0 = (const int*)(F.ws + WS_SMALL + SM_SLOT_TOK) + rk * MOE_ROWS; E.i1 = (const float*)(F.ws + WS_SMALL + SM_SLOT_W) + rk * MOE_ROWS; E.fin = (rk == 1) ? 1 : 0;
                E.osc = 1.f / (HQ_SCALE * WD_SCALE); }
            break; }
        }
        __syncthreads();
        if (is_gemm) { S.nwg = S.nM * S.nN;
            if (fp8) pg8::gemm_phase<pg8::Epi, pg8::Order, true, true>(ring, g, S, E, F.tid); else pg8::gemm_phase<pg8::Epi, pg8::Order, true, false>(ring, g, S, E, F.tid); }
        if (sync_after && st + 1 < args.ph_hi) xcd_barrier(bar);
    }
#if SKMODE == 2
    xcd_barrier(bar);
    { const unsigned e = xb_ld(ctl + sk::CW_ERR), n = xb_ld(ctl + sk::CW_ERR + 64);
      if (blockIdx.x == 0 && (e > SK_ERR_MAX || n != 1034240u)) args.out[threadIdx.x] = __builtin_nanf(""); }
#endif
}

extern "C" void kernel_launch(void* const* d_in, const int* in_sizes, int n_in, void* d_out, int out_size, void* d_ws, size_t ws_size, hipStream_t stream) {
    static int grid = 0;
    if (grid == 0) {
        if (n_in != 28 || ws_size < WS_END || out_size != BATCH * SEQ * D) { fprintf(stderr, "kernel_launch: unexpected shapes (n_in %d, ws %zu, out %d)\n", n_in, ws_size, out_size); grid = -1; return; }
        int dev = 0, cus = 0, per_cu = 0;
        if (hipGetDevice(&dev) != hipSuccess || hipDeviceGetAttribute(&cus, hipDeviceAttributeMultiprocessorCount, dev) != hipSuccess) { grid = -1; return; }
        if (hipFuncSetAttribute((const void*)fwd_kernel, hipFuncAttributeMaxDynamicSharedMemorySize, LDS_BYTES) != hipSuccess) { fprintf(stderr, "kernel_launch: hipFuncSetAttribute failed\n"); grid = -1; return; }
        if (hipOccupancyMaxActiveBlocksPerMultiprocessor(&per_cu, (const void*)fwd_kernel, NTHREADS, LDS_BYTES) != hipSuccess || per_cu < 1) { fprintf(stderr, "kernel_launch: occupancy query says %d\n", per_cu); }
        (void)hipGetLastError();
        grid = cus;
    }
    if (grid < 0) return;
    if (hipMemsetAsync((char*)d_ws + WS_CTL, 0, CTL_BYTES, stream) != hipSuccess) return;
    Args a{};
    for (int i = 0; i < 28; ++i) a.in[i] = (const float*)d_in[i];
    a.out = (float*)d_out; a.ws = (unsigned char*)d_ws; a.ph_lo = 0; a.ph_hi = NSTEP;
    hipLaunchKernelGGL(fwd_kernel, dim3(grid), dim3(NTHREADS), LDS_BYTES, stream, a);
}
```

```cpp
#include <hip/hip_runtime.h>
#include <cstdio>
#include <cstdint>

#define GAS __attribute__((address_space(1)))
#define LAS __attribute__((address_space(3)))
typedef unsigned short bf16;
typedef short bf16x8 __attribute__((ext_vector_type(8)));
typedef float f32x4 __attribute__((ext_vector_type(4)));
typedef float f32x2 __attribute__((ext_vector_type(2)));
typedef unsigned u32x4 __attribute__((ext_vector_type(4)));
typedef unsigned u32x2 __attribute__((ext_vector_type(2)));
typedef GAS unsigned gu32;

constexpr int BATCH = 4, SEQ = 8192, NMETA = 16, LTOK = SEQ + NMETA, PADL = 112, LP = LTOK + PADL, M = BATCH * LP, D = 1024;
constexpr int NWAVES = 8, NTHREADS = 512;
constexpr int YW = 4096, NGATE = 3072, IN_COLS = 7088;
constexpr int C_DQ = 0, C_DKV = 256, C_KR = 384, C_GQ = 416, C_GK = 672, C_GV = 928, C_GGD = 1440, C_GR = 1456, C_HQ = 1968, C_HF = 2480, C_HI = 2992, C_HG = 3504, C_END = 4016;
constexpr int QKW = 768, VW = 512;
constexpr float EPS = 1e-6f;
constexpr float QSCALE = 0.10206207261596577f * 1.4426950408889634f;
constexpr int DFF = 2816, DEXP = 3584, NEXP = 8;
constexpr float XB_SCALE = 8.f, WU_SCALE = 64.f, HQ_SCALE = 4.f, WD_SCALE = 128.f;
constexpr int MOE_TILES = 137, MOE_ROWS = MOE_TILES * 256;

constexpr size_t MiB = 1u << 20;
constexpr size_t WS_CTL = 0, CTL_BYTES = 1 * MiB;
constexpr size_t WS_ROPE = 1 * MiB;
constexpr size_t WS_SMALL = 3 * MiB;
constexpr size_t WS_H = 8 * MiB;
constexpr size_t WS_O = 74 * MiB;
constexpr size_t WS_WL = 138 * MiB;
constexpr size_t WS_YM = 160 * MiB;
constexpr size_t WS_YG = 420 * MiB;
constexpr size_t WS_V = 518 * MiB;
constexpr size_t WS_END = 562 * MiB;
constexpr size_t WS_WFF = WS_YG;
constexpr size_t WS_HMID = WS_YM;
constexpr size_t WS_WEXP = WS_YM;
constexpr size_t WS_HQ = WS_YM + 84 * MiB;
constexpr size_t WS_XB = 484 * MiB;
constexpr size_t WL_IN = 0, WL_UQKV = 14 * MiB, WL_OM = WL_UQKV + 1835008, WL_OG = WL_OM + 1572864, WL_OH = WL_OG + 1048576, WL_OUT = WL_OH + 1048576;
static_assert(WL_OUT + 2097152 <= 22 * MiB, "WL");
constexpr size_t DO_U = 0;
constexpr size_t DO_Q = 0, DO_K = 49 * MiB;
constexpr size_t DO_MIX = 49 * MiB;
constexpr size_t DO_XB1 = 0;
constexpr size_t SM_ASG_E = 0, SM_ASG_I = 262144, SM_ASG_W = 524288;
constexpr size_t SM_SLOT_TOK = 786432, SM_SLOT_W = SM_SLOT_TOK + 2 * MOE_ROWS * 4;
constexpr size_t SM_TILE_E = SM_SLOT_W + 2 * MOE_ROWS * 4;
constexpr size_t SM_NT = SM_TILE_E + 2048;
static_assert(SM_NT + 64 <= 5 * MiB, "small");
constexpr int CW_BAR = 4096, CW_CNT = 8192, CW_ATTQ = 16384, CW_LINC = 20480;

constexpr int RING_BYTES = 131072, LDSCTL_OFF = RING_BYTES, MISC_OFF = LDSCTL_OFF + 320, TAB_OFF = MISC_OFF + 128, LDS_BYTES = 147456;

__device__ __forceinline__ unsigned pk2(float lo, float hi) { unsigned r; asm("v_cvt_pk_bf16_f32 %0, %1, %2" : "=v"(r) : "v"(lo), "v"(hi)); return r; }
__device__ __forceinline__ unsigned f2bf(float f) { return pk2(f, f) & 0xffffu; }
__device__ __forceinline__ float bf2f(unsigned short b) { return __builtin_bit_cast(float, (unsigned)b << 16); }
__device__ __forceinline__ float bflo(unsigned w) { return __builtin_bit_cast(float, w << 16); }
__device__ __forceinline__ float bfhi(unsigned w) { return __builtin_bit_cast(float, w & 0xffff0000u); }
template <int CTRL> __device__ __forceinline__ float dppf(float v) { return __builtin_bit_cast(float, __builtin_amdgcn_update_dpp(0, __builtin_bit_cast(int, v), CTRL, 0xF, 0xF, true)); }
__device__ __forceinline__ float sum8(float v) { v += dppf<0xB1>(v); v += dppf<0x4E>(v); v += dppf<0x141>(v); return v; }
__device__ __forceinline__ float sum16(float v) { v = sum8(v); v += dppf<0x140>(v); return v; }
__device__ __forceinline__ float wave_sum(int, float v) {
    v = sum16(v);
    { float a = v, b = v; asm volatile("s_nop 1\n\tv_permlane16_swap_b32 %0, %1\n\ts_nop 1" : "+v"(a), "+v"(b)); v = a + b; }
    { float a = v, b = v; asm volatile("s_nop 1\n\tv_permlane32_swap_b32 %0, %1\n\ts_nop 1" : "+v"(a), "+v"(b)); v = a + b; }
    return v;
}
__device__ __forceinline__ float frcp(float x) { return __builtin_amdgcn_rcpf(x); }
__device__ __forceinline__ float frsq(float x) { return __builtin_amdgcn_rsqf(x); }
__device__ __forceinline__ float flog(float x) { return __builtin_amdgcn_logf(x) * 0.6931471805599453f; }
__device__ __forceinline__ float sigmoidf_(float x) { return frcp(1.f + __expf(-x)); }
__device__ __forceinline__ float siluf_(float x) { return x * frcp(1.f + __expf(-x)); }
#define WAVE_SYNC() do { asm volatile("s_waitcnt lgkmcnt(0)" ::: "memory"); __builtin_amdgcn_wave_barrier(); } while (0)
template <class T> __device__ __forceinline__ const GAS T* gp(const T* p) { return (const GAS T*)p; }
template <class T> __device__ __forceinline__ GAS T* gpw(T* p) { return (GAS T*)p; }
template <class T> __device__ __forceinline__ T gld(const void* p) { return *(const GAS T*)p; }
template <class T> __device__ __forceinline__ void gst(void* p, const T v) { *(GAS T*)p = v; }
__device__ __forceinline__ u32x4 zero4() { unsigned z = 0u; asm volatile("" : "+v"(z)); return (u32x4){z, z, z, z}; }
__device__ __forceinline__ const float* inptr(int k) {
    const __attribute__((address_space(4))) unsigned long long* ka = (const __attribute__((address_space(4))) unsigned long long*)__builtin_amdgcn_kernarg_segment_ptr();
    asm volatile("" : "+s"(ka));
    return (const float*)ka[k];
}

namespace pg8 {
#define PG8_LAS __attribute__((address_space(3)))
typedef unsigned short bf16_t;
constexpr int BM = 256, BK = 64, HALF = 128, HTB = HALF * BK * 2, NXCD = 8, WGM = 8;
__host__ __device__ __forceinline__ int lds_byte(int r, int c) { const int st = (r >> 4) * 2 + (c >> 5), rr = r & 15, cc = c & 31, ob = rr * 64 + cc * 2; return st * 1024 + (ob ^ (((ob >> 9) & 1) << 5)); }
__host__ __device__ __forceinline__ void stage_rc(int b, int& R, int& C) { const int st = b / 1024, sb = b % 1024, swz = sb ^ (((sb >> 9) & 1) << 5); R = (st >> 1) * 16 + swz / 64; C = (st & 1) * 32 + (swz % 64) / 2; }
__host__ __device__ __forceinline__ int perm32(int rho) { const int n = rho >> 4, i = rho & 15; return 8 * (i >> 2) + 4 * n + (i & 3); }

struct Unit { int pm, pn, pb; };
struct Gemm { const bf16_t* A; const bf16_t* Bt; int K, lda, ldb; };

__device__ __forceinline__ void tile_order(long L, int nM, int nN, int& pm, int& pn) {
    const int nwg = nM * nN; int wgid = (int)L;
    { const int q = nwg / NXCD, r = nwg % NXCD, xcd = wgid % NXCD, off = wgid / NXCD; wgid = (xcd < r ? xcd * (q + 1) : r * (q + 1) + (xcd - r) * q) + off; }
    const int nig = WGM * nN, gid = wgid / nig, fm = gid * WGM, gsz = (nM - fm) < WGM ? (nM - fm) : WGM;
    pm = fm + ((wgid % nig) % gsz); pn = (wgid % nig) / gsz;
}
struct Order {
    int nM, nN, nwg, G, c, tpe, boff, grouped; const PG8_LAS int* te; int xrow; int late;
    __device__ __forceinline__ bool next(int i, Unit& u) const {
        long L = (long)i * G + c;
        if (late > 0) {
            const int nf = G - late, R = nwg / nf;
            if (c >= late) { if (i >= R) return false; L = (long)i * nf + (c - late); } else L = (long)nf * R + (long)i * late + c; }
        if (L >= nwg) return false;
        tile_order(L, nM, nN, u.pm, u.pn);
        u.pb = grouped ? __builtin_amdgcn_readfirstlane(te[u.pm]) * tpe + boff + u.pn : u.pn;
        u.pm = 2 * u.pm + xrow * ((u.pm >> 5) + 1);
        return true;
    }
    __device__ __forceinline__ void a_ready(const Unit&) const {}
    __device__ __forceinline__ void done(const Unit&) const {}
};

typedef int v8i_t __attribute__((ext_vector_type(8)));
template <class Epi, class Sched, bool ALIGN_EPI = false, bool FP8 = false>
__device__ __forceinline__ void gemm_phase(PG8_LAS unsigned char* lds, const Gemm g, const Sched& S, const Epi& E, const int tid) {
    const int wid = __builtin_amdgcn_readfirstlane(tid >> 6), lane = tid & 63, wr = wid >> 2, wc = wid & 3, fr = lane & 15, fq = lane >> 4;
    constexpr int ESZ = FP8 ? 1 : 2;
    const int K = g.K, nt = K * ESZ / (BK * 2);
    unsigned voffA[2], voffB[2];
#pragma unroll
    for (int i = 0; i < 2; ++i) { int R, C; stage_rc(tid * 16 + i * 8192, R, C); const int Rb = Epi::PERM ? ((R & ~31) + perm32(R & 31)) : R;
        voffA[i] = (unsigned)(R * g.lda * ESZ + C * 2); voffB[i] = (unsigned)(Rb * g.ldb * ESZ + C * 2); }
    const size_t kstep = (size_t)(BK * 2);
    const size_t hstepA = (size_t)HALF * g.lda * ESZ, hstepB = (size_t)HALF * g.ldb * ESZ;
    const size_t tstepB = 2 * hstepB;
    const unsigned ldsw = (unsigned)wid * 1024u;
    const int aoff = lds_byte(wr * 64 + fr, FP8 ? fq * 16 : fq * 8), boff = lds_byte(wc * 32 + fr, FP8 ? fq * 16 : fq * 8);
    const int aoff1 = FP8 ? lds_byte(wr * 64 + fr, fq * 16 + 8) - aoff : 1024, boff1 = FP8 ? lds_byte(wc * 32 + fr, fq * 16 + 8) - boff : 1024;
#define PG8_SA(b, h) (((b) * 2 + (h)) * HTB)
#define PG8_SB(b, h) ((4 + (b) * 2 + (h)) * HTB)
#define PG8_STAGE(bufoff, gbase, voff) do { _Pragma("unroll") for (int _i = 0; _i < 2; ++_i) \
        __builtin_amdgcn_global_load_lds((const unsigned*)((const char*)(gbase) + (voff)[_i]), (PG8_LAS unsigned*)(lds + (bufoff) + ldsw + _i * 8192), 16, 0, 0); } while (0)
#define PG8_LDA(dst, b, h) do { _Pragma("unroll") for (int m = 0; m < 4; ++m) { \
        if constexpr (FP8) { const u32x4 lo_ = *(const PG8_LAS u32x4*)(lds + PG8_SA(b, h) + aoff + m * 2048), hi_ = *(const PG8_LAS u32x4*)(lds + PG8_SA(b, h) + aoff + m * 2048 + aoff1); \
            dst##8[m] = __builtin_bit_cast(v8i_t, __builtin_shufflevector(lo_, hi_, 0, 1, 2, 3, 4, 5, 6, 7)); } \
        else { _Pragma("unroll") for (int k = 0; k < 2; ++k) dst[m][k] = *(const PG8_LAS bf16x8*)(lds + PG8_SA(b, h) + aoff + m * 2048 + k * 1024); } } } while (0)
#define PG8_LDB(dst, b, h) do { _Pragma("unroll") for (int n = 0; n < 2; ++n) { \
        if constexpr (FP8) { const u32x4 lo_ = *(const PG8_LAS u32x4*)(lds + PG8_SB(b, h) + boff + n * 2048), hi_ = *(const PG8_LAS u32x4*)(lds + PG8_SB(b, h) + boff + n * 2048 + boff1); \
            dst##8[n] = __builtin_bit_cast(v8i_t, __builtin_shufflevector(lo_, hi_, 0, 1, 2, 3, 4, 5, 6, 7)); } \
        else { _Pragma("unroll") for (int k = 0; k < 2; ++k) dst[n][k] = *(const PG8_LAS bf16x8*)(lds + PG8_SB(b, h) + boff + n * 2048 + k * 1024); } } } while (0)
#define PG8_MMA(ai, bj, At, Bt) do { __builtin_amdgcn_s_setprio(1); \
        if constexpr (FP8) { _Pragma("unroll") for (int m = 0; m < 4; ++m) _Pragma("unroll") for (int n = 0; n < 2; ++n) \
            asm volatile("v_mfma_scale_f32_16x16x128_f8f6f4 %0, %1, %2, %0, %3, %3 op_sel_hi:[0,0,0]" : "+v"(acc[ai][bj][m][n]) : "v"(Bt##8[n]), "v"(At##8[m]), "v"(one8)); } \
        else { _Pragma("unroll") for (int m = 0; m < 4; ++m) _Pragma("unroll") for (int n = 0; n < 2; ++n) _Pragma("unroll") for (int k = 0; k < 2; ++k) \
            acc[ai][bj][m][n] = __builtin_amdgcn_mfma_f32_16x16x32_bf16(Bt[n][k], At[m][k], acc[ai][bj][m][n], 0, 0, 0); } \
        __builtin_amdgcn_s_setprio(0); } while (0)
#define PG8_WAIT_V(n) asm volatile("s_waitcnt vmcnt(" #n ")" ::: "memory")
#define PG8_WAIT_L(n) asm volatile("s_waitcnt lgkmcnt(" #n ")" ::: "memory")
#define PG8_BAR __builtin_amdgcn_s_barrier()
#define PG8_SCHED __builtin_amdgcn_sched_barrier(0)
    Unit cur, nxt; int ui = 0;
    if (!S.next(0, cur)) return;
    f32x4 acc[2][2][4][2];
#pragma unroll
    for (int a = 0; a < 2; ++a)
#pragma unroll
        for (int b = 0; b < 2; ++b)
#pragma unroll
            for (int m = 0; m < 4; ++m)
#pragma unroll
                for (int n = 0; n < 2; ++n) acc[a][b][m][n] = (f32x4){0.f, 0.f, 0.f, 0.f};
    bf16x8 At[4][2], B0[2][2], B1[2][2]; v8i_t At8[4], B08[2], B18[2];
    int one8 = 0x7F7F7F7F; asm volatile("" : "+v"(one8));
    const char* cA = (const char*)g.A + (size_t)cur.pm * hstepA; const char* cB = (const char*)g.Bt + (size_t)cur.pb * tstepB;
    S.a_ready(cur);
    PG8_STAGE(PG8_SB(0, 0), cB, voffB); PG8_STAGE(PG8_SB(0, 1), cB + hstepB, voffB); PG8_STAGE(PG8_SA(0, 0), cA, voffA); PG8_STAGE(PG8_SA(0, 1), cA + hstepA, voffA);
    if (wr == 1) PG8_BAR;
    PG8_WAIT_V(2); PG8_BAR;
    PG8_STAGE(PG8_SB(1, 0), cB + kstep, voffB); PG8_STAGE(PG8_SA(1, 0), cA + kstep, voffA); PG8_STAGE(PG8_SB(1, 1), cB + hstepB + kstep, voffB);
    PG8_WAIT_V(6); PG8_BAR;
    for (;;) {
        const bool has_next = S.next(ui + 1, nxt);
        const char* nA = has_next ? (const char*)g.A + (size_t)nxt.pm * hstepA : cA; const char* nB = has_next ? (const char*)g.Bt + (size_t)nxt.pb * tstepB : cB;
        for (int t = 0; t < nt; t += 2) {
            const bool last = (t == nt - 2);
            const char* a1 = cA + (size_t)(t + 1) * kstep;
            const char* a2 = last ? nA : cA + (size_t)(t + 2) * kstep; const char* b2 = last ? nB : cB + (size_t)(t + 2) * kstep;
            const char* a3 = a2 + kstep; const char* b3 = b2 + kstep;
            if (last && has_next) S.a_ready(nxt);
            PG8_LDB(B0, 0, 0); PG8_LDB(B1, 0, 1); PG8_SCHED; PG8_LDA(At, 0, 0); PG8_STAGE(PG8_SA(1, 1), a1 + hstepA, voffA);
            PG8_WAIT_V(8); PG8_WAIT_L(0); PG8_BAR; PG8_MMA(0, 0, At, B0); PG8_MMA(0, 1, At, B1); PG8_BAR; PG8_SCHED;
            PG8_LDA(At, 0, 1); PG8_STAGE(PG8_SB(0, 0), b2, voffB); PG8_STAGE(PG8_SB(0, 1), b2 + hstepB, voffB); PG8_STAGE(PG8_SA(0, 0), a2, voffA);
            PG8_WAIT_V(8); PG8_WAIT_L(0); PG8_BAR; PG8_MMA(1, 0, At, B0); PG8_MMA(1, 1, At, B1); PG8_BAR; PG8_SCHED;
            PG8_LDB(B0, 1, 0); PG8_LDB(B1, 1, 1); PG8_SCHED; PG8_LDA(At, 1, 0); PG8_STAGE(PG8_SA(0, 1), a2 + hstepA, voffA);
            PG8_WAIT_V(8); PG8_WAIT_L(0); PG8_BAR; PG8_MMA(0, 0, At, B0); PG8_MMA(0, 1, At, B1); PG8_BAR; PG8_SCHED;
            PG8_LDA(At, 1, 1); PG8_STAGE(PG8_SB(1, 0), b3, voffB); PG8_STAGE(PG8_SB(1, 1), b3 + hstepB, voffB); PG8_STAGE(PG8_SA(1, 0), a3, voffA);
            PG8_WAIT_V(8); PG8_WAIT_L(0); PG8_BAR; PG8_MMA(1, 0, At, B0); PG8_MMA(1, 1, At, B1); PG8_BAR; PG8_SCHED;
        }
        if constexpr (ALIGN_EPI) { if (wr == 0) PG8_BAR; }
        if constexpr (FP8) asm volatile("s_nop 15\n\ts_nop 15" ::: "memory");
        E(acc, cur, wr, wc, fr, fq); S.done(cur);
        if (!has_next) break;
#pragma unroll
        for (int a = 0; a < 2; ++a)
#pragma unroll
            for (int b = 0; b < 2; ++b)
#pragma unroll
                for (int m = 0; m < 4; ++m)
#pragma unroll
                    for (int n = 0; n < 2; ++n) acc[a][b][m][n] = (f32x4){0.f, 0.f, 0.f, 0.f};
        cur = nxt; cA = nA; cB = nB; ++ui;
        if constexpr (ALIGN_EPI) { if (wr == 1) PG8_BAR; }
    }
    PG8_WAIT_V(0);
    if constexpr (!ALIGN_EPI) { if (wr == 0) PG8_BAR; }
    PG8_BAR;
#undef PG8_SA
#undef PG8_SB
#undef PG8_STAGE
#undef PG8_LDA
#undef PG8_LDB
#undef PG8_MMA
#undef PG8_WAIT_V
#undef PG8_WAIT_L
#undef PG8_BAR
#undef PG8_SCHED
}

__device__ __forceinline__ unsigned cvt_pk_bf16(float lo, float hi) { unsigned r; asm volatile("v_cvt_pk_bf16_f32 %0, %1, %2" : "=v"(r) : "v"(lo), "v"(hi)); return r; }
__device__ __forceinline__ u32x4 pack8(const f32x4 v0, const f32x4 v1) { u32x4 w; w.x = cvt_pk_bf16(v0[0], v0[1]); w.y = cvt_pk_bf16(v0[2], v0[3]); w.z = cvt_pk_bf16(v1[0], v1[1]); w.w = cvt_pk_bf16(v1[2], v1[3]); return w; }
__device__ __forceinline__ float clamp448(float x) { return __builtin_amdgcn_fmed3f(x, -448.f, 448.f); }
__device__ __forceinline__ unsigned fp8x4(const f32x4 v) { int w = 0; w = __builtin_amdgcn_cvt_pk_fp8_f32(clamp448(v[0]), clamp448(v[1]), w, false);
    w = __builtin_amdgcn_cvt_pk_fp8_f32(clamp448(v[2]), clamp448(v[3]), w, true); return (unsigned)w; }
__device__ __forceinline__ unsigned q8(float x) { const float s = frcp(1.f + __expf(-x)); return (unsigned)(s * 255.f + 0.5f); }

#define EPI_FENCE() asm volatile("" ::: "memory")
enum { EK_INPROJ = 0, EK_MIX0, EK_MIX1, EK_MIX2, EK_RESID, EK_SWIGLU, EK_MOEDOWN, EK_MLA };
struct Epi {
    static constexpr bool PERM = true;
    int kind;
    void* o0;
    void* o1;
    const void* i0;
    const void* i1;
    int ldo, fin, dry;
    float isc;
    float osc;
    __device__ __forceinline__ void operator()(const f32x4 (&acc)[2][2][4][2], const Unit& u, int wr, int wc, int fr, int fq) const {
        const int row0 = u.pm * HALF + wr * 64 + fr;
        if (dry) { float sink = 0.f;
#pragma unroll
            for (int ai = 0; ai < 2; ++ai)
#pragma unroll
                for (int bj = 0; bj < 2; ++bj)
#pragma unroll
                    for (int m = 0; m < 4; ++m) sink += acc[ai][bj][m][0][0] + acc[ai][bj][m][1][3];
            asm volatile("" :: "v"(sink)); return; }
        if (kind == EK_INPROJ) {
            if (u.pn < 16) { bf16_t* Ym = (bf16_t*)o0; const int col0 = u.pn * BM + wc * 32 + 8 * fq;
#pragma unroll
                for (int ai = 0; ai < 2; ++ai)
#pragma unroll
                    for (int m = 0; m < 4; ++m) { bf16_t* rowp = Ym + (size_t)(row0 + ai * HALF + m * 16) * YW + col0;
#pragma unroll
                        for (int bj = 0; bj < 2; ++bj) gst<u32x4>(rowp + bj * HALF, pack8(acc[ai][bj][m][0], acc[ai][bj][m][1])); }
            } else { unsigned char* Yg = (unsigned char*)o1; const int col0 = (u.pn - 16) * BM + wc * 32 + 8 * fq;
#pragma unroll
                for (int ai = 0; ai < 2; ++ai)
#pragma unroll
                    for (int m = 0; m < 4; ++m) { unsigned char* rowp = Yg + (size_t)(row0 + ai * HALF + m * 16) * NGATE + col0;
#pragma unroll
                        for (int bj = 0; bj < 2; ++bj) { const f32x4 a = acc[ai][bj][m][0], b = acc[ai][bj][m][1]; u32x2 w;
                            w.x = q8(a[0]) | (q8(a[1]) << 8) | (q8(a[2]) << 16) | (q8(a[3]) << 24); w.y = q8(b[0]) | (q8(b[1]) << 8) | (q8(b[2]) << 16) | (q8(b[3]) << 24);
                            gst<u32x2>(rowp + bj * HALF, w); } }
            }
        } else if (kind <= EK_MIX2) {
            bf16_t* Mx = (bf16_t*)o0; const unsigned char* Yg = (const unsigned char*)i0 + (kind - EK_MIX0) * 1024; const bool addp = kind != EK_MIX0;
            const int col0 = u.pn * BM + wc * 32 + 8 * fq; const float s = 1.f / 255.f;
#pragma unroll
            for (int ai = 0; ai < 2; ++ai)
#pragma unroll
                for (int bj = 0; bj < 2; ++bj) { const int col = col0 + bj * HALF; u32x2 gw[4]; u32x4 pv[4];
#pragma unroll
                    for (int m = 0; m < 4; ++m) { const int row = row0 + ai * HALF + m * 16; gw[m] = gld<u32x2>(Yg + (size_t)row * NGATE + col);
                        pv[m] = (u32x4){0u, 0u, 0u, 0u}; if (addp) pv[m] = gld<u32x4>(Mx + (size_t)row * D + col); }
#pragma unroll
                    for (int m = 0; m < 4; ++m) { const int row = row0 + ai * HALF + m * 16; f32x4 a = acc[ai][bj][m][0], b = acc[ai][bj][m][1]; const u32x2 g = gw[m]; const u32x4 p = pv[m];
                        a[0] = a[0] * ((float)(g.x & 255u) * s) + bflo(p.x); a[1] = a[1] * ((float)((g.x >> 8) & 255u) * s) + bfhi(p.x); a[2] = a[2] * ((float)((g.x >> 16) & 255u) * s) + bflo(p.y); a[3] = a[3] * ((float)(g.x >> 24) * s) + bfhi(p.y);
                        b[0] = b[0] * ((float)(g.y & 255u) * s) + bflo(p.z); b[1] = b[1] * ((float)((g.y >> 8) & 255u) * s) + bfhi(p.z); b[2] = b[2] * ((float)((g.y >> 16) & 255u) * s) + bflo(p.w); b[3] = b[3] * ((float)(g.y >> 24) * s) + bfhi(p.w);
                        gst<u32x4>(Mx + (size_t)row * D + col, pack8(a, b)); }
                    EPI_FENCE(); }
        } else if (kind == EK_RESID) {
            bf16_t* H = (bf16_t*)o0; const int col0 = u.pn * BM + wc * 32 + 8 * fq;
#pragma unroll
            for (int ai = 0; ai < 2; ++ai)
#pragma unroll
                for (int bj = 0; bj < 2; ++bj) { u32x4 x[4];
#pragma unroll
                    for (int m = 0; m < 4; ++m) x[m] = gld<u32x4>(H + (size_t)(row0 + ai * HALF + m * 16) * D + col0 + bj * HALF);
#pragma unroll
                    for (int m = 0; m < 4; ++m) { const f32x4 a = acc[ai][bj][m][0] * isc + (f32x4){bflo(x[m].x), bfhi(x[m].x), bflo(x[m].y), bfhi(x[m].y)}, b = acc[ai][bj][m][1] * isc + (f32x4){bflo(x[m].z), bfhi(x[m].z), bflo(x[m].w), bfhi(x[m].w)};
                        gst<u32x4>(H + (size_t)(row0 + ai * HALF + m * 16) * D + col0 + bj * HALF, pack8(a, b)); }
                    EPI_FENCE(); }
        } else if (kind == EK_SWIGLU) {
            bf16_t* O = (bf16_t*)o0; const int col0 = u.pn * HALF + wc * 32 + 8 * fq; const float c1 = -1.4426950408889634f * isc, c2 = isc * isc * (osc > 0.f ? osc : 1.f);
#pragma unroll
            for (int ai = 0; ai < 2; ++ai)
#pragma unroll
                for (int m = 0; m < 4; ++m) { f32x4 h[2];
#pragma unroll
                    for (int n = 0; n < 2; ++n)
#pragma unroll
                        for (int e = 0; e < 4; ++e) { const float ga = acc[ai][0][m][n][e], ua = acc[ai][1][m][n][e];
                            h[n][e] = ga * ua * c2 * frcp(1.f + __builtin_amdgcn_exp2f(ga * c1)); }
                    if (osc > 0.f) { u32x2 w8; w8.x = fp8x4(h[0]); w8.y = fp8x4(h[1]); gst<u32x2>((unsigned char*)o0 + (size_t)(row0 + ai * HALF + m * 16) * ldo + col0, w8); }
                    else gst<u32x4>(O + (size_t)(row0 + ai * HALF + m * 16) * ldo + col0, pack8(h[0], h[1])); }
        } else if (kind == EK_MLA) {
            bf16_t* Qb = (bf16_t*)o0; bf16_t* Kb = (bf16_t*)o1; bf16_t* Vb = (bf16_t*)i0;
#pragma unroll
            for (int ai = 0; ai < 2; ++ai)
#pragma unroll
                for (int m = 0; m < 4; ++m) { const size_t row = (size_t)(row0 + ai * HALF + m * 16);
#pragma unroll
                    for (int bj = 0; bj < 2; ++bj) { const u32x4 w = pack8(acc[ai][bj][m][0], acc[ai][bj][m][1]);
                        const int pn_ = u.pn + fin;
                        if (pn_ < 3) gst<u32x4>(Qb + row * QKW + pn_ * BM + bj * HALF + wc * 32 + 8 * fq, w);
                        else { const int c = (pn_ - 3) * BM + bj * HALF + wc * 32 + 8 * fq, hh = c >> 7, d = c & 127;
                            if (d < 64) gst<u32x4>(Kb + row * QKW + hh * 96 + d, w); else gst<u32x4>(Vb + row * VW + hh * 64 + d - 64, w); } } }
        } else {
            bf16_t* H = (bf16_t*)o0; float* out = (float*)o1; const int* slot_tok = (const int*)i0; const float* slot_w = (const float*)i1;
            const int col0 = u.pn * BM + wc * 32 + 8 * fq;
#pragma unroll
            for (int ai = 0; ai < 2; ++ai) { int tk[4]; float wv[4];
#pragma unroll
                for (int m = 0; m < 4; ++m) { const int slot = row0 + ai * HALF + m * 16; tk[m] = gld<int>(slot_tok + slot); wv[m] = gld<float>(slot_w + slot) * osc; }
#pragma unroll
                for (int bj = 0; bj < 2; ++bj) { u32x4 x[4];
#pragma unroll
                    for (int m = 0; m < 4; ++m) { const int t_ = tk[m] < 0 ? 0 : tk[m]; x[m] = gld<u32x4>(H + (size_t)t_ * D + col0 + bj * HALF); }
#pragma unroll
                    for (int m = 0; m < 4; ++m) if (tk[m] >= 0) {
                        const f32x4 a = acc[ai][bj][m][0] * wv[m] + (f32x4){bflo(x[m].x), bfhi(x[m].x), bflo(x[m].y), bfhi(x[m].y)}, b = acc[ai][bj][m][1] * wv[m] + (f32x4){bflo(x[m].z), bfhi(x[m].z), bflo(x[m].w), bfhi(x[m].w)};
                        if (fin) { const int bb = tk[m] / LP, p = tk[m] - bb * LP; f32x4* q = (f32x4*)(out + ((size_t)bb * SEQ + (p - 128)) * D + col0 + bj * HALF); gst<f32x4>(q, a); gst<f32x4>(q + 1, b); }
                        else gst<u32x4>(H + (size_t)tk[m] * D + col0 + bj * HALF, pack8(a, b)); }
                    EPI_FENCE(); } }
        }
    }
};
}

#define XB_TMO      128
#define XB_XCNT(j)  (256  + 64 * (j))
#define XB_XSUB(j)  (1280 + 64 * (j))
#define XB_XGEN(j)  (2304 + 64 * (j))
#define XB_TOP      3328
#define XB_TOPGEN   3392
#define XCD_BAR_WORDS 3456
#define XB_SPIN_CAP (1u << 25)
__device__ __forceinline__ unsigned xb_ld(unsigned* p)              { return __hip_atomic_load(p, __ATOMIC_RELAXED, __HIP_MEMORY_SCOPE_AGENT); }
__device__ __forceinline__ unsigned xb_add(unsigned* p, unsigned v) { return __hip_atomic_fetch_add(p, v, __ATOMIC_RELAXED, __HIP_MEMORY_SCOPE_AGENT); }
__device__ __forceinline__ unsigned xb_xcc_id() { return (unsigned)__builtin_amdgcn_s_getreg((3 << 11) | 20) & 0xFu; }
#define XB_SPIN(cond, bar) do { unsigned _sp = 0; while (cond) { __builtin_amdgcn_s_sleep(1); \
    if ((++_sp & 255u) == 0u) { if (xb_ld(&(bar)[XB_TMO])) break; if (_sp > XB_SPIN_CAP) { atomicAdd(&(bar)[XB_TMO], 1u); break; } } } } while (0)
struct XcdBarrier { unsigned* bar; unsigned x; volatile LAS unsigned* st; };
__device__ __forceinline__ XcdBarrier xcd_barrier_post(unsigned* bar, volatile LAS unsigned* st) {
    XcdBarrier b; b.bar = bar; b.x = xb_xcc_id(); b.st = st;
    if (threadIdx.x == 0) (void)xb_add(&bar[XB_XCNT(b.x)], 1u);
    return b;
}
__device__ __forceinline__ void xcd_barrier_complete(unsigned* bar, unsigned x, unsigned& nloc, unsigned& nx) {
    const unsigned G = gridDim.x * gridDim.y * gridDim.z;
    unsigned sum, cnt, mine, sp = 0u;
    for (;;) {
        sum = 0u; cnt = 0u; mine = 0u;
#pragma unroll
        for (unsigned j = 0; j < 16; ++j) { const unsigned c = xb_ld(&bar[XB_XCNT(j)]); sum += c; cnt += (c > 0u) ? 1u : 0u; mine = (j == x) ? c : mine; }
        if (sum == G) break;
        __builtin_amdgcn_s_sleep(1);
        if ((++sp & 255u) == 0u) { if (xb_ld(&bar[XB_TMO])) break; if (sp > XB_SPIN_CAP) { atomicAdd(&bar[XB_TMO], 1u); break; } }
    }
    nloc = mine > 0u ? mine : 1u; nx = cnt > 0u ? cnt : 1u;
}
__device__ __forceinline__ void xcd_barrier(const XcdBarrier& b) {
    asm volatile("s_waitcnt vmcnt(0)" ::: "memory");
    __syncthreads();
    if (threadIdx.x == 0) {
        unsigned* bar = b.bar;
        __builtin_amdgcn_s_waitcnt(0);
        unsigned nloc = b.st[0], nx = b.st[1];
        if (nloc == 0u) { xcd_barrier_complete(bar, b.x, nloc, nx); b.st[0] = nloc; b.st[1] = nx; }
        const unsigned old = xb_add(&bar[XB_XSUB(b.x)], 1u);
        const unsigned gen = old / nloc;
        if (old + 1u == (gen + 1u) * nloc) {
            __builtin_amdgcn_fence(__ATOMIC_RELEASE, "agent");
            asm volatile("s_waitcnt vmcnt(0)" ::: "memory");
            const unsigned og = xb_add(&bar[XB_TOP], 1u);
            const unsigned tg = og / nx;
            if (og + 1u == (tg + 1u) * nx) xb_add(&bar[XB_TOPGEN], 1u);
            else XB_SPIN(xb_ld(&bar[XB_TOPGEN]) == tg, bar);
            __builtin_amdgcn_fence(__ATOMIC_ACQUIRE, "agent");
            xb_add(&bar[XB_XGEN(b.x)], 1u);
            asm volatile("s_waitcnt vmcnt(0)" ::: "memory");
        } else {
            XB_SPIN(xb_ld(&bar[XB_XGEN(b.x)]) == gen, bar);
            __builtin_amdgcn_fence(__ATOMIC_ACQUIRE, "agent");
            asm volatile("s_waitcnt vmcnt(0)" ::: "memory");
        }
    }
    __syncthreads();
}

struct Args { const float* in[28]; float* out; unsigned char* ws; int ph_lo, ph_hi; };
struct Frame {
    LAS unsigned char* lds; unsigned char* ws; unsigned char* dout;
    int tid, lane, wave, G, bid, gw, NGW, dry;
};

template <bool F8>
__device__ __forceinline__ void transpose_tile(const float* W, size_t ldw, int k0, int ncol0, int nvalid, bf16* WT, size_t ldt, int drow0, int dk0, const float* gain, float scale, LAS float* scr, int lane) {
    const int n_ = lane & 31;
    float tv[32];
#pragma unroll
    for (int i = 0; i < 32; ++i) { const int kk = 2 * i + (lane >> 5); tv[i] = 0.f; if (n_ < nvalid) tv[i] = *(const GAS float*)gp(W + (size_t)(k0 + kk) * ldw + ncol0 + n_); }
    { const float* gsrc = gain ? gain : W;
      const bool hasg = gain != nullptr;
#pragma unroll
      for (int i = 0; i < 32; ++i) { const float gv = *(const GAS float*)gp(gsrc + k0 + 2 * i + (lane >> 5)); tv[i] *= hasg ? gv : 1.f; } }
#pragma unroll
    for (int i = 0; i < 32; ++i) scr[(2 * i + (lane >> 5)) * 33 + n_] = tv[i] * scale;
    WAVE_SYNC();
    const int c = lane & 7;
#pragma unroll
    for (int j = 0; j < 4; ++j) { const LAS float* s = scr + (8 * c) * 33 + (lane >> 3) + 8 * j;
#pragma unroll
        for (int q = 0; q < 8; ++q) tv[8 * j + q] = s[q * 33]; }
#pragma unroll
    for (int j = 0; j < 4; ++j) { const int n = (lane >> 3) + 8 * j; const float* s = tv + 8 * j;
        if (F8) { u32x2 o; o.x = pg8::fp8x4((f32x4){s[0], s[1], s[2], s[3]}); o.y = pg8::fp8x4((f32x4){s[4], s[5], s[6], s[7]});
            if (n < nvalid) *(GAS u32x2*)gpw((u32x2*)((unsigned char*)WT + (size_t)(drow0 + n) * ldt + dk0 + 8 * c)) = o; }
        else { u32x4 o; o.x = pk2(s[0], s[1]); o.y = pk2(s[2], s[3]); o.z = pk2(s[4], s[5]); o.w = pk2(s[6], s[7]);
            if (n < nvalid) *(GAS u32x4*)gpw((u32x4*)(WT + (size_t)(drow0 + n) * ldt + dk0 + 8 * c)) = o; } }
    WAVE_SYNC();
}
template <int MODE, bool F8 = false>
__device__ __forceinline__ void conv_matrix(const Frame& F, const float* W, int K, int Ncols, size_t ldw, int ncol_base, bf16* WT, size_t ldt, int drow_base, const float* gain, int dk_base = 0, float scale = 1.f) {
    LAS float* scr = (LAS float*)(F.lds + F.wave * 16384);
    const int nkb = K / 64, nnb = (Ncols + 31) / 32, ntile = nkb * nnb;
    for (int it = F.gw; it < ntile; it += F.NGW) {
        const int kb = it / nnb, nb = it % nnb, n0 = nb * 32, nvalid = (Ncols - n0) < 32 ? (Ncols - n0) : 32;
        int drow0 = drow_base + n0, dk0 = dk_base + kb * 64;
        if (MODE == 1) drow0 = 256 * (n0 / 128) + (n0 % 128) + drow_base;
        if (MODE == 2) dk0 = kb * 96;
        transpose_tile<F8>(W, ldw, kb * 64, ncol_base + n0, nvalid, WT, ldt, drow0, dk0, gain, scale, scr, F.lane);
    }
}
__device__ __forceinline__ void zero_fill16(const Frame& F, void* p, size_t bytes) {
    u32x4* q = (u32x4*)p; const size_t n = bytes / 16;
    const u32x4 z4 = zero4();
    for (size_t i = (size_t)F.bid * NTHREADS + F.tid; i < n; i += (size_t)F.G * NTHREADS) q[i] = z4;
}
__device__ __forceinline__ void convert_layer_weights(const Frame& F, int layer) {
    unsigned char* wl = F.ws + WS_WL;
    bf16* WinT = (bf16*)(wl + WL_IN); bf16* uq = (bf16*)(wl + WL_UQKV);
    const float* w_in = inptr(3) + (size_t)layer * D * IN_COLS;
    LAS float* scr = (LAS float*)(F.lds + F.wave * 16384);
    constexpr int T0 = 16 * 126, T1 = T0 + 16 * 96, T2 = T1 + 4 * 24, T3 = T2 + 2 * 32, T4 = T3 + 8 * 32, T5 = T4 + 8 * 32, T6 = T5 + 8 * 32, T7 = T6 + 16 * 32;
    for (int it = F.gw; it < T7; it += F.NGW) {
        const float* W; const float* gain = nullptr; bf16* WT; int Ncols, ldw, ncol_base = 0, ldt, drow_base = 0, nnb, t;
        if (it < T0)      { t = it;      W = w_in; Ncols = C_END; ldw = IN_COLS; WT = WinT; ldt = D; nnb = 126; }
        else if (it < T1) { t = it - T0; W = w_in; Ncols = NGATE; ldw = IN_COLS; ncol_base = C_END; WT = WinT; ldt = D; drow_base = YW; nnb = 96; }
        else if (it < T2) { t = it - T1; W = inptr(5) + (size_t)layer * 256 * 768; Ncols = 768; ldw = 768; WT = uq; ldt = 256; gain = inptr(4) + layer * 256; nnb = 24; }
        else if (it < T3) { t = it - T2; W = inptr(7) + (size_t)layer * 128 * 1024; Ncols = 1024; ldw = 1024; WT = uq; ldt = 256; drow_base = 768; gain = inptr(6) + layer * 128; nnb = 32; }
        else if (it < T4) { t = it - T3; W = inptr(15) + (size_t)layer * 512 * 1024; Ncols = 1024; ldw = 1024; WT = (bf16*)(wl + WL_OM); ldt = 512; nnb = 32; }
        else if (it < T5) { t = it - T4; W = inptr(16) + (size_t)layer * 512 * 1024; Ncols = 1024; ldw = 1024; WT = (bf16*)(wl + WL_OG); ldt = 512; nnb = 32; }
        else if (it < T6) { t = it - T5; W = inptr(17) + (size_t)layer * 512 * 1024; Ncols = 1024; ldw = 1024; WT = (bf16*)(wl + WL_OH); ldt = 512; nnb = 32; }
        else              { t = it - T6; W = inptr(18) + (size_t)layer * 1024 * 1024; Ncols = 1024; ldw = 1024; WT = (bf16*)(wl + WL_OUT); ldt = 1024; nnb = 32; }
        const int kb = t / nnb, n0 = (t % nnb) * 32, nvalid = (Ncols - n0) < 32 ? (Ncols - n0) : 32;
        transpose_tile<false>(W, (size_t)ldw, kb * 64, ncol_base + n0, nvalid, WT, (size_t)ldt, drow_base + n0, kb * 64, gain, 1.f, scr, F.lane);
    }
    zero_fill16(F, WinT + (size_t)C_END * D, (size_t)(YW - C_END) * D * 2);
    { const u32x4 z4 = zero4();
      for (int i = F.bid * NTHREADS + F.tid; i < 1024 * 16; i += F.G * NTHREADS) { const int row = 768 + (i >> 4), c = 16 + (i & 15); *(u32x4*)(uq + (size_t)row * 256 + 8 * c) = z4; } }
}

__device__ __forceinline__ float row_rstd(const Frame& F, const f32x4 (&v)[4]) {
    float s = 0.f;
#pragma unroll
    for (int j = 0; j < 4; ++j) s += (v[j].x * v[j].x + v[j].y * v[j].y) + (v[j].z * v[j].z + v[j].w * v[j].w);
    return frsq(wave_sum(F.lane, s) * (1.f / D) + EPS);
}
__device__ __forceinline__ void store_row_bf16(bf16* orow, const f32x4 (&v)[4], float rstd, const float* gain, int lane) {
    unsigned long long* o8 = (unsigned long long*)orow + lane;
#pragma unroll
    for (int j = 0; j < 4; ++j) { const f32x4 g = gld<f32x4>((const f32x4*)gain + lane + 64 * j);
        gst<u32x2>(o8 + 64 * j, (u32x2){pk2(v[j].x * rstd * g.x, v[j].y * rstd * g.y), pk2(v[j].z * rstd * g.z, v[j].w * rstd * g.w)}); }
}
__device__ __forceinline__ void store_row_bf16g(bf16* orow, const f32x4 (&v)[4], float rstd, const f32x4 (&g)[4], int lane) {
    unsigned long long* o8 = (unsigned long long*)orow + lane;
#pragma unroll
    for (int j = 0; j < 4; ++j) gst<u32x2>(o8 + 64 * j, (u32x2){pk2(v[j].x * rstd * g[j].x, v[j].y * rstd * g[j].y), pk2(v[j].z * rstd * g[j].z, v[j].w * rstd * g[j].w)});
}
__device__ __forceinline__ void store_row_fp8(unsigned char* orow, const f32x4 (&v)[4], float rstd, const float* gain, float scale, int lane) {
    unsigned* o4 = (unsigned*)orow + lane;
#pragma unroll
    for (int j = 0; j < 4; ++j) { const f32x4 g = gld<f32x4>((const f32x4*)gain + lane + 64 * j); const float sc = rstd * scale;
        gst<unsigned>(o4 + 64 * j, pg8::fp8x4((f32x4){v[j].x * sc * g.x, v[j].y * sc * g.y, v[j].z * sc * g.z, v[j].w * sc * g.w})); }
}
__device__ __forceinline__ void load_h_row(const bf16* hrow, int lane, f32x4 (&v)[4]) {
#pragma unroll
    for (int j = 0; j < 4; ++j) { const u32x2 w = *(const GAS u32x2*)gp((const u32x2*)hrow + lane + 64 * j); v[j] = (f32x4){bflo(w.x), bfhi(w.x), bflo(w.y), bfhi(w.y)}; }
}
__device__ __forceinline__ void store_h_row(bf16* hrow, int lane, const f32x4 (&v)[4]) {
#pragma unroll
    for (int j = 0; j < 4; ++j) { u32x2 w; w.x = pk2(v[j].x, v[j].y); w.y = pk2(v[j].z, v[j].w); gst<u32x2>((u32x2*)hrow + lane + 64 * j, w); }
}
__device__ __forceinline__ void phase_init_rows(const Frame& F, const float* gain) {
    bf16* H = (bf16*)(F.ws + WS_H); bf16* U = (bf16*)(F.dout + DO_U);
    const float* x = inptr(0); const float* meta = inptr(1);
    f32x4 gn[4];
#pragma unroll
    for (int j = 0; j < 4; ++j) gn[j] = gld<f32x4>((const f32x4*)gain + F.lane + 64 * j);
    f32x4 vr[2][4];
    auto issue = [&](int q, int r_) { const int r = r_ < M ? r_ : F.gw; const int b = r / LP, p = r - b * LP;
        const float* src = (p < 128) ? meta + (size_t)(p < PADL ? 0 : p - PADL) * D : x + ((size_t)b * SEQ + (p - 128)) * D;
#pragma unroll
        for (int j = 0; j < 4; ++j) vr[q][j] = *(const GAS f32x4*)gp((const f32x4*)src + F.lane + 64 * j); };
    issue(0, F.gw); issue(1, F.gw + F.NGW);
    for (int r0 = F.gw; r0 < M; r0 += 2 * F.NGW)
#pragma unroll
        for (int q = 0; q < 2; ++q) { const int r = r0 + q * F.NGW; if (r >= M) break;
            f32x4 v[4]; const int p = r % LP;
#pragma unroll
            for (int j = 0; j < 4; ++j) { v[j] = vr[q][j]; if (p < PADL) v[j] = (f32x4){0.f, 0.f, 0.f, 0.f}; }
            issue(q, r + 2 * F.NGW);
            store_h_row(H + (size_t)r * D, F.lane, v);
            const float rstd = row_rstd(F, v);
            store_row_bf16g(U + (size_t)r * D, v, rstd, gn, F.lane); }
}
__device__ __forceinline__ void phase_norm_rows(const Frame& F, const float* gain, bf16* U) {
    const bf16* H = (const bf16*)(F.ws + WS_H);
    f32x4 gn[4];
#pragma unroll
    for (int j = 0; j < 4; ++j) gn[j] = gld<f32x4>((const f32x4*)gain + F.lane + 64 * j);
    u32x2 rw[4][4];
#pragma unroll
    for (int q = 0; q < 4; ++q) { const int r = F.gw + q * F.NGW < M ? F.gw + q * F.NGW : F.gw;
#pragma unroll
        for (int j = 0; j < 4; ++j) rw[q][j] = *(const GAS u32x2*)gp((const u32x2*)(H + (size_t)r * D) + F.lane + 64 * j); }
    for (int r0 = F.gw; r0 < M; r0 += 4 * F.NGW)
#pragma unroll
        for (int q = 0; q < 4; ++q) { const int r = r0 + q * F.NGW; if (r >= M) break;
            f32x4 v[4];
#pragma unroll
            for (int j = 0; j < 4; ++j) { const u32x2 w = rw[q][j]; v[j] = (f32x4){bflo(w.x), bfhi(w.x), bflo(w.y), bfhi(w.y)}; }
            { const int rn = r + 4 * F.NGW < M ? r + 4 * F.NGW : r;
#pragma unroll
              for (int j = 0; j < 4; ++j) rw[q][j] = *(const GAS u32x2*)gp((const u32x2*)(H + (size_t)rn * D) + F.lane + 64 * j); }
            const float rstd = row_rstd(F, v);
            store_row_bf16g(U + (size_t)r * D, v, rstd, gn, F.lane); }
}
__device__ __forceinline__ void phase_rope_table(const Frame& F) {
    float* ct = (float*)(F.ws + WS_ROPE); float* st = ct + LP * 16;
    for (int i = F.bid * NTHREADS + F.tid; i < LP * 16; i += F.G * NTHREADS) {
        const int p = i >> 4, k = i & 15; const int pos = p - PADL;
        const float inv = exp2f(-(float)k * 0.83048202372184059f);
        const float ang = (float)(pos < 0 ? 0 : pos) * inv;
        const float c_hi = 0.15915494309189535f;
        const float c_lo = 6.420638326565253e-09f;
        const float t_hi = ang * c_hi; const float e = fmaf(ang, c_hi, -t_hi);
        float fr = t_hi - rintf(t_hi); fr += e + ang * c_lo;
        ct[i] = __builtin_amdgcn_cosf(fr); st[i] = __builtin_amdgcn_sinf(fr);
    }
}

namespace att {
typedef float f32x16 __attribute__((ext_vector_type(16)));
typedef short s16x4 __attribute__((ext_vector_type(4)));
typedef short v4i16_t __attribute__((ext_vector_type(4)));
constexpr int KS = 208, VS = 192, KBUF = 64 * KS, VBUF = 64 * VS, BUF = KBUF + VBUF;
constexpr int NUNIT = BATCH * 8 * 33;
__device__ __forceinline__ int crow(int r, int hi) { return (r & 3) + 8 * (r >> 2) + 4 * hi; }
__device__ __forceinline__ unsigned cvtpk(float lo, float hi) { unsigned r; asm volatile("v_cvt_pk_bf16_f32 %0, %1, %2" : "=v"(r) : "v"(lo), "v"(hi)); return r; }
__device__ __forceinline__ s16x4 vtr(const LAS unsigned char* p) { return __builtin_bit_cast(s16x4, __builtin_amdgcn_ds_read_tr16_b64_v4i16((LAS v4i16_t*)p)); }
__device__ __forceinline__ float xhalf_max(float m) { auto rr = __builtin_amdgcn_permlane32_swap(__float_as_uint(m), __float_as_uint(m), false, false); return fmaxf(__uint_as_float(rr[0]), __uint_as_float(rr[1])); }
__device__ __forceinline__ float xhalf_sum(float m) { auto rr = __builtin_amdgcn_permlane32_swap(__float_as_uint(m), __float_as_uint(m), false, false); return __uint_as_float(rr[0]) + __uint_as_float(rr[1]); }

__device__ __forceinline__ void unit(const Frame& F, int b, int h, int qb) {
    const int tid = F.tid, lane = F.lane, wave = F.wave, r32 = lane & 31, hi = lane >> 5;
    bf16* Q = (bf16*)(F.dout + DO_Q); const bf16* Kg = (const bf16*)(F.dout + DO_K) + (size_t)b * LP * QKW + h * 96; const bf16* Vg = (const bf16*)(F.ws + WS_V) + (size_t)b * LP * VW + h * 64;
    const int pw = 256 * qb + 32 * wave;
    const int Tl = (4 * qb + 3) < 129 ? (4 * qb + 3) : 129;
    const int twr = pw >> 6;
    const int tw = (pw >= LP) ? 0 : (twr < 129 ? twr : 129);
    const int qp = pw + r32, qpc = qp < LP ? qp : LP - 1;
    bf16x8 qf[6];
    { const bf16* qrow = Q + ((size_t)b * LP + qpc) * QKW + h * 96 + 8 * hi;
#pragma unroll
      for (int ks = 0; ks < 6; ++ks) qf[ks] = *(const GAS bf16x8*)gp(qrow + 16 * ks); }
    const int kr0 = tid / 12, kc0 = tid % 12, kr1 = (512 + tid) / 12, kc1 = (512 + tid) % 12, vr = tid >> 3, vc = tid & 7;
    const bf16* kg0 = Kg + (size_t)kr0 * QKW + kc0 * 8; const bf16* kg1 = Kg + (size_t)kr1 * QKW + kc1 * 8; const bf16* vg = Vg + (size_t)vr * VW + vc * 8;
    LAS unsigned char* lds = F.lds;
    const int kl0 = kr0 * KS + kc0 * 16, kl1 = kr1 * KS + kc1 * 16, vl = KBUF + vr * VS + vc * 16;
    const int koff = r32 * KS + 16 * hi;
    const int voff = KBUF + (4 * hi + ((lane & 15) >> 2)) * VS + (16 * ((lane >> 4) & 1) + 4 * (lane & 3)) * 2;
    u32x4 kA0, kA1 = zero4(), vA;
#define ATT_LOAD(k0_, k1_, v_, tt) do { const int tc_ = (tt) <= Tl ? (tt) : Tl; const size_t ko_ = (size_t)(64 * tc_) * QKW, vo_ = (size_t)(64 * tc_) * VW; \
        k0_ = *(const GAS u32x4*)gp(kg0 + ko_); if (tid < 256) k1_ = *(const GAS u32x4*)gp(kg1 + ko_); v_ = *(const GAS u32x4*)gp(vg + vo_); } while (0)
#define ATT_WRITE(k0_, k1_, v_, bufi) do { LAS unsigned char* nb_ = lds + (bufi) * BUF; *(LAS u32x4*)(nb_ + kl0) = k0_; if (tid < 256) *(LAS u32x4*)(nb_ + kl1) = k1_; *(LAS u32x4*)(nb_ + vl) = v_; } while (0)
#define ATT_QK(P0, P1, bufi) do { const LAS unsigned char* kq_ = lds + (bufi) * BUF + koff; \
        _Pragma("unroll") for (int ks = 0; ks < 6; ++ks) { const bf16x8 a0 = *(const LAS bf16x8*)(kq_ + 32 * ks), a1 = *(const LAS bf16x8*)(kq_ + 32 * KS + 32 * ks); \
            P0 = __builtin_amdgcn_mfma_f32_32x32x16_bf16(a0, qf[ks], P0, 0, 0, 0); P1 = __builtin_amdgcn_mfma_f32_32x32x16_bf16(a1, qf[ks], P1, 0, 0, 0); } } while (0)
#define ATT_MASK(P0, P1, tt) do { const int kbase = 64 * (tt) + 4 * hi; \
        _Pragma("unroll") for (int r = 0; r < 16; ++r) { const int key = kbase + (r & 3) + 8 * (r >> 2); \
            if (key > qp || key < PADL) P0[r] = -1e30f; if (key + 32 > qp || key + 32 < PADL) P1[r] = -1e30f; } } while (0)
    ATT_LOAD(kA0, kA1, vA, 1); ATT_WRITE(kA0, kA1, vA, 0);
    ATT_LOAD(kA0, kA1, vA, 2); ATT_WRITE(kA0, kA1, vA, 1);
    __syncthreads();
    float m = -1e30f, l = 0.f; f32x16 o0 = {}, o1 = {}, p0 = {}, p1 = {};
    if (tw >= 1) { ATT_QK(p0, p1, 0); ATT_MASK(p0, p1, 1); }
    int cur = 0;
    for (int t = 1; t <= Tl; ++t) {
        ATT_LOAD(kA0, kA1, vA, t + 2);
        const int nx1 = cur == 2 ? 0 : cur + 1, nx2 = nx1 == 2 ? 0 : nx1 + 1;
        if (t <= tw) {
            const LAS unsigned char* kb = lds + cur * BUF; const LAS unsigned char* kq_ = lds + nx1 * BUF + koff;
            bf16x8 kf0[3], kf1[3];
#pragma unroll
            for (int ks = 0; ks < 3; ++ks) { kf0[ks] = *(const LAS bf16x8*)(kq_ + 32 * ks); kf1[ks] = *(const LAS bf16x8*)(kq_ + 32 * KS + 32 * ks); }
            __builtin_amdgcn_sched_barrier(0);
            float rm = fmaxf(p0[0], p1[0]);
#pragma unroll
            for (int r = 1; r < 16; ++r) rm = fmaxf(rm, fmaxf(p0[r], p1[r]));
            rm = xhalf_max(rm);
            const float mn = fmaxf(m, rm), alpha = __builtin_amdgcn_exp2f(m - mn); m = mn;
            __builtin_amdgcn_sched_barrier(0);
            f32x16 n0 = {}, n1 = {};
#pragma unroll
            for (int ks = 0; ks < 3; ++ks) { n0 = __builtin_amdgcn_mfma_f32_32x32x16_bf16(kf0[ks], qf[ks], n0, 0, 0, 0); n1 = __builtin_amdgcn_mfma_f32_32x32x16_bf16(kf1[ks], qf[ks], n1, 0, 0, 0); }
            __builtin_amdgcn_sched_barrier(0);
#pragma unroll
            for (int ks = 0; ks < 3; ++ks) { kf0[ks] = *(const LAS bf16x8*)(kq_ + 32 * (ks + 3)); kf1[ks] = *(const LAS bf16x8*)(kq_ + 32 * KS + 32 * (ks + 3)); }
            __builtin_amdgcn_sched_barrier(0);
            float ls = 0.f;
#pragma unroll
            for (int r = 0; r < 16; ++r) { p0[r] = __builtin_amdgcn_exp2f(p0[r] - mn); ls += p0[r]; }
            __builtin_amdgcn_sched_barrier(0);
#pragma unroll
            for (int ks = 0; ks < 3; ++ks) { n0 = __builtin_amdgcn_mfma_f32_32x32x16_bf16(kf0[ks], qf[ks + 3], n0, 0, 0, 0); n1 = __builtin_amdgcn_mfma_f32_32x32x16_bf16(kf1[ks], qf[ks + 3], n1, 0, 0, 0); }
            __builtin_amdgcn_sched_barrier(0);
            s16x4 vlo[8], vhi[8];
#pragma unroll
            for (int s_ = 0; s_ < 4; ++s_)
#pragma unroll
                for (int d0 = 0; d0 < 2; ++d0) { const LAS unsigned char* vp = kb + voff + (32 * (s_ >> 1) + 16 * (s_ & 1)) * VS + 64 * d0; vlo[2 * s_ + d0] = vtr(vp); vhi[2 * s_ + d0] = vtr(vp + 8 * VS); }
            __builtin_amdgcn_sched_barrier(0);
#pragma unroll
            for (int r = 0; r < 16; ++r) { p1[r] = __builtin_amdgcn_exp2f(p1[r] - mn); ls += p1[r]; }
            l = l * alpha + ls;
            if (!__all(alpha == 1.f)) {
#pragma unroll
                for (int r = 0; r < 16; ++r) { o0[r] *= alpha; o1[r] *= alpha; } }
            bf16x8 pb[4];
#pragma unroll
            for (int s_ = 0; s_ < 4; ++s_) { u32x4 w;
                if (s_ < 2) { w.x = cvtpk(p0[8 * s_], p0[8 * s_ + 1]); w.y = cvtpk(p0[8 * s_ + 2], p0[8 * s_ + 3]); w.z = cvtpk(p0[8 * s_ + 4], p0[8 * s_ + 5]); w.w = cvtpk(p0[8 * s_ + 6], p0[8 * s_ + 7]); }
                else { const int q_ = 8 * (s_ - 2); w.x = cvtpk(p1[q_], p1[q_ + 1]); w.y = cvtpk(p1[q_ + 2], p1[q_ + 3]); w.z = cvtpk(p1[q_ + 4], p1[q_ + 5]); w.w = cvtpk(p1[q_ + 6], p1[q_ + 7]); }
                pb[s_] = __builtin_bit_cast(bf16x8, w); }
#pragma unroll
            for (int s_ = 0; s_ < 4; ++s_) {
                const bf16x8 af0 = (bf16x8){vlo[2 * s_][0], vlo[2 * s_][1], vlo[2 * s_][2], vlo[2 * s_][3], vhi[2 * s_][0], vhi[2 * s_][1], vhi[2 * s_][2], vhi[2 * s_][3]};
                const bf16x8 af1 = (bf16x8){vlo[2 * s_ + 1][0], vlo[2 * s_ + 1][1], vlo[2 * s_ + 1][2], vlo[2 * s_ + 1][3], vhi[2 * s_ + 1][0], vhi[2 * s_ + 1][1], vhi[2 * s_ + 1][2], vhi[2 * s_ + 1][3]};
                o0 = __builtin_amdgcn_mfma_f32_32x32x16_bf16(af0, pb[s_], o0, 0, 0, 0); o1 = __builtin_amdgcn_mfma_f32_32x32x16_bf16(af1, pb[s_], o1, 0, 0, 0); }
            if (t + 1 == twr) ATT_MASK(n0, n1, t + 1);
            p0 = n0; p1 = n1;
        }
        ATT_WRITE(kA0, kA1, vA, nx2); __syncthreads(); cur = nx1;
    }
#undef ATT_LOAD
#undef ATT_WRITE
#undef ATT_QK
#undef ATT_MASK
    const float lt = xhalf_sum(l); const float inv = (qp >= PADL && lt > 0.f) ? 1.f / lt : 0.f;
    if (qp < LP && !F.dry) { bf16* orow = (bf16*)(F.ws + WS_O) + ((size_t)b * LP + qp) * 512 + h * 64 + 4 * hi;
#pragma unroll
        for (int g4 = 0; g4 < 4; ++g4) { u32x2 w0, w1;
            w0.x = cvtpk(o0[4 * g4] * inv, o0[4 * g4 + 1] * inv); w0.y = cvtpk(o0[4 * g4 + 2] * inv, o0[4 * g4 + 3] * inv);
            w1.x = cvtpk(o1[4 * g4] * inv, o1[4 * g4 + 1] * inv); w1.y = cvtpk(o1[4 * g4 + 2] * inv, o1[4 * g4 + 3] * inv);
            gst<u32x2>(orow + 8 * g4, w0); gst<u32x2>(orow + 32 + 8 * g4, w1); } }
}
__device__ __forceinline__ void phase(const Frame& F, int layer) {
    const int xg = F.bid & 7;
    unsigned* ctl = (unsigned*)(F.ws + WS_CTL) + CW_ATTQ + 64 * ((2 * layer + F.dry) * 8 + xg);
    volatile LAS int* slot = (volatile LAS int*)(F.lds + MISC_OFF + 64);
    for (;;) {
        if (F.tid == 0) slot[0] = (int)atomicAdd(ctl, 1u);
        __syncthreads();
        const int i = __builtin_amdgcn_readfirstlane(slot[0]);
        __syncthreads();
        if (i >= NUNIT / 8) break;
        const int qb = 32 - (i >> 2), bh = 4 * xg + (i & 3);
        unit(F, bh >> 3, bh & 7, qb);
    }
}
}

namespace mla {
__device__ __forceinline__ void fix(const Frame& F, int layer) {
    const bf16* Ym = (const bf16*)(F.ws + WS_YM);
    bf16* Q = (bf16*)(F.dout + DO_Q); bf16* Kb = (bf16*)(F.dout + DO_K); bf16* V = (bf16*)(F.ws + WS_V);
    const float* qn = inptr(8) + layer * 96; const float* kn = inptr(9) + layer * 96;
    const float* ct = (const float*)(F.ws + WS_ROPE); const float* st = ct + LP * 16;
    const int lane = F.lane, h = lane >> 3, sub = lane & 7;
    f32x4 qg0 = *(const GAS f32x4*)gp(qn + 8 * sub), qg1 = *(const GAS f32x4*)gp(qn + 8 * sub + 4), kg0 = *(const GAS f32x4*)gp(kn + 8 * sub), kg1 = *(const GAS f32x4*)gp(kn + 8 * sub + 4);
    const f32x2 qr1 = *(const GAS f32x2*)gp(qn + 64 + 2 * sub), qr2 = *(const GAS f32x2*)gp(qn + 80 + 2 * sub), kr1 = *(const GAS f32x2*)gp(kn + 64 + 2 * sub), kr2 = *(const GAS f32x2*)gp(kn + 80 + 2 * sub);
    struct Ld { u32x2 dqw; unsigned dkw, krw, qa, qb, ka, kb_; u32x4 qw, kw, vw; f32x2 c, sn; };
    auto load_row = [&](int r) { Ld d; const int rc = r < M ? r : F.gw; const int p = rc % LP; const bf16* y = Ym + (size_t)rc * YW;
        const bf16* qrow = Q + (size_t)rc * QKW + h * 96; const bf16* krow = Kb + (size_t)rc * QKW + h * 96; const bf16* vrow = V + (size_t)rc * VW + h * 64;
        d.dqw = *(const GAS u32x2*)gp(y + C_DQ + 4 * lane); d.dkw = *(const GAS unsigned*)gp(y + C_DKV + 2 * lane);
        d.krw = *(const GAS unsigned*)gp(y + C_KR + 2 * (lane & 15));
        d.qw = *(const GAS u32x4*)gp(qrow + 8 * sub); d.qa = *(const GAS unsigned*)gp(qrow + 64 + 2 * sub); d.qb = *(const GAS unsigned*)gp(qrow + 80 + 2 * sub);
        d.kw = *(const GAS u32x4*)gp(krow + 8 * sub); d.vw = *(const GAS u32x4*)gp(vrow + 8 * sub);
        d.ka = *(const GAS unsigned*)gp(y + C_KR + 2 * sub); d.kb_ = *(const GAS unsigned*)gp(y + C_KR + 16 + 2 * sub);
        d.c = *(const GAS f32x2*)gp(ct + (size_t)p * 16 + 2 * sub); d.sn = *(const GAS f32x2*)gp(st + (size_t)p * 16 + 2 * sub); return d; };
    Ld nx = load_row(F.gw);
    for (int r = F.gw; r < M; r += F.NGW) {
        const Ld d = nx; nx = load_row(r + F.NGW);
        bf16* qrow = Q + (size_t)r * QKW + h * 96; bf16* krow = Kb + (size_t)r * QKW + h * 96; bf16* vrow = V + (size_t)r * VW + h * 64;
        const u32x2 dqw = d.dqw; const unsigned dkw = d.dkw, krw = d.krw, qa = d.qa, qb = d.qb, ka = d.ka, kb_ = d.kb_; const u32x4 qw = d.qw, kw = d.kw, vw = d.vw; const f32x2 c = d.c, sn = d.sn;
        const float rsq = frsq(wave_sum(F.lane, bflo(dqw.x) * bflo(dqw.x) + bfhi(dqw.x) * bfhi(dqw.x) + bflo(dqw.y) * bflo(dqw.y) + bfhi(dqw.y) * bfhi(dqw.y)) * (1.f / 256.f) + EPS);
        const float rskv = frsq(wave_sum(F.lane, bflo(dkw) * bflo(dkw) + bfhi(dkw) * bfhi(dkw)) * (1.f / 128.f) + EPS);
        float krs = bflo(krw) * bflo(krw) + bfhi(krw) * bfhi(krw);
        krs = sum16(krs);
        { float e[8] = {bflo(qw.x), bfhi(qw.x), bflo(qw.y), bfhi(qw.y), bflo(qw.z), bfhi(qw.z), bflo(qw.w), bfhi(qw.w)}; float x1[2] = {bflo(qa), bfhi(qa)}, x2[2] = {bflo(qb), bfhi(qb)};
          float ss = 0.f;
#pragma unroll
          for (int i = 0; i < 8; ++i) { e[i] *= rsq; ss += e[i] * e[i]; }
#pragma unroll
          for (int i = 0; i < 2; ++i) { x1[i] *= rsq; x2[i] *= rsq; ss += x1[i] * x1[i] + x2[i] * x2[i]; }
          ss = sum8(ss);
          const float sc = QSCALE * frsq(ss * (1.f / 96.f) + EPS);
          u32x4 w; w.x = pk2(e[0] * sc * qg0[0], e[1] * sc * qg0[1]); w.y = pk2(e[2] * sc * qg0[2], e[3] * sc * qg0[3]); w.z = pk2(e[4] * sc * qg1[0], e[5] * sc * qg1[1]); w.w = pk2(e[6] * sc * qg1[2], e[7] * sc * qg1[3]);
          if (!F.dry) *(GAS u32x4*)gpw(qrow + 8 * sub) = w;
          const float a0 = x1[0] * sc * qr1[0], a1 = x1[1] * sc * qr1[1], b0 = x2[0] * sc * qr2[0], b1 = x2[1] * sc * qr2[1];
          if (!F.dry) *(GAS unsigned*)gpw(qrow + 64 + 2 * sub) = pk2(a0 * c[0] - b0 * sn[0], a1 * c[1] - b1 * sn[1]); if (!F.dry) *(GAS unsigned*)gpw(qrow + 80 + 2 * sub) = pk2(a0 * sn[0] + b0 * c[0], a1 * sn[1] + b1 * c[1]); }
        { float e[8] = {bflo(kw.x), bfhi(kw.x), bflo(kw.y), bfhi(kw.y), bflo(kw.z), bfhi(kw.z), bflo(kw.w), bfhi(kw.w)}; float ss = 0.f;
#pragma unroll
          for (int i = 0; i < 8; ++i) { e[i] *= rskv; ss += e[i] * e[i]; }
          ss = sum8(ss);
          const float sc = frsq((ss + krs) * (1.f / 96.f) + EPS);
          u32x4 w; w.x = pk2(e[0] * sc * kg0[0], e[1] * sc * kg0[1]); w.y = pk2(e[2] * sc * kg0[2], e[3] * sc * kg0[3]); w.z = pk2(e[4] * sc * kg1[0], e[5] * sc * kg1[1]); w.w = pk2(e[6] * sc * kg1[2], e[7] * sc * kg1[3]);
          if (!F.dry) *(GAS u32x4*)gpw(krow + 8 * sub) = w;
          const float a0 = bflo(ka) * sc * kr1[0], a1 = bfhi(ka) * sc * kr1[1], b0 = bflo(kb_) * sc * kr2[0], b1 = bfhi(kb_) * sc * kr2[1];
          if (!F.dry) *(GAS unsigned*)gpw(krow + 64 + 2 * sub) = pk2(a0 * c[0] - b0 * sn[0], a1 * c[1] - b1 * sn[1]); if (!F.dry) *(GAS unsigned*)gpw(krow + 80 + 2 * sub) = pk2(a0 * sn[0] + b0 * c[0], a1 * sn[1] + b1 * c[1]);
          u32x4 wv; wv.x = pk2(bflo(vw.x) * rskv, bfhi(vw.x) * rskv); wv.y = pk2(bflo(vw.y) * rskv, bfhi(vw.y) * rskv); wv.z = pk2(bflo(vw.z) * rskv, bfhi(vw.z) * rskv); wv.w = pk2(bflo(vw.w) * rskv, bfhi(vw.w) * rskv);
          if (!F.dry) *(GAS u32x4*)gpw(vrow + 8 * sub) = wv; }
    }
}
}

constexpr size_t WS_C12 = 551 * MiB;
constexpr int NCHUNK = LP / 64;
__device__ __forceinline__ void phase_lin_prep(const Frame& F, int layer) {
    bf16* Ym = (bf16*)(F.ws + WS_YM); float* c1g = (float*)(F.ws + WS_C12);
    const int lane = F.lane;
    LAS float* bbl = (LAS float*)(F.lds + F.wave * 16384) + lane;
    for (int u = F.gw; u < BATCH * NCHUNK * 12; u += F.NGW) {
        const int chunk = u / 12, sub = u % 12, b = chunk / NCHUNK, n = chunk % NCHUNK;
        const bool HG = sub >= 4; const int h = HG ? (sub - 4) >> 1 : sub; const int i = HG ? ((sub - 4) & 1) * 64 + lane : lane; const int DK = HG ? 128 : 64;
        const int ch = h * DK + i; const int cq = (HG ? C_HQ : C_GQ) + ch, ck = (HG ? C_HF : C_GK) + ch;
        bf16* y0 = Ym + ((size_t)b * LP + 64 * n) * YW;
        const int tpad = PADL - 64 * n;
        float run = 0.f, lb = 0.f;
        unsigned kq[128];
#define LP_ISSUE() do { _Pragma("unroll") for (int t = 0; t < 64; ++t) { const bf16* y = y0 + (size_t)t * YW; kq[t] = gld<bf16>(y + ck); kq[64 + t] = gld<bf16>(y + cq); } } while (0)
        if (!HG) { const float* w_g2 = inptr(10) + (size_t)layer * 16 * 256; const float bg = inptr(11)[layer * 256 + ch]; float wg[16];
#pragma unroll
            for (int rr = 0; rr < 16; ++rr) wg[rr] = gld<float>(w_g2 + rr * 256 + ch);
#pragma unroll 16
            for (int t = 0; t < 64; ++t) { const bf16* y = y0 + (size_t)t * YW; const u32x4 g0 = gld<u32x4>(y + C_GGD), g1 = gld<u32x4>(y + C_GGD + 8);
                const float z = bg + bflo(g0.x) * wg[0] + bfhi(g0.x) * wg[1] + bflo(g0.y) * wg[2] + bfhi(g0.y) * wg[3] + bflo(g0.z) * wg[4] + bfhi(g0.z) * wg[5] + bflo(g0.w) * wg[6] + bfhi(g0.w) * wg[7]
                              + bflo(g1.x) * wg[8] + bfhi(g1.x) * wg[9] + bflo(g1.y) * wg[10] + bfhi(g1.y) * wg[11] + bflo(g1.z) * wg[12] + bfhi(g1.z) * wg[13] + bflo(g1.w) * wg[14] + bfhi(g1.w) * wg[15];
                float lg = -(fmaxf(-z, 0.f) + flog(1.f + __expf(-fabsf(z)))) * (1.f / 16.f);
                if (t < tpad) lg = 0.f;
                run += lg; bbl[64 * t] = run; }
            LP_ISSUE();
        } else { if (layer == 1) { const float* lbp = inptr(13); lb = 1.f / (1.f + __expf(lbp[ch] - lbp[512 + ch])); }
            LP_ISSUE();
#pragma unroll
            for (int t = 0; t < 64; ++t) { const float f = lb + (1.f - lb) * sigmoidf_(bf2f((bf16)kq[t])); float lg = flog(fmaxf(f, 1e-30f));
                kq[t] = __builtin_bit_cast(unsigned, f);
                if (t < tpad) lg = 0.f;
                run += lg; bbl[64 * t] = run; } }
#undef LP_ISSUE
        const float bref = run;
#pragma unroll
        for (int t = 0; t < 64; ++t) { bf16* y = y0 + (size_t)t * YW; float q, k;
            if (!HG) { q = bf2f((bf16)kq[64 + t]) * 0.125f; k = bf2f((bf16)kq[t]); }
            else { q = siluf_(bf2f((bf16)kq[64 + t])); k = 1.f - __builtin_bit_cast(float, kq[t]); }
            if (t < tpad) { q = 0.f; k = 0.f; }
            const float d = fminf(bbl[64 * t] - bref, 80.f);
            if (!F.dry) { gst<bf16>(y + cq, (bf16)f2bf(q * __expf(d))); gst<bf16>(y + ck, (bf16)f2bf(k * __expf(-d))); } }
        if (!F.dry) gst<float>(c1g + chunk * 768 + (HG ? 256 + ch : ch), __expf(bref));
    }
}
namespace lin {
typedef float f32x16 __attribute__((ext_vector_type(16)));
using att::vtr; using att::cvtpk; using att::crow; using att::xhalf_sum; typedef att::s16x4 s16x4;
constexpr int NSEG = 4;
constexpr size_t WS_SLOC = 553 * MiB;
constexpr size_t WS_DTOT = 561 * MiB;
template <int DK, bool HG>
__device__ __forceinline__ void pass1(const Frame& F, int b, int h, int n0, int nc, float* sloc, float* dtot) {
    constexpr int QS = DK * 2 + 16, VSt = 320, QB = 64 * QS, VB = 64 * VSt, CB = DK * 4, BUFB = QB + VB + CB, NI = DK / 32, NO = NI / 2, QCH = DK / 8;
    constexpr int NQC = 64 * QCH, NL = (NQC + 1024) / NTHREADS; static_assert(NQC % NTHREADS == 0 && 2 * BUFB <= RING_BYTES, "pass1 staging");
    const bf16* Ym = (const bf16*)(F.ws + WS_YM); const float* c1g = (const float*)(F.ws + WS_C12);
    const int tid = F.tid, lane = F.lane, wave = F.wave, j = wave & 3, th = wave >> 2, hi = lane >> 5;
    const int ck = (HG ? C_HF : C_GK) + h * DK, cv = (HG ? C_HI : C_GV) + h * 128, cc = (HG ? 256 : 0) + h * DK;
    LAS unsigned char* lds = F.lds;
    unsigned gsrc[NL]; int ldst[NL];
#pragma unroll
    for (int k = 0; k < NL; ++k) { const int reg = (NTHREADS * k) / NQC;
        if (reg < 1) { const int e2 = tid + NTHREADS * k, r = e2 / QCH, c = e2 % QCH; gsrc[k] = (unsigned)(r * YW + ck + 8 * c); ldst[k] = r * QS + 16 * c; }
        else { const int e3 = tid + NTHREADS * k - NQC, r = e3 >> 4, c = e3 & 15; gsrc[k] = (unsigned)(r * YW + cv + 8 * c); ldst[k] = QB + r * VSt + 16 * c; } }
    const size_t rowb = (size_t)b * LP;
    float S[NO][16];
#pragma unroll
    for (int i = 0; i < NO; ++i)
#pragma unroll
        for (int r = 0; r < 16; ++r) S[i][r] = 0.f;
    f32x4 prod;
    { const size_t ro = (rowb + 64 * n0) * YW; u32x4 st[NL];
#pragma unroll
      for (int k = 0; k < NL; ++k) st[k] = *(const GAS u32x4*)gp(Ym + ro + gsrc[k]);
      const f32x4 cst = *(const GAS f32x4*)gp(c1g + (size_t)(b * NCHUNK + n0) * 768 + cc + 4 * (tid & (DK / 4 - 1)));
#pragma unroll
      for (int k = 0; k < NL; ++k) *(LAS u32x4*)(lds + ldst[k]) = st[k];
      if (tid < DK / 4) *(LAS f32x4*)(lds + QB + VB + 16 * tid) = cst;
      prod = cst; }
    __syncthreads();
    const int trq = (lane & 15) >> 2, trc = (16 * ((lane >> 4) & 1) + 4 * (lane & 3)) * 2;
    int cur = 0;
    for (int c = 0; c < nc; ++c) {
        const bool more = c + 1 < nc; const int nn = n0 + c + (more ? 1 : 0); const size_t ron = (rowb + 64 * nn) * YW; LAS unsigned char* nb = lds + (cur ^ 1) * BUFB;
        u32x4 st[NL];
#pragma unroll
        for (int k = 0; k < NL; ++k) st[k] = *(const GAS u32x4*)gp(Ym + ron + gsrc[k]);
        const f32x4 cst = *(const GAS f32x4*)gp(c1g + (size_t)(b * NCHUNK + nn) * 768 + cc + 4 * (tid & (DK / 4 - 1)));
        const LAS unsigned char* kt = lds + cur * BUFB; const LAS unsigned char* vt = kt + QB; const LAS float* c1l = (const LAS float*)(vt + VB);
#pragma unroll
        for (int ii = 0; ii < NO; ++ii) { const int i = th + 2 * ii;
#pragma unroll
            for (int g4 = 0; g4 < 4; ++g4) { const f32x4 dc = *(const LAS f32x4*)(c1l + 32 * i + 8 * g4 + 4 * hi);
#pragma unroll
                for (int e = 0; e < 4; ++e) S[ii][4 * g4 + e] *= dc[e]; }
            f32x16 T = {};
#pragma unroll
            for (int s_ = 0; s_ < 4; ++s_) { const LAS unsigned char* kp = kt + (16 * s_ + 8 * hi + trq) * QS + 64 * i + trc; const LAS unsigned char* vp = vt + (16 * s_ + 8 * hi + trq) * VSt + 64 * j + trc;
                const s16x4 ka = vtr(kp), kb2 = vtr(kp + 4 * QS), va = vtr(vp), vb2 = vtr(vp + 4 * VSt);
                T = __builtin_amdgcn_mfma_f32_32x32x16_bf16((bf16x8){ka[0], ka[1], ka[2], ka[3], kb2[0], kb2[1], kb2[2], kb2[3]}, (bf16x8){va[0], va[1], va[2], va[3], vb2[0], vb2[1], vb2[2], vb2[3]}, T, 0, 0, 0); }
#pragma unroll
            for (int r = 0; r < 16; ++r) S[ii][r] += T[r]; }
#pragma unroll
        for (int k = 0; k < NL; ++k) *(LAS u32x4*)(nb + ldst[k]) = st[k];
        if (tid < DK / 4) *(LAS f32x4*)(nb + QB + VB + 16 * tid) = cst;
        if (more) prod = prod * cst;
        __syncthreads();
        cur ^= 1;
    }
#pragma unroll
    for (int ii = 0; ii < NO; ++ii) { const int i = th + 2 * ii;
#pragma unroll
        for (int r = 0; r < 16; ++r) *(GAS float*)gpw(sloc + (size_t)(((i * 4 + j) * 16 + r) * 64 + lane)) = S[ii][r]; }
    if (tid < DK / 4) *(GAS f32x4*)gpw((f32x4*)dtot + tid) = prod;
}
template <int DK, bool HG>
__device__ __forceinline__ void unit(const Frame& F, int layer, int b, int h, int seg, int uidx) {
    const int n0 = seg == 0 ? 1 : 34 + 32 * (seg - 1), nc = seg == 0 ? 33 : 32, nend = n0 + nc;
    float* slocb = (float*)(F.ws + WS_SLOC) + (size_t)uidx * NSEG * 16384; float* dtotb = (float*)(F.ws + WS_DTOT) + (size_t)uidx * NSEG * 128;
    unsigned* cnt = (unsigned*)(F.ws + WS_CTL) + CW_LINC + 64 * ((2 * layer + F.dry) * 32 + uidx);
    pass1<DK, HG>(F, b, h, n0, nc, slocb + (size_t)seg * 16384, dtotb + seg * 128);
    asm volatile("s_waitcnt vmcnt(0)" ::: "memory");
    __syncthreads();
    if (F.tid == 0) { __builtin_amdgcn_fence(__ATOMIC_RELEASE, "agent"); asm volatile("s_waitcnt vmcnt(0)" ::: "memory"); (void)xb_add(cnt, 1u);
        if (seg > 0) { unsigned sp = 0; while (xb_ld(cnt) < (unsigned)NSEG) { __builtin_amdgcn_s_sleep(2); if (++sp > (1u << 22)) break; }
            __builtin_amdgcn_fence(__ATOMIC_ACQUIRE, "agent"); asm volatile("s_waitcnt vmcnt(0)" ::: "memory"); } }
    __syncthreads();
    constexpr int QS = DK * 2 + 16, VSt = 320, QB = 64 * QS, VB = 64 * VSt, CB = DK * 4, BUFB = 2 * QB + VB + CB, XCO = BUFB, SSO = XCO + 32768, ONO = SSO + 1024, NI = DK / 32, NO = NI / 2, QCH = DK / 8;
    static_assert(ONO + 512 <= RING_BYTES, "lin LDS");
    constexpr int NQC = 64 * QCH, NLD = (2 * NQC + 1024) / NTHREADS; static_assert(NQC % NTHREADS == 0, "staging regions");
    bf16* Ym = (bf16*)(F.ws + WS_YM); const float* c1g = (const float*)(F.ws + WS_C12);
    const int tid = F.tid, lane = F.lane, wave = F.wave, j = wave & 3, th = wave >> 2, r32 = lane & 31, hi = lane >> 5;
    const int cq = (HG ? C_HQ : C_GQ) + h * DK, ck = (HG ? C_HF : C_GK) + h * DK, cv = (HG ? C_HI : C_GV) + h * 128, cg = (HG ? C_HG : C_GR) + h * 128, cc = (HG ? 256 : 0) + h * DK;
    LAS unsigned char* lds = F.lds;
    unsigned gsrc[NLD]; int ldst[NLD];
#pragma unroll
    for (int k = 0; k < NLD; ++k) { const int reg = (NTHREADS * k) / NQC;
        if (reg < 2) { const int e2 = tid + NTHREADS * k - reg * NQC, r = e2 / QCH, c = e2 % QCH; gsrc[k] = (unsigned)(r * YW + (reg == 0 ? cq : ck) + 8 * c); ldst[k] = reg * QB + r * QS + 16 * c; }
        else { const int e3 = tid + NTHREADS * k - 2 * NQC, r = e3 >> 4, c = e3 & 15; gsrc[k] = (unsigned)(r * YW + cv + 8 * c); ldst[k] = 2 * QB + r * VSt + 16 * c; } }
    const size_t rowb = (size_t)b * LP;
    if (tid < 128) ((LAS float*)(lds + ONO))[tid] = (inptr(HG ? 14 : 12) + layer * 128)[tid];
    float S[NO][16];
#pragma unroll
    for (int i = 0; i < NO; ++i)
#pragma unroll
        for (int r = 0; r < 16; ++r) S[i][r] = 0.f;
#pragma unroll 1
    for (int g = 0; g < seg; ++g) {
#pragma unroll
        for (int ii = 0; ii < NO; ++ii) { const int i = th + 2 * ii;
#pragma unroll
            for (int g4 = 0; g4 < 4; ++g4) { const f32x4 dd = *(const GAS f32x4*)gp(dtotb + g * 128 + 32 * i + 8 * g4 + 4 * hi);
#pragma unroll
                for (int e = 0; e < 4; ++e) { const int r = 4 * g4 + e; S[ii][r] = dd[e] * S[ii][r] + *(const GAS float*)gp(slocb + (size_t)g * 16384 + ((i * 4 + j) * 16 + r) * 64 + lane); } } } }
    { const size_t ro = (rowb + 64 * n0) * YW;
#pragma unroll
      for (int k = 0; k < NLD; ++k) { const u32x4 v = *(const GAS u32x4*)gp(Ym + ro + gsrc[k]); *(LAS u32x4*)(lds + ldst[k]) = v; }
      if (tid < DK / 4) { const f32x4 cst = *(const GAS f32x4*)gp(c1g + (size_t)(b * NCHUNK + n0) * 768 + cc + 4 * tid); *(LAS f32x4*)(lds + 2 * QB + VB + 16 * tid) = cst; } }
    __syncthreads();
    const LAS unsigned char* qt = lds; const LAS unsigned char* kt = qt + QB; const LAS unsigned char* vt = kt + QB; const LAS float* c1l = (const LAS float*)(vt + VB);
    const int trq = (lane & 15) >> 2, trc = (16 * ((lane >> 4) & 1) + 4 * (lane & 3)) * 2;
    for (int n = n0; n < nend; ++n) {
        const int nn = n + 1 < nend ? n + 1 : n; const size_t ron = (rowb + 64 * nn) * YW;
        u32x4 st[NLD];
#pragma unroll
        for (int k = 0; k < NLD; ++k) st[k] = *(const GAS u32x4*)gp(Ym + ron + gsrc[k]);
        const f32x4 cst = *(const GAS f32x4*)gp(c1g + (size_t)(b * NCHUNK + nn) * 768 + cc + 4 * (tid & (DK / 4 - 1)));
        bf16* yrow = Ym + (rowb + 64 * n + 32 * th + r32) * YW;
        u32x2 gt[4];
#pragma unroll
        for (int g4 = 0; g4 < 4; ++g4) gt[g4] = *(const GAS u32x2*)gp(yrow + cg + 32 * j + 8 * g4 + 4 * hi);
        f32x16 o = {};
#pragma unroll
        for (int jb = 0; jb < 2; ++jb) { f32x16 AT = {};
#pragma unroll
            for (int ks = 0; ks < DK / 16; ++ks) { const bf16x8 bq = *(const LAS bf16x8*)(qt + (32 * th + r32) * QS + 32 * ks + 16 * hi);
                const bf16x8 ak = *(const LAS bf16x8*)(kt + (32 * jb + r32) * QS + 32 * ks + 16 * hi);
                AT = __builtin_amdgcn_mfma_f32_32x32x16_bf16(ak, bq, AT, 0, 0, 0); }
            int tq = 32 * th + r32 - 32 * jb;
            asm volatile("" : "+v"(tq));
#pragma unroll
            for (int r = 0; r < 16; ++r) AT[r] = (crow(r, hi) > tq) ? 0.f : AT[r];
#pragma unroll
            for (int sp = 0; sp < 2; ++sp) { u32x4 w; w.x = cvtpk(AT[8 * sp], AT[8 * sp + 1]); w.y = cvtpk(AT[8 * sp + 2], AT[8 * sp + 3]); w.z = cvtpk(AT[8 * sp + 4], AT[8 * sp + 5]); w.w = cvtpk(AT[8 * sp + 6], AT[8 * sp + 7]);
                const LAS unsigned char* vp = vt + (32 * jb + 16 * sp + 4 * hi + trq) * VSt + 64 * j + trc;
                const s16x4 lo = vtr(vp), h4 = vtr(vp + 8 * VSt);
                o = __builtin_amdgcn_mfma_f32_32x32x16_bf16((bf16x8){lo[0], lo[1], lo[2], lo[3], h4[0], h4[1], h4[2], h4[3]}, __builtin_bit_cast(bf16x8, w), o, 0, 0, 0); }
            __builtin_amdgcn_sched_barrier(0); }
        f32x16 op = {};
#pragma unroll
        for (int ii = 0; ii < NO; ++ii) { const int i = th + 2 * ii;
#pragma unroll
            for (int g4 = 0; g4 < 4; ++g4) { const f32x4 dc = *(const LAS f32x4*)(c1l + 32 * i + 8 * g4 + 4 * hi);
#pragma unroll
                for (int e = 0; e < 4; ++e) S[ii][4 * g4 + e] *= dc[e]; }
#pragma unroll
            for (int sp = 0; sp < 2; ++sp) { u32x4 w; w.x = cvtpk(S[ii][8 * sp], S[ii][8 * sp + 1]); w.y = cvtpk(S[ii][8 * sp + 2], S[ii][8 * sp + 3]); w.z = cvtpk(S[ii][8 * sp + 4], S[ii][8 * sp + 5]); w.w = cvtpk(S[ii][8 * sp + 6], S[ii][8 * sp + 7]);
                const LAS unsigned char* qo_ = qt + (32 * th + r32) * QS + (32 * i + 16 * sp + 4 * hi) * 2; const LAS unsigned char* qp_ = qt + (32 * (th ^ 1) + r32) * QS + (32 * i + 16 * sp + 4 * hi) * 2;
                const u32x2 b0 = *(const LAS u32x2*)qo_, b1 = *(const LAS u32x2*)(qo_ + 16), c0 = *(const LAS u32x2*)qp_, c1 = *(const LAS u32x2*)(qp_ + 16);
                o = __builtin_amdgcn_mfma_f32_32x32x16_bf16(__builtin_bit_cast(bf16x8, w), __builtin_bit_cast(bf16x8, (u32x4){b0.x, b0.y, b1.x, b1.y}), o, 0, 0, 0);
                op = __builtin_amdgcn_mfma_f32_32x32x16_bf16(__builtin_bit_cast(bf16x8, w), __builtin_bit_cast(bf16x8, (u32x4){c0.x, c0.y, c1.x, c1.y}), op, 0, 0, 0); }
            f32x16 T = {};
#pragma unroll
            for (int s_ = 0; s_ < 4; ++s_) { const LAS unsigned char* kp = kt + (16 * s_ + 8 * hi + trq) * QS + 64 * i + trc; const LAS unsigned char* vp = vt + (16 * s_ + 8 * hi + trq) * VSt + 64 * j + trc;
                const s16x4 ka = vtr(kp), kb2 = vtr(kp + 4 * QS), va = vtr(vp), vb2 = vtr(vp + 4 * VSt);
                T = __builtin_amdgcn_mfma_f32_32x32x16_bf16((bf16x8){ka[0], ka[1], ka[2], ka[3], kb2[0], kb2[1], kb2[2], kb2[3]}, (bf16x8){va[0], va[1], va[2], va[3], vb2[0], vb2[1], vb2[2], vb2[3]}, T, 0, 0, 0); }
#pragma unroll
            for (int r = 0; r < 16; ++r) S[ii][r] += T[r];
            __builtin_amdgcn_sched_barrier(0); }
        { LAS float* xo = (LAS float*)(lds + XCO) + wave * 1024 + lane;
#pragma unroll
          for (int r = 0; r < 16; ++r) xo[64 * r] = op[r]; }
        __syncthreads();
        { const LAS float* xi = (const LAS float*)(lds + XCO) + (wave ^ 4) * 1024 + lane;
#pragma unroll
          for (int r = 0; r < 16; ++r) o[r] += xi[64 * r]; }
        float ssq = 0.f;
#pragma unroll
        for (int r = 0; r < 16; ++r) ssq += o[r] * o[r];
        ssq = xhalf_sum(ssq);
        LAS float* ssb = (LAS float*)(lds + SSO);
        if (hi == 0) ssb[(th * 4 + j) * 32 + r32] = ssq;
#pragma unroll
        for (int k = 0; k < NLD; ++k) *(LAS u32x4*)(lds + ldst[k]) = st[k];
        if (tid < DK / 4) *(LAS f32x4*)(lds + 2 * QB + VB + 16 * tid) = cst;
        __syncthreads();
        const float tot = ssb[(th * 4 + 0) * 32 + r32] + ssb[(th * 4 + 1) * 32 + r32] + ssb[(th * 4 + 2) * 32 + r32] + ssb[(th * 4 + 3) * 32 + r32];
        const float rstd = frsq(tot * (1.f / 128.f) + EPS);
#pragma unroll
        for (int g4 = 0; g4 < 4; ++g4) { const f32x4 on = *(const LAS f32x4*)(lds + ONO + (32 * j + 8 * g4 + 4 * hi) * 4);
            const float v0 = o[4 * g4] * rstd * on[0] * siluf_(bflo(gt[g4].x)), v1 = o[4 * g4 + 1] * rstd * on[1] * siluf_(bfhi(gt[g4].x));
            const float v2 = o[4 * g4 + 2] * rstd * on[2] * siluf_(bflo(gt[g4].y)), v3 = o[4 * g4 + 3] * rstd * on[3] * siluf_(bfhi(gt[g4].y));
            u32x2 w; w.x = cvtpk(v0, v1); w.y = cvtpk(v2, v3); if (!F.dry) *(GAS u32x2*)gpw(yrow + cv + 32 * j + 8 * g4 + 4 * hi) = w; }
    }
    __syncthreads();
}
}
__device__ __forceinline__ void phase_linattn(const Frame& F, int layer) {
    if (F.bid < 32 * lin::NSEG) { const int seg = F.bid >> 5, u = F.bid & 31, br = u >> 4, b = (u >> 2) & 3, h = u & 3;
        if (br == 0) lin::unit<64, false>(F, layer, b, h, seg, u); else lin::unit<128, true>(F, layer, b, h, seg, u); }
}

__device__ __forceinline__ void phase_route(const Frame& F, const float* gain) {
    const bf16* H = (const bf16*)(F.ws + WS_H); const float* wr_ = inptr(23); const float* br_ = inptr(24);
    int* asg_e = (int*)(F.ws + WS_SMALL + SM_ASG_E); int* asg_i = (int*)(F.ws + WS_SMALL + SM_ASG_I); float* asg_w = (float*)(F.ws + WS_SMALL + SM_ASG_W);
    unsigned* ctl = (unsigned*)(F.ws + WS_CTL);
    f32x4 wa[4][4], wc[4][4];
#pragma unroll
    for (int j = 0; j < 4; ++j) { const f32x4 g = gld<f32x4>((const f32x4*)gain + F.lane + 64 * j); const f32x4* w0 = (const f32x4*)(wr_ + (size_t)(4 * (F.lane + 64 * j)) * 8);
#pragma unroll
        for (int kk = 0; kk < 4; ++kk) { wa[j][kk] = gld<f32x4>(w0 + 2 * kk) * g[kk]; wc[j][kk] = gld<f32x4>(w0 + 2 * kk + 1) * g[kk]; } }
    float brr[8];
#pragma unroll
    for (int e = 0; e < 8; ++e) brr[e] = gld<float>(br_ + e);
    constexpr int NT = BATCH * SEQ;
    int me1 = 0, me2 = 0, mt = -1, kit = 0; float mw1 = 0.f;
    u32x2 rw[4][4];
    const int npw_ = (NT + F.NGW - 1) / F.NGW, tw0 = F.gw * npw_, tw1 = (tw0 + npw_) < NT ? (tw0 + npw_) : NT;
#pragma unroll
    for (int q = 0; q < 4; ++q) { const int tq = tw0 + q < tw1 ? tw0 + q : tw0, b = tq / SEQ, r = b * LP + 128 + (tq - b * SEQ);
#pragma unroll
        for (int j = 0; j < 4; ++j) rw[q][j] = *(const GAS u32x2*)gp((const u32x2*)(H + (size_t)r * D) + F.lane + 64 * j); }
    for (int t0 = tw0; t0 < tw1; t0 += 4)
#pragma unroll
    for (int q = 0; q < 4; ++q) { const int t = t0 + q; if (t >= tw1) break;
        f32x4 v[4];
#pragma unroll
        for (int j = 0; j < 4; ++j) { const u32x2 w = rw[q][j]; v[j] = (f32x4){bflo(w.x), bfhi(w.x), bflo(w.y), bfhi(w.y)}; }
        { const int tn = t + 4 < tw1 ? t + 4 : t, b = tn / SEQ, r = b * LP + 128 + (tn - b * SEQ);
#pragma unroll
          for (int j = 0; j < 4; ++j) rw[q][j] = *(const GAS u32x2*)gp((const u32x2*)(H + (size_t)r * D) + F.lane + 64 * j); }
        const float rstd = row_rstd(F, v);
        float lg[8];
#pragma unroll
        for (int e = 0; e < 8; ++e) lg[e] = 0.f;
#pragma unroll
        for (int j = 0; j < 4; ++j) {
#pragma unroll
            for (int kk = 0; kk < 4; ++kk) { const float uu = v[j][kk] * rstd; const f32x4 a = wa[j][kk], c = wc[j][kk];
                lg[0] += uu * a.x; lg[1] += uu * a.y; lg[2] += uu * a.z; lg[3] += uu * a.w; lg[4] += uu * c.x; lg[5] += uu * c.y; lg[6] += uu * c.z; lg[7] += uu * c.w; } }
#pragma unroll
        for (int e = 0; e < 8; ++e) lg[e] = wave_sum(F.lane, lg[e]) + brr[e];
        int e1 = 0; float v1 = lg[0];
#pragma unroll
        for (int e = 1; e < 8; ++e) if (lg[e] > v1) { v1 = lg[e]; e1 = e; }
        int e2 = -1; float v2 = -INFINITY;
#pragma unroll
        for (int e = 0; e < 8; ++e) if (e != e1 && lg[e] > v2) { v2 = lg[e]; e2 = e; }
        const float w1 = 1.f / (1.f + __expf(v2 - v1)), w2 = 1.f - w1;
        if (F.lane == kit) { me1 = e1; me2 = e2; mw1 = w1; mt = t; }
        ++kit; (void)w2;
    }
    const int npw = (NT + F.NGW - 1) / F.NGW, K = NWAVES * npw;
    LAS int* le = (LAS int*)F.lds; LAS int* lt = le + 1024; LAS float* lw = (LAS float*)(le + 1536); LAS unsigned* lbase = (LAS unsigned*)(le + 2048);
    __syncthreads();
    if (F.lane < npw) { const int k = F.wave * npw + F.lane; le[k] = mt >= 0 ? me1 : -1; le[512 + k] = mt >= 0 ? me2 : -1; lt[k] = mt; lw[k] = mw1; }
    __syncthreads();
    int my_e[2] = {-1, -1}, my_r[2] = {0, 0}, my_k[2] = {0, 0};
#pragma unroll
    for (int q = 0; q < 2; ++q) { const int x = F.tid + q * NTHREADS; if (x < 2 * K) { const int rk = x / K, k = x - rk * K; const int e = le[rk * 512 + k]; int cnt = 0, rnk = 0;
            for (int k2 = 0; k2 < K; ++k2) { const int ee = le[rk * 512 + k2]; cnt += (ee == e) ? 1 : 0; rnk += (ee == e && k2 < k) ? 1 : 0; }
            my_e[q] = e; my_r[q] = rnk; my_k[q] = x;
            if (e >= 0 && rnk == 0 && !F.dry) lbase[rk * 8 + e] = atomicAdd(ctl + CW_CNT + 64 * (rk * 8 + e), (unsigned)cnt); } }
    __syncthreads();
#pragma unroll
    for (int q = 0; q < 2; ++q) if (my_e[q] >= 0 && !F.dry) { const int x = my_k[q], rk = x / K, k = x - rk * K, t = lt[k]; const float w1 = lw[k];
        asg_e[rk * 32768 + t] = my_e[q]; asg_i[rk * 32768 + t] = (int)(lbase[rk * 8 + my_e[q]] + (unsigned)my_r[q]); asg_w[rk * 32768 + t] = rk ? 1.f - w1 : w1; }
    __syncthreads();
}
__device__ __forceinline__ void phase_scatter(const Frame& F, const float* gain) {
    const bf16* H = (const bf16*)(F.ws + WS_H);
    const int* asg_e = (const int*)(F.ws + WS_SMALL + SM_ASG_E); const int* asg_i = (const int*)(F.ws + WS_SMALL + SM_ASG_I); const float* asg_w = (const float*)(F.ws + WS_SMALL + SM_ASG_W);
    int* slot_tok = (int*)(F.ws + WS_SMALL + SM_SLOT_TOK); float* slot_w = (float*)(F.ws + WS_SMALL + SM_SLOT_W);
    int* tile_e = (int*)(F.ws + WS_SMALL + SM_TILE_E); int* ntl = (int*)(F.ws + WS_SMALL + SM_NT);
    unsigned* ctl = (unsigned*)(F.ws + WS_CTL);
    unsigned char* xb[2] = {F.ws + WS_XB, F.ws + WS_XB + (size_t)MOE_ROWS * D};
    LAS int* tb = (LAS int*)(F.lds + TAB_OFF);
    if (F.tid < 16) tb[16 + F.tid] = (int)xb_ld(ctl + CW_CNT + 64 * F.tid);
    __syncthreads();
    if (F.tid == 0) {
#pragma unroll 1
        for (int rk = 0; rk < 2; ++rk) { int t = 0;
#pragma unroll 1
            for (int e = 0; e < 8; ++e) { tb[rk * 8 + e] = t; const int nt_ = (tb[16 + rk * 8 + e] + 255) >> 8;
                if (F.bid == 0) {
#pragma unroll 1
                    for (int q = 0; q < nt_; ++q) tile_e[rk * 256 + t + q] = e; }
                t += nt_; }
            if (F.bid == 0) ntl[rk] = t; } }
    __syncthreads();
    for (int g = 0; g < 16; ++g) { const int rk = g >> 3, cnt = tb[16 + g], base = tb[g] * 256, end = base + ((cnt + 255) >> 8) * 256;
        for (int s = base + cnt + F.gw; s < end; s += F.NGW) { if (F.lane == 0) { slot_tok[rk * MOE_ROWS + s] = -1; slot_w[rk * MOE_ROWS + s] = 0.f; }
            u32x4* xr = (u32x4*)(xb[rk] + (size_t)s * D); xr[F.lane] = zero4(); } }
    constexpr int NT = BATCH * SEQ;
    const int npw = (NT + F.NGW - 1) / F.NGW, tw0 = F.gw * npw, tw1 = (tw0 + npw) < NT ? (tw0 + npw) : NT;
    int ae[2], ai[2]; float aw[2];
    { const int tl = tw0 + F.lane < tw1 ? tw0 + F.lane : (tw0 < NT ? tw0 : 0);
#pragma unroll
      for (int rk = 0; rk < 2; ++rk) { ae[rk] = gld<int>(asg_e + rk * 32768 + tl); ai[rk] = gld<int>(asg_i + rk * 32768 + tl); aw[rk] = gld<float>(asg_w + rk * 32768 + tl); } }
    f32x4 gn[4];
#pragma unroll
    for (int j = 0; j < 4; ++j) gn[j] = gld<f32x4>((const f32x4*)gain + F.lane + 64 * j);
    u32x2 rw[4][4];
#pragma unroll
    for (int q = 0; q < 4; ++q) { const int tq = tw0 + q < tw1 ? tw0 + q : (tw0 < NT ? tw0 : 0), b = tq / SEQ, r = b * LP + 128 + (tq - b * SEQ);
#pragma unroll
        for (int j = 0; j < 4; ++j) rw[q][j] = *(const GAS u32x2*)gp((const u32x2*)(H + (size_t)r * D) + F.lane + 64 * j); }
    for (int t0 = tw0; t0 < tw1; t0 += 4)
#pragma unroll
    for (int q = 0; q < 4; ++q) { const int t = t0 + q; if (t >= tw1) break;
        const int b = t / SEQ, r = b * LP + 128 + (t - b * SEQ), k = t - tw0;
        f32x4 v[4];
#pragma unroll
        for (int j = 0; j < 4; ++j) { const u32x2 w = rw[q][j]; v[j] = (f32x4){bflo(w.x), bfhi(w.x), bflo(w.y), bfhi(w.y)}; }
        { const int tn = t + 4 < tw1 ? t + 4 : t, bn = tn / SEQ, rn = bn * LP + 128 + (tn - bn * SEQ);
#pragma unroll
          for (int j = 0; j < 4; ++j) rw[q][j] = *(const GAS u32x2*)gp((const u32x2*)(H + (size_t)rn * D) + F.lane + 64 * j); }
        const float rstd = row_rstd(F, v);
#pragma unroll
        for (int rk = 0; rk < 2; ++rk) { const int e = __builtin_amdgcn_readlane(ae[rk], k), s = tb[rk * 8 + e] * 256 + __builtin_amdgcn_readlane(ai[rk], k);
            const float wgt = __builtin_bit_cast(float, __builtin_amdgcn_readlane(__builtin_bit_cast(int, aw[rk]), k)); const float sc = rstd * XB_SCALE;
            unsigned* o4 = (unsigned*)(xb[rk] + (size_t)s * D) + F.lane;
#pragma unroll
            for (int j = 0; j < 4; ++j) gst<unsigned>(o4 + 64 * j, pg8::fp8x4((f32x4){v[j].x * sc * gn[j].x, v[j].y * sc * gn[j].y, v[j].z * sc * gn[j].z, v[j].w * sc * gn[j].w}));
            if (F.lane == 0) { gst<int>(slot_tok + rk * MOE_ROWS + s, r); gst<float>(slot_w + rk * MOE_ROWS + s, wgt); } }
    }
}
__device__ __forceinline__ void convert_expert_weights(const Frame& F) {
    unsigned char* GU = F.ws + WS_WEXP; unsigned char* DT = F.ws + WS_WEXP + (size_t)8 * 7168 * 1024;
    LAS float* scr = (LAS float*)(F.lds + F.wave * 16384);
    for (int it = F.gw; it < NEXP * 3 * 1792; it += F.NGW) {
        const int e = it / 5376, r = it - e * 5376, m = r / 1792, t = r - m * 1792;
        if (m < 2) { const int kb = t / 112, n0 = (t % 112) * 32; const float* W = inptr(m == 0 ? 25 : 26) + (size_t)e * D * DEXP;
            transpose_tile<true>(W, (size_t)DEXP, kb * 64, n0, 32, (bf16*)(GU + (size_t)e * 7168 * 1024), (size_t)D, 256 * (n0 / 128) + (n0 % 128) + 128 * m, kb * 64, nullptr, WU_SCALE, scr, F.lane); }
        else { const int kb = t / 32, n0 = (t % 32) * 32; const float* W = inptr(27) + (size_t)e * DEXP * D;
            transpose_tile<true>(W, (size_t)D, kb * 64, n0, 32, (bf16*)(DT + (size_t)e * 1024 * DEXP), (size_t)DEXP, n0, kb * 64, nullptr, WD_SCALE, scr, F.lane); }
    }
}
__device__ __forceinline__ void convert_ffn_weights(const Frame& F) {
    bf16* GU = (bf16*)(F.ws + WS_WFF); bf16* DT = GU + (size_t)2 * DFF * D;
    conv_matrix<1>(F, inptr(20), D, DFF, DFF, 0, GU, D, 0, nullptr);
    conv_matrix<1>(F, inptr(21), D, DFF, DFF, 0, GU, D, 128, nullptr);
    conv_matrix<0>(F, inptr(22), DFF, D, D, 0, DT, DFF, 0, nullptr);
}

namespace sk {
constexpr int CW_ERR = 32768;
constexpr size_t WS_DBG = 110 * MiB;
template <int NACC>
__device__ __forceinline__ void dot16(const bf16* A, size_t lda, const bf16* W0, const bf16* W1, size_t ldb, int nk, int lane, f32x4 (&acc)[NACC]) {
    const int i = lane & 15, kq = lane >> 4;
    const bf16* ap = A + (size_t)i * lda + 8 * kq; const bf16* w0 = W0 + (size_t)i * ldb + 8 * kq; const bf16* w1 = W1 + (size_t)i * ldb + 8 * kq;
#pragma unroll 1
    for (int s = 0; s < nk; s += 4) {
        bf16x8 a[4], b0[4], b1[4];
#pragma unroll
        for (int q = 0; q < 4; ++q) { const int ss = (s + q < nk) ? s + q : s;
            a[q] = *(const GAS bf16x8*)gp((const bf16x8*)(ap + 32 * ss)); b0[q] = *(const GAS bf16x8*)gp((const bf16x8*)(w0 + 32 * ss));
            if (NACC == 2) b1[q] = *(const GAS bf16x8*)gp((const bf16x8*)(w1 + 32 * ss)); }
#pragma unroll
        for (int q = 0; q < 4; ++q) if (s + q < nk) { acc[0] = __builtin_amdgcn_mfma_f32_16x16x32_bf16(b0[q], a[q], acc[0], 0, 0, 0);
            if (NACC == 2) acc[1] = __builtin_amdgcn_mfma_f32_16x16x32_bf16(b1[q], a[q], acc[1], 0, 0, 0); }
    }
}
template <int NACC>
__device__ __forceinline__ void reduce8(const Frame& F, f32x4 (&acc)[NACC]) {
    LAS f32x4* red = (LAS f32x4*)F.lds;
#pragma unroll
    for (int a = 0; a < NACC; ++a) red[(a * 8 + F.wave) * 64 + F.lane] = acc[a];
    __syncthreads();
    if (F.wave == 0) {
#pragma unroll
        for (int a = 0; a < NACC; ++a) { f32x4 s = red[(a * 8) * 64 + F.lane];
#pragma unroll
            for (int w = 1; w < 8; ++w) s += red[(a * 8 + w) * 64 + F.lane];
            acc[a] = s; } }
}
struct Cnt { unsigned n, e; };
__device__ __forceinline__ void chk(Cnt& C, float mine, float ref, float rel, float ab) {
#ifdef SK_EXACT
    rel = 0.f; ab = 0.f;
#endif
    C.n += 1u; if (!(fabsf(mine - ref) <= rel * fmaxf(fabsf(mine), fabsf(ref)) + ab)) C.e += 1u;
}
__device__ __forceinline__ void flush(const Frame& F, const Cnt& C) {
    unsigned* ctl = (unsigned*)(F.ws + WS_CTL);
    if (C.n) atomicAdd(ctl + CW_ERR + 64, C.n);
    if (C.e) atomicAdd(ctl + CW_ERR, C.e);
}
__device__ __forceinline__ u32x2 pack4(const f32x4 v) { u32x2 w; w.x = pg8::cvt_pk_bf16(v[0], v[1]); w.y = pg8::cvt_pk_bf16(v[2], v[3]); return w; }
template <bool CHECK>
__device__ __forceinline__ void put4(const Frame& F, Cnt& C, bf16* dst, size_t rs, const f32x4 v, int nb, float rel, float ab) {
    const u32x2 w = pack4(v);
#pragma unroll
    for (int b = 0; b < 4; ++b) if (b < nb) { u32x2* p = (u32x2*)(dst + (size_t)b * LP * rs);
        if (CHECK) { const u32x2 m = gld<u32x2>(p); chk(C, bflo(w.x), bflo(m.x), rel, ab); chk(C, bfhi(w.x), bfhi(m.x), rel, ab); chk(C, bflo(w.y), bflo(m.y), rel, ab); chk(C, bfhi(w.y), bfhi(m.y), rel, ab); }
        else if (!F.dry) gst<u32x2>(p, w); }
}
template <bool CHECK>
__device__ __forceinline__ void inproj(const Frame& F) { Cnt C{0u, 0u};
    const bf16* U = (const bf16*)(F.dout + DO_U) + (size_t)PADL * D; const bf16* W = (const bf16*)(F.ws + WS_WL + WL_IN);
    bf16* Ym = (bf16*)(F.ws + WS_YM); unsigned char* Yg = F.ws + WS_YG;
    if (!CHECK && !F.dry) { const u32x4 z4 = zero4();
        for (int idx = F.bid * NTHREADS + F.tid; idx < BATCH * PADL * (YW / 8); idx += F.G * NTHREADS) { const int row = idx / (YW / 8), c8 = idx % (YW / 8), b = row / PADL, p = row % PADL;
            gst<u32x4>(Ym + ((size_t)b * LP + p) * YW + 8 * c8, z4); } }
    for (int g = F.bid; g < 251 + 192; g += F.G) {
        const int wrow = g < 251 ? 16 * g : YW + 16 * (g - 251);
        f32x4 acc[1] = {(f32x4){0.f, 0.f, 0.f, 0.f}};
        dot16<1>(U + 128 * F.wave, D, W + (size_t)wrow * D + 128 * F.wave, W, D, 4, F.lane, acc);
        reduce8<1>(F, acc);
        if (F.wave == 0) { const int i = F.lane & 15, c = 4 * (F.lane >> 4);
            if (g < 251) put4<CHECK>(F, C, Ym + (size_t)(PADL + i) * YW + 16 * g + c, YW, acc[0], 4, 0.01f, 1e-3f);
            else { const unsigned w = pg8::q8(acc[0][0]) | (pg8::q8(acc[0][1]) << 8) | (pg8::q8(acc[0][2]) << 16) | (pg8::q8(acc[0][3]) << 24);
                unsigned* p = (unsigned*)(Yg + (size_t)(PADL + i) * NGATE + 16 * (g - 251) + c);
                if (CHECK) { const unsigned m = *p;
#pragma unroll
                    for (int e = 0; e < 4; ++e) chk(C, (float)((w >> (8 * e)) & 255u), (float)((m >> (8 * e)) & 255u), 0.f, 1.f); }
                else if (!F.dry) *p = w; } }
        __syncthreads();
    }
    if (CHECK) flush(F, C);
}
template <bool CHECK>
__device__ __forceinline__ void mlaprep(const Frame& F) { Cnt C{0u, 0u};
    const bf16* Ym0 = (const bf16*)(F.ws + WS_YM) + (size_t)PADL * YW; const bf16* W = (const bf16*)(F.ws + WS_WL + WL_UQKV);
    bf16* Q = (bf16*)(F.dout + DO_Q); bf16* Kb = (bf16*)(F.dout + DO_K); bf16* V = (bf16*)(F.ws + WS_V);
    if (!CHECK && !F.dry) { const u32x4 z4 = zero4();
        for (int idx = F.bid * NTHREADS + F.tid; idx < BATCH * PADL * 256; idx += F.G * NTHREADS) { const int row = idx >> 8, c = idx & 255, b = row / PADL, p = row % PADL; const size_t r = (size_t)b * LP + p;
            if (c < 96) gst<u32x4>(Q + r * QKW + 8 * c, z4); else if (c < 192) gst<u32x4>(Kb + r * QKW + 8 * (c - 96), z4); else gst<u32x4>(V + r * VW + 8 * (c - 192), z4); } }
    for (int g = F.bid; g < 48 + 64; g += F.G) {
        const bool kv = g >= 48; const int n0 = kv ? 16 * (g - 48) : 16 * g;
        f32x4 acc[1] = {(f32x4){0.f, 0.f, 0.f, 0.f}};
        dot16<1>(Ym0 + (kv ? C_DKV : C_DQ) + 32 * F.wave, YW, W + (size_t)((kv ? 768 : 0) + n0) * 256 + 32 * F.wave, W, 256, 1, F.lane, acc);
        reduce8<1>(F, acc);
        if (F.wave == 0) { const int i = F.lane & 15, c = n0 + 4 * (F.lane >> 4); const size_t r = (size_t)(PADL + i);
            if (!kv) put4<CHECK>(F, C, Q + r * QKW + c, QKW, acc[0], 4, 0.01f, 1e-3f);
            else { const int hh = c >> 7, d = c & 127;
                if (d < 64) put4<CHECK>(F, C, Kb + r * QKW + hh * 96 + d, QKW, acc[0], 4, 0.01f, 1e-3f); else put4<CHECK>(F, C, V + r * VW + hh * 64 + d - 64, VW, acc[0], 4, 0.01f, 1e-3f); } }
        __syncthreads();
    }
    if (CHECK) flush(F, C);
}
template <bool CHECK>
__device__ __forceinline__ void mix(const Frame& F) { Cnt C{0u, 0u};
    const bf16* Ym0 = (const bf16*)(F.ws + WS_YM) + (size_t)PADL * YW; const bf16* O0 = (const bf16*)(F.ws + WS_O) + (size_t)PADL * 512; const unsigned char* Yg0 = F.ws + WS_YG + (size_t)PADL * NGATE;
    bf16* Mx = (bf16*)(F.dout + DO_MIX); unsigned char* wl = F.ws + WS_WL;
    const int w = F.wave, I = w < 4 ? 0 : (w < 6 ? 1 : 2);
    const bf16* A = I == 0 ? O0 + 128 * w : (I == 1 ? Ym0 + C_GV + 256 * (w - 4) : Ym0 + C_HI + 256 * (w - 6));
    const size_t lda = I == 0 ? 512 : YW, ldb = 512; const int nk = I == 0 ? 4 : 8;
    const bf16* Wb = I == 0 ? (const bf16*)(wl + WL_OM) + 128 * w : (I == 1 ? (const bf16*)(wl + WL_OG) + 256 * (w - 4) : (const bf16*)(wl + WL_OH) + 256 * (w - 6));
    for (int g = F.bid; g < 64; g += F.G) {
        f32x4 acc[1] = {(f32x4){0.f, 0.f, 0.f, 0.f}};
        dot16<1>(A, lda, Wb + (size_t)(16 * g) * ldb, Wb, ldb, nk, F.lane, acc);
        const int i = F.lane & 15, c = 16 * g + 4 * (F.lane >> 4);
        const unsigned gw = gld<unsigned>(Yg0 + (size_t)i * NGATE + I * 1024 + c); const float s = 1.f / 255.f;
        acc[0][0] *= (float)(gw & 255u) * s; acc[0][1] *= (float)((gw >> 8) & 255u) * s; acc[0][2] *= (float)((gw >> 16) & 255u) * s; acc[0][3] *= (float)(gw >> 24) * s;
        reduce8<1>(F, acc);
        if (F.wave == 0) put4<CHECK>(F, C, Mx + (size_t)(PADL + i) * D + c, D, acc[0], 1, 0.03f, 3e-3f);
        __syncthreads();
    }
    if (CHECK) flush(F, C);
}
template <bool CHECK>
__device__ __forceinline__ void resid(const Frame& F, const bf16* A0, size_t lda, const bf16* W, int K, const bf16* hold) { Cnt C{0u, 0u};
    bf16* H = (bf16*)(F.ws + WS_H); const int nk = K / 256, k0 = (K / 8) * F.wave;
    for (int g = F.bid; g < 64; g += F.G) {
        f32x4 acc[1] = {(f32x4){0.f, 0.f, 0.f, 0.f}};
        dot16<1>(A0 + k0, lda, W + (size_t)(16 * g) * K + k0, W, (size_t)K, nk, F.lane, acc);
        reduce8<1>(F, acc);
        if (F.wave == 0) { const int i = F.lane & 15, c = 16 * g + 4 * (F.lane >> 4);
            const u32x2 x = gld<u32x2>(hold + (size_t)i * D + c);
            const f32x4 v = acc[0] + (f32x4){bflo(x.x), bfhi(x.x), bflo(x.y), bfhi(x.y)};
            put4<CHECK>(F, C, H + (size_t)(PADL + i) * D + c, D, v, 4, 0.01f, 1e-3f); }
        __syncthreads();
    }
    if (CHECK) flush(F, C);
}
template <bool CHECK>
__device__ __forceinline__ void ffn_up(const Frame& F) { Cnt C{0u, 0u};
    const bf16* U = (const bf16*)(F.dout + DO_U) + (size_t)PADL * D; const bf16* GU = (const bf16*)(F.ws + WS_WFF); bf16* Hm = (bf16*)(F.ws + WS_HMID);
    for (int g = F.bid; g < DFF / 16; g += F.G) {
        const int hc0 = 16 * g, r0 = 256 * (hc0 >> 7) + (hc0 & 127);
        f32x4 acc[2] = {(f32x4){0.f, 0.f, 0.f, 0.f}, (f32x4){0.f, 0.f, 0.f, 0.f}};
        dot16<2>(U + 128 * F.wave, D, GU + (size_t)r0 * D + 128 * F.wave, GU + (size_t)(r0 + 128) * D + 128 * F.wave, D, 4, F.lane, acc);
        reduce8<2>(F, acc);
        if (F.wave == 0) { const int i = F.lane & 15, c = hc0 + 4 * (F.lane >> 4); f32x4 h;
#pragma unroll
            for (int e = 0; e < 4; ++e) { const float gq = acc[0][e], uq = acc[1][e]; h[e] = gq * frcp(1.f + __expf(-gq)) * uq; }
            put4<CHECK>(F, C, Hm + (size_t)(PADL + i) * DFF + c, DFF, h, 1, 0.02f, 1e-3f); }
        __syncthreads();
    }
    if (CHECK) flush(F, C);
}
}

#ifndef SK_ERR_MAX
#define SK_ERR_MAX 200u
#endif
#ifndef SKMODE
#define SKMODE 1
#endif
enum { OP_INIT = 0, OP_INPROJ, OP_MLAPREP, OP_ATTN, OP_LIN, OP_MIX0, OP_MIX1, OP_MIX2, OP_CONV, OP_WOUT, OP_NORM_FFN, OP_FFN_UP, OP_FFN_DOWN, OP_NEXT, OP_ROUTE, OP_SCATTER, OP_MOE_UP, OP_MOE_DOWN, OP_MLAFIX, OP_NOP, OP_MLAPREP2 };
#define SW(op, layer, rh) ((unsigned)(op) | ((unsigned)(layer) << 5) | ((unsigned)(rh) << 6))
#define SWDRY(op, layer, rh) (SW(op, layer, rh) | 256u)
#ifndef STEP_PROGRAM
#define STEP_PROGRAM \
    SW(OP_INIT, 0, 0), \
    SW(OP_INPROJ, 0, 0), SW(OP_MLAPREP, 0, 0), SW(OP_MLAPREP2, 0, 0), SW(OP_MLAFIX, 0, 0), SW(OP_ATTN, 0, 0), SW(OP_MIX0, 0, 0), SW(OP_MIX1, 0, 0), SW(OP_MIX2, 0, 0), SW(OP_CONV, 0, 0), SW(OP_WOUT, 0, 0), \
    SW(OP_NORM_FFN, 0, 0), SW(OP_FFN_UP, 0, 0), SW(OP_FFN_DOWN, 0, 0), SW(OP_NEXT, 0, 0), \
    SW(OP_INPROJ, 1, 0), SW(OP_MLAPREP, 1, 0), SW(OP_MLAPREP2, 1, 0), SW(OP_MLAFIX, 1, 0), SW(OP_ATTN, 1, 0), SW(OP_MIX0, 1, 0), SW(OP_MIX1, 1, 0), SW(OP_MIX2, 1, 0), SW(OP_CONV, 1, 0), SW(OP_WOUT, 1, 0), \
    SW(OP_ROUTE, 1, 0), SW(OP_SCATTER, 1, 0), \
    SW(OP_MOE_UP, 1, 0), SW(OP_MOE_DOWN, 1, 0), SW(OP_MOE_UP, 1, 1), SW(OP_MOE_DOWN, 1, 1)
#endif
__device__ __forceinline__ unsigned step_word(int st) {
    constexpr unsigned prog[] = {STEP_PROGRAM};
    unsigned w = 0;
#pragma unroll
    for (int i = 0; i < (int)(sizeof(prog) / sizeof(prog[0])); ++i) w = (st == i) ? prog[i] : w;
    return w;
}
constexpr unsigned step_prog_host[] = {STEP_PROGRAM};
constexpr int NSTEP = (int)(sizeof(step_prog_host) / sizeof(step_prog_host[0]));
__global__ void __launch_bounds__(NTHREADS, 2) fwd_kernel(Args args) {
    extern __shared__ __attribute__((aligned(16))) unsigned char lds_raw[];
    Frame F;
    F.lds = (LAS unsigned char*)lds_raw; F.ws = args.ws; F.dout = (unsigned char*)args.out;
    F.tid = threadIdx.x; F.lane = F.tid & 63; F.wave = __builtin_amdgcn_readfirstlane(F.tid >> 6);
    F.G = gridDim.x; F.bid = blockIdx.x; F.gw = F.bid * NWAVES + F.wave; F.NGW = F.G * NWAVES;
    volatile LAS unsigned* MISC = (volatile LAS unsigned*)(F.lds + MISC_OFF);
    for (int u = F.tid; u < (LDS_BYTES - LDSCTL_OFF) / 4; u += NTHREADS) ((LAS unsigned*)(F.lds + LDSCTL_OFF))[u] = 0u;
    __syncthreads();
    unsigned* ctl = (unsigned*)(F.ws + WS_CTL);
    XcdBarrier bar = xcd_barrier_post(ctl + CW_BAR, MISC + 8);
    const int wave0 = F.wave;
#pragma unroll 1
    for (int st = args.ph_lo; st < args.ph_hi; ++st) {
        { unsigned char* p_ = args.ws; asm volatile("" : "+s"(p_)); F.ws = p_; p_ = (unsigned char*)args.out; asm volatile("" : "+s"(p_)); F.dout = p_;
          int wv_ = wave0; asm volatile("" : "+s"(wv_)); int ln_; asm volatile("v_mbcnt_lo_u32_b32 %0, -1, 0\n\tv_mbcnt_hi_u32_b32 %0, -1, %0" : "=v"(ln_)); int tid_ = wv_ * 64 + ln_; int bid_ = blockIdx.x; asm volatile("" : "+s"(bid_)); int G_ = gridDim.x; asm volatile("" : "+s"(G_));
          unsigned lo_ = 0; asm volatile("" : "+s"(lo_));
          F.lds = (LAS unsigned char*)lds_raw + lo_; F.tid = tid_; F.lane = tid_ & 63; F.wave = __builtin_amdgcn_readfirstlane(tid_ >> 6); F.G = G_; F.bid = bid_; F.gw = bid_ * NWAVES + F.wave; F.NGW = G_ * NWAVES; }
        LAS unsigned char* ring = F.lds;
        int layer, op, rh = 0;
        { const unsigned pw = step_word(st); op = pw & 31; layer = (pw >> 5) & 1; rh = (pw >> 6) & 3; F.dry = (pw >> 8) & 1; }
        bool is_gemm = false, sync_after = true, fp8 = false;
        pg8::Gemm g{nullptr, nullptr, 0, 0, 0}; pg8::Order S{0, 0, 0, F.G, F.bid, 0, 0, 0, (const LAS int*)(F.lds + TAB_OFF), 0, 0}; pg8::Epi E{0, nullptr, nullptr, nullptr, nullptr, 0, 0, F.dry, 1.f, 0.f};
        unsigned char* wl = F.ws + WS_WL;
        constexpr int XM = (SKMODE == 1) ? 1 : 0;
#if SKMODE == 1
        if (op == OP_INPROJ) sk::inproj<false>(F);
        else if (op == OP_MLAPREP) sk::mlaprep<false>(F);
        else if (op == OP_MIX0 && layer == 0) sk::mix<false>(F);
        else if (op == OP_WOUT && layer == 0) sk::resid<false>(F, (const bf16*)(F.dout + DO_MIX) + (size_t)PADL * D, D, (const bf16*)(wl + WL_OUT), D, (const bf16*)(F.ws + WS_H) + (size_t)PADL * D);
        else if (op == OP_FFN_UP) sk::ffn_up<false>(F);
        else if (op == OP_FFN_DOWN) sk::resid<false>(F, (const bf16*)(F.ws + WS_HMID) + (size_t)PADL * DFF, DFF, (const bf16*)(F.ws + WS_WFF) + (size_t)2 * DFF * D, DFF, (const bf16*)(F.ws + WS_H) + (size_t)PADL * D);
#elif SKMODE == 2
        { bool did = true; const bf16* dbg = (const bf16*)(F.ws + sk::WS_DBG);
          if (op == OP_MLAPREP) sk::inproj<true>(F);
          else if (op == OP_MLAFIX) sk::mlaprep<true>(F);
          else if (op == OP_CONV && layer == 0) sk::mix<true>(F);
          else if (op == OP_NORM_FFN) sk::resid<true>(F, (const bf16*)(F.dout + DO_MIX) + (size_t)PADL * D, D, (const bf16*)(wl + WL_OUT), D, dbg);
          else if (op == OP_FFN_DOWN) sk::ffn_up<true>(F);
          else if (op == OP_NEXT) sk::resid<true>(F, (const bf16*)(F.ws + WS_HMID) + (size_t)PADL * DFF, DFF, (const bf16*)(F.ws + WS_WFF) + (size_t)2 * DFF * D, DFF, dbg);
          else did = false;
          if ((op == OP_CONV || op == OP_FFN_UP) && layer == 0 && F.bid == 0) {
              for (int i = F.tid; i < 16 * D / 8; i += NTHREADS) *((u32x4*)(F.ws + sk::WS_DBG) + i) = *((const u32x4*)((const bf16*)(F.ws + WS_H) + (size_t)PADL * D) + i); }
          if (did) xcd_barrier(bar); }
#endif
        switch (op) {
        case OP_INIT:
            convert_layer_weights(F, 0); phase_rope_table(F); phase_init_rows(F, inptr(2)); break;
        case OP_INPROJ:
            is_gemm = true; g = pg8::Gemm{(const bf16*)(F.dout + DO_U), (const bf16*)(wl + WL_IN), D, D, D}; S.nM = XM ? 128 : M / 256; S.xrow = XM; S.nN = 28;
            E.kind = pg8::EK_INPROJ; E.o0 = F.ws + WS_YM; E.o1 = F.ws + WS_YG; break;
        case OP_MLAPREP:
            is_gemm = true; sync_after = false; g = pg8::Gemm{(const bf16*)(F.ws + WS_YM) + C_DQ, (const bf16*)(wl + WL_UQKV), 256, YW, 256}; S.nM = XM ? 128 : M / 256; S.xrow = XM; S.nN = 3;
            E.kind = pg8::EK_MLA; E.o0 = F.dout + DO_Q; E.o1 = F.dout + DO_K; E.i0 = F.ws + WS_V; E.fin = 0; break;
        case OP_MLAPREP2:
            is_gemm = true; g = pg8::Gemm{(const bf16*)(F.ws + WS_YM) + C_DKV, (const bf16*)(wl + WL_UQKV) + 768 * 256, 256, YW, 256}; S.nM = XM ? 128 : M / 256; S.xrow = XM; S.nN = 4;
            E.kind = pg8::EK_MLA; E.o0 = F.dout + DO_Q; E.o1 = F.dout + DO_K; E.i0 = F.ws + WS_V; E.fin = 3; break;
        case OP_MLAFIX:
            if (F.wave < 4) { mla::fix(F, layer); phase_lin_prep(F, layer); } else { phase_lin_prep(F, layer); mla::fix(F, layer); } break;
        case OP_NOP: break;
        case OP_ATTN: phase_linattn(F, layer); att::phase(F, layer); break;
        case OP_LIN: phase_linattn(F, layer); break;
        case OP_MIX0:
            is_gemm = true; sync_after = false; g = pg8::Gemm{(const bf16*)(F.ws + WS_O), (const bf16*)(wl + WL_OM), 512, 512, 512}; S.nM = (XM || layer) ? 128 : M / 256; S.xrow = (XM || layer) ? 1 : 0; S.nN = 4;
            E.kind = pg8::EK_MIX0; E.o0 = F.dout + DO_MIX; E.i0 = F.ws + WS_YG; break;
        case OP_MIX1:
            is_gemm = true; sync_after = false; g = pg8::Gemm{(const bf16*)(F.ws + WS_YM) + C_GV, (const bf16*)(wl + WL_OG), 512, YW, 512}; S.nM = (XM || layer) ? 128 : M / 256; S.xrow = (XM || layer) ? 1 : 0; S.nN = 4;
            E.kind = pg8::EK_MIX1; E.o0 = F.dout + DO_MIX; E.i0 = F.ws + WS_YG; break;
        case OP_MIX2:
            is_gemm = true; g = pg8::Gemm{(const bf16*)(F.ws + WS_YM) + C_HI, (const bf16*)(wl + WL_OH), 512, YW, 512}; S.nM = (XM || layer) ? 128 : M / 256; S.xrow = (XM || layer) ? 1 : 0; S.nN = 4;
            E.kind = pg8::EK_MIX2; E.o0 = F.dout + DO_MIX; E.i0 = F.ws + WS_YG; break;
        case OP_CONV:
            sync_after = false; if (layer == 0) convert_ffn_weights(F); else convert_expert_weights(F); break;
        case OP_WOUT:
            is_gemm = true; g = pg8::Gemm{(const bf16*)(F.dout + DO_MIX), (const bf16*)(wl + WL_OUT), D, D, D}; S.nM = (XM || layer) ? 128 : M / 256; S.xrow = (XM || layer) ? 1 : 0; S.nN = 4;
            E.kind = pg8::EK_RESID; E.o0 = F.ws + WS_H; break;
        case OP_NORM_FFN: phase_norm_rows(F, inptr(19), (bf16*)(F.dout + DO_U)); break;
        case OP_FFN_UP:
            is_gemm = true; g = pg8::Gemm{(const bf16*)(F.dout + DO_U), (const bf16*)(F.ws + WS_WFF), D, D, D}; S.nM = XM ? 128 : M / 256; S.xrow = XM; S.nN = 22;
            E.kind = pg8::EK_SWIGLU; E.o0 = F.ws + WS_HMID; E.ldo = DFF; break;
        case OP_FFN_DOWN:
            is_gemm = true; g = pg8::Gemm{(const bf16*)(F.ws + WS_HMID), (const bf16*)(F.ws + WS_WFF) + (size_t)2 * DFF * D, DFF, DFF, DFF}; S.nM = XM ? 128 : M / 256; S.xrow = XM; S.nN = 4;
            E.kind = pg8::EK_RESID; E.o0 = F.ws + WS_H; break;
        case OP_NEXT:
            convert_layer_weights(F, 1); phase_norm_rows(F, inptr(2) + D, (bf16*)(F.dout + DO_U)); break;
        case OP_ROUTE: phase_route(F, inptr(19) + D); break;
        case OP_SCATTER: phase_scatter(F, inptr(19) + D); break;
        default: {
            const int rk = rh;
            const int* tile_e = (const int*)(F.ws + WS_SMALL + SM_TILE_E) + rk * 256; const int* ntl = (const int*)(F.ws + WS_SMALL + SM_NT);
            LAS int* te = (LAS int*)(F.lds + TAB_OFF);
            const int nt_ = __builtin_amdgcn_readfirstlane(__hip_atomic_load(ntl + rk, __ATOMIC_RELAXED, __HIP_MEMORY_SCOPE_AGENT));
            for (int i = F.tid; i < 256; i += NTHREADS) te[i] = __hip_atomic_load(tile_e + i, __ATOMIC_RELAXED, __HIP_MEMORY_SCOPE_AGENT);
            const bf16* GU = (const bf16*)(F.ws + WS_WEXP); const bf16* DT = (const bf16*)(F.ws + WS_WEXP + (size_t)8 * 7168 * 1024);
            is_gemm = true; S.nM = nt_; S.grouped = 1;
            fp8 = true;
            if (op == OP_MOE_UP) { g = pg8::Gemm{(const bf16*)(F.ws + WS_XB + (size_t)rk * MOE_ROWS * D), GU, D, D, D}; S.nN = 28; S.tpe = 28; S.boff = 0;
                if (rk == 1) { const int nt0 = __builtin_amdgcn_readfirstlane(__hip_atomic_load(ntl + 0, __ATOMIC_RELAXED, __HIP_MEMORY_SCOPE_AGENT)); const int l3 = nt0 * 4 - 2 * F.G; S.late = (l3 > 0 && l3 < F.G / 2) ? l3 : 0; }
                E.kind = pg8::EK_SWIGLU; E.o0 = F.ws + WS_HQ + (size_t)rk * MOE_ROWS * DEXP; E.ldo = DEXP; E.osc = HQ_SCALE; E.isc = 1.f / (XB_SCALE * WU_SCALE); }
            else { g = pg8::Gemm{(const bf16*)(F.ws + WS_HQ + (size_t)rk * MOE_ROWS * DEXP), DT, DEXP, DEXP, DEXP}; S.nN = 4; S.tpe = 4; S.boff = 0;
                if (rk == 0) sync_after = false;
                E.kind = pg8::EK_MOEDOWN; E.o0 = F.ws + WS_H; E.o1 = F.dout; E.i0 = (const int*)(F.ws + WS_SMALL + SM_SLOT_TOK) + rk * MOE_ROWS; E.i1 = (const float*)(F.ws + WS_SMALL + SM_SLOT_W) + rk * MOE_ROWS; E.fin = (rk == 1) ? 1 : 0;
                E.osc = 1.f / (HQ_SCALE * WD_SCALE); }
            break; }
        }
        __syncthreads();
        if (is_gemm) { S.nwg = S.nM * S.nN;
            if (fp8) pg8::gemm_phase<pg8::Epi, pg8::Order, true, true>(ring, g, S, E, F.tid); else pg8::gemm_phase<pg8::Epi, pg8::Order, true, false>(ring, g, S, E, F.tid); }
        if (sync_after && st + 1 < args.ph_hi) xcd_barrier(bar);
    }
#if SKMODE == 2
    xcd_barrier(bar);
    { const unsigned e = xb_ld(ctl + sk::CW_ERR), n = xb_ld(ctl + sk::CW_ERR + 64);
      if (blockIdx.x == 0 && (e > SK_ERR_MAX || n != 1034240u)) args.out[threadIdx.x] = __builtin_nanf(""); }
#endif
}

extern "C" void kernel_launch(void* const* d_in, const int* in_sizes, int n_in, void* d_out, int out_size, void* d_ws, size_t ws_size, hipStream_t stream) {
    static int grid = 0;
    if (grid == 0) {
        if (n_in != 28 || ws_size < WS_END || out_size != BATCH * SEQ * D) { fprintf(stderr, "kernel_launch: unexpected shapes (n_in %d, ws %zu, out %d)\n", n_in, ws_size, out_size); grid = -1; return; }
        int dev = 0, cus = 0, per_cu = 0;
        if (hipGetDevice(&dev) != hipSuccess || hipDeviceGetAttribute(&cus, hipDeviceAttributeMultiprocessorCount, dev) != hipSuccess) { grid = -1; return; }
        if (hipFuncSetAttribute((const void*)fwd_kernel, hipFuncAttributeMaxDynamicSharedMemorySize, LDS_BYTES) != hipSuccess) { fprintf(stderr, "kernel_launch: hipFuncSetAttribute failed\n"); grid = -1; return; }
        if (hipOccupancyMaxActiveBlocksPerMultiprocessor(&per_cu, (const void*)fwd_kernel, NTHREADS, LDS_BYTES) != hipSuccess || per_cu < 1) { fprintf(stderr, "kernel_launch: occupancy query says %d\n", per_cu); }
        (void)hipGetLastError();
        grid = cus;
    }
    if (grid < 0) return;
    if (hipMemsetAsync((char*)d_ws + WS_CTL, 0, CTL_BYTES, stream) != hipSuccess) return;
    Args a{};
    for (int i = 0; i < 28; ++i) a.in[i] = (const float*)d_in[i];
    a.out = (float*)d_out; a.ws = (unsigned char*)d_ws; a.ph_lo = 0; a.ph_hi = NSTEP;
    hipLaunchKernelGGL(fwd_kernel, dim3(grid), dim3(NTHREADS), LDS_BYTES, stream, a);
}
```

```cpp
#include <hip/hip_runtime.h>
#include <cstdio>
#include <cstdint>

#define GAS __attribute__((address_space(1)))
#define LAS __attribute__((address_space(3)))
typedef unsigned short bf16;
typedef short bf16x8 __attribute__((ext_vector_type(8)));
typedef float f32x4 __attribute__((ext_vector_type(4)));
typedef float f32x2 __attribute__((ext_vector_type(2)));
typedef unsigned u32x4 __attribute__((ext_vector_type(4)));
typedef unsigned u32x2 __attribute__((ext_vector_type(2)));
typedef GAS unsigned gu32;

constexpr int BATCH = 4, SEQ = 8192, NMETA = 16, LTOK = SEQ + NMETA, PADL = 112, LP = LTOK + PADL, M = BATCH * LP, D = 1024;
constexpr int NWAVES = 8, NTHREADS = 512;
constexpr int YW = 4096, NGATE = 3072, IN_COLS = 7088;
constexpr int C_DQ = 0, C_DKV = 256, C_KR = 384, C_GQ = 416, C_GK = 672, C_GV = 928, C_GGD = 1440, C_GR = 1456, C_HQ = 1968, C_HF = 2480, C_HI = 2992, C_HG = 3504, C_END = 4016;
constexpr int QKW = 768, VW = 512;
constexpr float EPS = 1e-6f;
constexpr float QSCALE = 0.10206207261596577f * 1.4426950408889634f;
constexpr int DFF = 2816, DEXP = 3584, NEXP = 8;
constexpr float XB_SCALE = 8.f, WU_SCALE = 64.f, HQ_SCALE = 4.f, WD_SCALE = 128.f;
constexpr int MOE_TILES = 137, MOE_ROWS = MOE_TILES * 256;

constexpr size_t MiB = 1u << 20;
constexpr size_t WS_CTL = 0, CTL_BYTES = 1 * MiB;
constexpr size_t WS_ROPE = 1 * MiB;
constexpr size_t WS_SKG = 2560 * 1024;
constexpr size_t WS_SMALL = 3 * MiB;
constexpr size_t WS_H = 8 * MiB;
constexpr size_t WS_O = 74 * MiB;
constexpr size_t WS_WL = 138 * MiB;
constexpr size_t WS_YM = 160 * MiB;
constexpr size_t WS_YG = 420 * MiB;
constexpr size_t WS_V = 518 * MiB;
constexpr size_t WS_END = 562 * MiB;
constexpr size_t WS_WFF = WS_YG;
constexpr size_t WS_HMID = WS_YM;
constexpr size_t WS_WEXP = WS_YM;
constexpr size_t WS_HQ = WS_YM + 84 * MiB;
constexpr size_t WS_XB = 484 * MiB;
constexpr size_t WL_IN = 0, WL_UQKV = 14 * MiB, WL_OM = WL_UQKV + 1835008, WL_OG = WL_OM + 1572864, WL_OH = WL_OG + 1048576, WL_OUT = WL_OH + 1048576;
static_assert(WL_OUT + 2097152 <= 22 * MiB, "WL");
constexpr size_t DO_U = 0;
constexpr size_t DO_Q = 0, DO_K = 49 * MiB;
constexpr size_t DO_MIX = 49 * MiB;
constexpr size_t DO_XB1 = 0;
constexpr size_t SM_ASG_E = 0, SM_ASG_I = 262144, SM_ASG_W = 524288;
constexpr size_t SM_SLOT_TOK = 786432, SM_SLOT_W = SM_SLOT_TOK + 2 * MOE_ROWS * 4;
constexpr size_t SM_TILE_E = SM_SLOT_W + 2 * MOE_ROWS * 4;
constexpr size_t SM_NT = SM_TILE_E + 2048;
static_assert(SM_NT + 64 <= 5 * MiB, "small");
constexpr int CW_BAR = 4096, CW_CNT = 8192, CW_ATTQ = 16384, CW_LINC = 20480;

constexpr int RING_BYTES = 131072, LDSCTL_OFF = RING_BYTES, MISC_OFF = LDSCTL_OFF + 320, TAB_OFF = MISC_OFF + 128, LDS_BYTES = 147456;

__device__ __forceinline__ unsigned pk2(float lo, float hi) { unsigned r; asm("v_cvt_pk_bf16_f32 %0, %1, %2" : "=v"(r) : "v"(lo), "v"(hi)); return r; }
__device__ __forceinline__ unsigned f2bf(float f) { return pk2(f, f) & 0xffffu; }
__device__ __forceinline__ float bf2f(unsigned short b) { return __builtin_bit_cast(float, (unsigned)b << 16); }
__device__ __forceinline__ float bflo(unsigned w) { return __builtin_bit_cast(float, w << 16); }
__device__ __forceinline__ float bfhi(unsigned w) { return __builtin_bit_cast(float, w & 0xffff0000u); }
template <int CTRL> __device__ __forceinline__ float dppf(float v) { return __builtin_bit_cast(float, __builtin_amdgcn_update_dpp(0, __builtin_bit_cast(int, v), CTRL, 0xF, 0xF, true)); }
__device__ __forceinline__ float sum8(float v) { v += dppf<0xB1>(v); v += dppf<0x4E>(v); v += dppf<0x141>(v); return v; }
__device__ __forceinline__ float sum16(float v) { v = sum8(v); v += dppf<0x140>(v); return v; }
__device__ __forceinline__ float wave_sum(int, float v) {
    v = sum16(v);
    { float a = v, b = v; asm volatile("s_nop 1\n\tv_permlane16_swap_b32 %0, %1\n\ts_nop 1" : "+v"(a), "+v"(b)); v = a + b; }
    { float a = v, b = v; asm volatile("s_nop 1\n\tv_permlane32_swap_b32 %0, %1\n\ts_nop 1" : "+v"(a), "+v"(b)); v = a + b; }
    return v;
}
__device__ __forceinline__ float frcp(float x) { return __builtin_amdgcn_rcpf(x); }
__device__ __forceinline__ float frsq(float x) { return __builtin_amdgcn_rsqf(x); }
__device__ __forceinline__ float flog(float x) { return __builtin_amdgcn_logf(x) * 0.6931471805599453f; }
__device__ __forceinline__ float sigmoidf_(float x) { return frcp(1.f + __expf(-x)); }
__device__ __forceinline__ float siluf_(float x) { return x * frcp(1.f + __expf(-x)); }
#define WAVE_SYNC() do { asm volatile("s_waitcnt lgkmcnt(0)" ::: "memory"); __builtin_amdgcn_wave_barrier(); } while (0)
template <class T> __device__ __forceinline__ const GAS T* gp(const T* p) { return (const GAS T*)p; }
template <class T> __device__ __forceinline__ GAS T* gpw(T* p) { return (GAS T*)p; }
template <class T> __device__ __forceinline__ T gld(const void* p) { return *(const GAS T*)p; }
template <class T> __device__ __forceinline__ void gst(void* p, const T v) { *(GAS T*)p = v; }
__device__ __forceinline__ u32x4 zero4() { unsigned z = 0u; asm volatile("" : "+v"(z)); return (u32x4){z, z, z, z}; }
__device__ __forceinline__ const float* inptr(int k) {
    const __attribute__((address_space(4))) unsigned long long* ka = (const __attribute__((address_space(4))) unsigned long long*)__builtin_amdgcn_kernarg_segment_ptr();
    asm volatile("" : "+s"(ka));
    return (const float*)ka[k];
}

namespace pg8 {
#define PG8_LAS __attribute__((address_space(3)))
typedef unsigned short bf16_t;
constexpr int BM = 256, BK = 64, HALF = 128, HTB = HALF * BK * 2, NXCD = 8, WGM = 8;
__host__ __device__ __forceinline__ int lds_byte(int r, int c) { const int st = (r >> 4) * 2 + (c >> 5), rr = r & 15, cc = c & 31, ob = rr * 64 + cc * 2; return st * 1024 + (ob ^ (((ob >> 9) & 1) << 5)); }
__host__ __device__ __forceinline__ void stage_rc(int b, int& R, int& C) { const int st = b / 1024, sb = b % 1024, swz = sb ^ (((sb >> 9) & 1) << 5); R = (st >> 1) * 16 + swz / 64; C = (st & 1) * 32 + (swz % 64) / 2; }
__host__ __device__ __forceinline__ int perm32(int rho) { const int n = rho >> 4, i = rho & 15; return 8 * (i >> 2) + 4 * n + (i & 3); }

struct Unit { int pm, pn, pb, pt; };
struct Gemm { const bf16_t* A; const bf16_t* Bt; int K, lda, ldb; };

__device__ __forceinline__ void tile_order(long L, int nM, int nN, int& pm, int& pn) {
    const int nwg = nM * nN; int wgid = (int)L;
    { const int q = nwg / NXCD, r = nwg % NXCD, xcd = wgid % NXCD, off = wgid / NXCD; wgid = (xcd < r ? xcd * (q + 1) : r * (q + 1) + (xcd - r) * q) + off; }
    const int nig = WGM * nN, gid = wgid / nig, fm = gid * WGM, gsz = (nM - fm) < WGM ? (nM - fm) : WGM;
    pm = fm + ((wgid % nig) % gsz); pn = (wgid % nig) / gsz;
}
struct Order {
    int nM, nN, nwg, G, c, tpe, boff, grouped; const PG8_LAS int* te; int xrow; int late;
    __device__ __forceinline__ bool next(int i, Unit& u) const {
        long L = (long)i * G + c;
        if (late > 0) {
            const int nf = G - late, R = nwg / nf;
            if (c >= late) { if (i >= R) return false; L = (long)i * nf + (c - late); } else L = (long)nf * R + (long)i * late + c; }
        if (L >= nwg) return false;
        tile_order(L, nM, nN, u.pm, u.pn);
        u.pb = grouped ? __builtin_amdgcn_readfirstlane(te[u.pm]) * tpe + boff + u.pn : u.pn; u.pt = u.pm;
        u.pm = 2 * u.pm + xrow * ((u.pm >> 5) + 1);
        return true;
    }
    __device__ __forceinline__ void a_ready(const Unit&) const {}
    __device__ __forceinline__ void done(const Unit&) const {}
};

typedef int v8i_t __attribute__((ext_vector_type(8)));
template <class Epi, class Sched, bool ALIGN_EPI = false, bool FP8 = false>
__device__ __forceinline__ void gemm_phase(PG8_LAS unsigned char* lds, const Gemm g, const Sched& S, const Epi& E, const int tid) {
    const int wid = __builtin_amdgcn_readfirstlane(tid >> 6), lane = tid & 63, wr = wid >> 2, wc = wid & 3, fr = lane & 15, fq = lane >> 4;
    constexpr int ESZ = FP8 ? 1 : 2;
    const int K = g.K, nt = K * ESZ / (BK * 2);
    unsigned voffA[2], voffB[2];
#pragma unroll
    for (int i = 0; i < 2; ++i) { int R, C; stage_rc(tid * 16 + i * 8192, R, C); const int Rb = Epi::PERM ? ((R & ~31) + perm32(R & 31)) : R;
        voffA[i] = (unsigned)(R * g.lda * ESZ + C * 2); voffB[i] = (unsigned)(Rb * g.ldb * ESZ + C * 2); }
    const size_t kstep = (size_t)(BK * 2);
    const size_t hstepA = (size_t)HALF * g.lda * ESZ, hstepB = (size_t)HALF * g.ldb * ESZ;
    const size_t tstepB = 2 * hstepB;
    const unsigned ldsw = (unsigned)wid * 1024u;
    const int aoff = lds_byte(wr * 64 + fr, FP8 ? fq * 16 : fq * 8), boff = lds_byte(wc * 32 + fr, FP8 ? fq * 16 : fq * 8);
    const int aoff1 = FP8 ? lds_byte(wr * 64 + fr, fq * 16 + 8) - aoff : 1024, boff1 = FP8 ? lds_byte(wc * 32 + fr, fq * 16 + 8) - boff : 1024;
#define PG8_SA(b, h) (((b) * 2 + (h)) * HTB)
#define PG8_SB(b, h) ((4 + (b) * 2 + (h)) * HTB)
#define PG8_STAGE(bufoff, gbase, voff) do { _Pragma("unroll") for (int _i = 0; _i < 2; ++_i) \
        __builtin_amdgcn_global_load_lds((const unsigned*)((const char*)(gbase) + (voff)[_i]), (PG8_LAS unsigned*)(lds + (bufoff) + ldsw + _i * 8192), 16, 0, 0); } while (0)
#define PG8_LDA(dst, b, h) do { _Pragma("unroll") for (int m = 0; m < 4; ++m) { \
        if constexpr (FP8) { const u32x4 lo_ = *(const PG8_LAS u32x4*)(lds + PG8_SA(b, h) + aoff + m * 2048), hi_ = *(const PG8_LAS u32x4*)(lds + PG8_SA(b, h) + aoff + m * 2048 + aoff1); \
            dst##8[m] = __builtin_bit_cast(v8i_t, __builtin_shufflevector(lo_, hi_, 0, 1, 2, 3, 4, 5, 6, 7)); } \
        else { _Pragma("unroll") for (int k = 0; k < 2; ++k) dst[m][k] = *(const PG8_LAS bf16x8*)(lds + PG8_SA(b, h) + aoff + m * 2048 + k * 1024); } } } while (0)
#define PG8_LDB(dst, b, h) do { _Pragma("unroll") for (int n = 0; n < 2; ++n) { \
        if constexpr (FP8) { const u32x4 lo_ = *(const PG8_LAS u32x4*)(lds + PG8_SB(b, h) + boff + n * 2048), hi_ = *(const PG8_LAS u32x4*)(lds + PG8_SB(b, h) + boff + n * 2048 + boff1); \
            dst##8[n] = __builtin_bit_cast(v8i_t, __builtin_shufflevector(lo_, hi_, 0, 1, 2, 3, 4, 5, 6, 7)); } \
        else { _Pragma("unroll") for (int k = 0; k < 2; ++k) dst[n][k] = *(const PG8_LAS bf16x8*)(lds + PG8_SB(b, h) + boff + n * 2048 + k * 1024); } } } while (0)
#define PG8_MMA(ai, bj, At, Bt) do { __builtin_amdgcn_s_setprio(1); \
        if constexpr (FP8) { _Pragma("unroll") for (int m = 0; m < 4; ++m) _Pragma("unroll") for (int n = 0; n < 2; ++n) \
            asm volatile("v_mfma_scale_f32_16x16x128_f8f6f4 %0, %1, %2, %0, %3, %3 op_sel_hi:[0,0,0]" : "+v"(acc[ai][bj][m][n]) : "v"(Bt##8[n]), "v"(At##8[m]), "v"(one8)); } \
        else { _Pragma("unroll") for (int m = 0; m < 4; ++m) _Pragma("unroll") for (int n = 0; n < 2; ++n) _Pragma("unroll") for (int k = 0; k < 2; ++k) \
            acc[ai][bj][m][n] = __builtin_amdgcn_mfma_f32_16x16x32_bf16(Bt[n][k], At[m][k], acc[ai][bj][m][n], 0, 0, 0); } \
        __builtin_amdgcn_s_setprio(0); } while (0)
#define PG8_WAIT_V(n) asm volatile("s_waitcnt vmcnt(" #n ")" ::: "memory")
#define PG8_WAIT_L(n) asm volatile("s_waitcnt lgkmcnt(" #n ")" ::: "memory")
#define PG8_BAR __builtin_amdgcn_s_barrier()
#define PG8_SCHED __builtin_amdgcn_sched_barrier(0)
    Unit cur, nxt; int ui = 0;
    if (!S.next(0, cur)) return;
    f32x4 acc[2][2][4][2];
#pragma unroll
    for (int a = 0; a < 2; ++a)
#pragma unroll
        for (int b = 0; b < 2; ++b)
#pragma unroll
            for (int m = 0; m < 4; ++m)
#pragma unroll
                for (int n = 0; n < 2; ++n) acc[a][b][m][n] = (f32x4){0.f, 0.f, 0.f, 0.f};
    bf16x8 At[4][2], B0[2][2], B1[2][2]; v8i_t At8[4], B08[2], B18[2];
    int one8 = 0x7F7F7F7F; asm volatile("" : "+v"(one8));
    const char* cA = (const char*)g.A + (size_t)cur.pm * hstepA; const char* cB = (const char*)g.Bt + (size_t)cur.pb * tstepB;
    S.a_ready(cur);
    PG8_STAGE(PG8_SB(0, 0), cB, voffB); PG8_STAGE(PG8_SB(0, 1), cB + hstepB, voffB); PG8_STAGE(PG8_SA(0, 0), cA, voffA); PG8_STAGE(PG8_SA(0, 1), cA + hstepA, voffA);
    if (wr == 1) PG8_BAR;
    PG8_WAIT_V(2); PG8_BAR;
    PG8_STAGE(PG8_SB(1, 0), cB + kstep, voffB); PG8_STAGE(PG8_SA(1, 0), cA + kstep, voffA); PG8_STAGE(PG8_SB(1, 1), cB + hstepB + kstep, voffB);
    PG8_WAIT_V(6); PG8_BAR;
    for (;;) {
        const bool has_next = S.next(ui + 1, nxt);
        const char* nA = has_next ? (const char*)g.A + (size_t)nxt.pm * hstepA : cA; const char* nB = has_next ? (const char*)g.Bt + (size_t)nxt.pb * tstepB : cB;
        for (int t = 0; t < nt; t += 2) {
            const bool last = (t == nt - 2);
            const char* a1 = cA + (size_t)(t + 1) * kstep;
            const char* a2 = last ? nA : cA + (size_t)(t + 2) * kstep; const char* b2 = last ? nB : cB + (size_t)(t + 2) * kstep;
            const char* a3 = a2 + kstep; const char* b3 = b2 + kstep;
            if (last && has_next) S.a_ready(nxt);
            PG8_LDB(B0, 0, 0); PG8_LDB(B1, 0, 1); PG8_SCHED; PG8_LDA(At, 0, 0); PG8_STAGE(PG8_SA(1, 1), a1 + hstepA, voffA);
            PG8_WAIT_V(8); PG8_WAIT_L(0); PG8_BAR; PG8_MMA(0, 0, At, B0); PG8_MMA(0, 1, At, B1); PG8_BAR; PG8_SCHED;
            PG8_LDA(At, 0, 1); PG8_STAGE(PG8_SB(0, 0), b2, voffB); PG8_STAGE(PG8_SB(0, 1), b2 + hstepB, voffB); PG8_STAGE(PG8_SA(0, 0), a2, voffA);
            PG8_WAIT_V(8); PG8_WAIT_L(0); PG8_BAR; PG8_MMA(1, 0, At, B0); PG8_MMA(1, 1, At, B1); PG8_BAR; PG8_SCHED;
            PG8_LDB(B0, 1, 0); PG8_LDB(B1, 1, 1); PG8_SCHED; PG8_LDA(At, 1, 0); PG8_STAGE(PG8_SA(0, 1), a2 + hstepA, voffA);
            PG8_WAIT_V(8); PG8_WAIT_L(0); PG8_BAR; PG8_MMA(0, 0, At, B0); PG8_MMA(0, 1, At, B1); PG8_BAR; PG8_SCHED;
            PG8_LDA(At, 1, 1); PG8_STAGE(PG8_SB(1, 0), b3, voffB); PG8_STAGE(PG8_SB(1, 1), b3 + hstepB, voffB); PG8_STAGE(PG8_SA(1, 0), a3, voffA);
            PG8_WAIT_V(8); PG8_WAIT_L(0); PG8_BAR; PG8_MMA(1, 0, At, B0); PG8_MMA(1, 1, At, B1); PG8_BAR; PG8_SCHED;
        }
        if constexpr (ALIGN_EPI) { if (wr == 0) PG8_BAR; }
        if constexpr (FP8) asm volatile("s_nop 15\n\ts_nop 15" ::: "memory");
        E(acc, cur, wr, wc, fr, fq); S.done(cur);
        if (!has_next) break;
#pragma unroll
        for (int a = 0; a < 2; ++a)
#pragma unroll
            for (int b = 0; b < 2; ++b)
#pragma unroll
                for (int m = 0; m < 4; ++m)
#pragma unroll
                    for (int n = 0; n < 2; ++n) acc[a][b][m][n] = (f32x4){0.f, 0.f, 0.f, 0.f};
        cur = nxt; cA = nA; cB = nB; ++ui;
        if constexpr (ALIGN_EPI) { if (wr == 1) PG8_BAR; }
    }
    PG8_WAIT_V(0);
    if constexpr (!ALIGN_EPI) { if (wr == 0) PG8_BAR; }
    PG8_BAR;
#undef PG8_SA
#undef PG8_SB
#undef PG8_STAGE
#undef PG8_LDA
#undef PG8_LDB
#undef PG8_MMA
#undef PG8_WAIT_V
#undef PG8_WAIT_L
#undef PG8_BAR
#undef PG8_SCHED
}

__device__ __forceinline__ unsigned cvt_pk_bf16(float lo, float hi) { unsigned r; asm volatile("v_cvt_pk_bf16_f32 %0, %1, %2" : "=v"(r) : "v"(lo), "v"(hi)); return r; }
__device__ __forceinline__ u32x4 pack8(const f32x4 v0, const f32x4 v1) { u32x4 w; w.x = cvt_pk_bf16(v0[0], v0[1]); w.y = cvt_pk_bf16(v0[2], v0[3]); w.z = cvt_pk_bf16(v1[0], v1[1]); w.w = cvt_pk_bf16(v1[2], v1[3]); return w; }
__device__ __forceinline__ float clamp448(float x) { return __builtin_amdgcn_fmed3f(x, -448.f, 448.f); }
__device__ __forceinline__ unsigned fp8x4(const f32x4 v) { int w = 0; w = __builtin_amdgcn_cvt_pk_fp8_f32(clamp448(v[0]), clamp448(v[1]), w, false);
    w = __builtin_amdgcn_cvt_pk_fp8_f32(clamp448(v[2]), clamp448(v[3]), w, true); return (unsigned)w; }
__device__ __forceinline__ unsigned q8(float x) { const float s = frcp(1.f + __expf(-x)); return (unsigned)(s * 255.f + 0.5f); }

#define EPI_FENCE() asm volatile("" ::: "memory")
enum { EK_INPROJ = 0, EK_MIX0, EK_MIX1, EK_MIX2, EK_RESID, EK_SWIGLU, EK_MOEDOWN, EK_MLA };
struct Epi {
    static constexpr bool PERM = true;
    int kind;
    void* o0;
    void* o1;
    const void* i0;
    const void* i1;
    int ldo, fin, dry;
    float isc;
    float osc;
    __device__ __forceinline__ void operator()(const f32x4 (&acc)[2][2][4][2], const Unit& u, int wr, int wc, int fr, int fq) const {
        const int row0 = u.pm * HALF + wr * 64 + fr;
        if (dry) { float sink = 0.f;
#pragma unroll
            for (int ai = 0; ai < 2; ++ai)
#pragma unroll
                for (int bj = 0; bj < 2; ++bj)
#pragma unroll
                    for (int m = 0; m < 4; ++m) sink += acc[ai][bj][m][0][0] + acc[ai][bj][m][1][3];
            asm volatile("" :: "v"(sink)); return; }
        if (kind == EK_INPROJ) {
            if (u.pn < 16) { bf16_t* Ym = (bf16_t*)o0; const int col0 = u.pn * BM + wc * 32 + 8 * fq;
#pragma unroll
                for (int ai = 0; ai < 2; ++ai)
#pragma unroll
                    for (int m = 0; m < 4; ++m) { bf16_t* rowp = Ym + (size_t)(row0 + ai * HALF + m * 16) * YW + col0;
#pragma unroll
                        for (int bj = 0; bj < 2; ++bj) gst<u32x4>(rowp + bj * HALF, pack8(acc[ai][bj][m][0], acc[ai][bj][m][1])); }
            } else {
                u32x2* img = (u32x2*)((unsigned char*)o1 + ((size_t)(u.pt * 12 + (u.pn - 16)) << 16)) + (wr * 4 + wc) * 1024 + fq * 16 + fr;
#pragma unroll
                for (int ai = 0; ai < 2; ++ai)
#pragma unroll
                    for (int m = 0; m < 4; ++m) {
#pragma unroll
                        for (int bj = 0; bj < 2; ++bj) { const f32x4 a = acc[ai][bj][m][0], b = acc[ai][bj][m][1]; u32x2 w;
                            w.x = q8(a[0]) | (q8(a[1]) << 8) | (q8(a[2]) << 16) | (q8(a[3]) << 24); w.y = q8(b[0]) | (q8(b[1]) << 8) | (q8(b[2]) << 16) | (q8(b[3]) << 24);
                            gst<u32x2>(img + ((ai * 2 + bj) * 4 + m) * 64, w); } }
            }
        } else if (kind <= EK_MIX2) {
            bf16_t* Mx = (bf16_t*)o0; const bool addp = kind != EK_MIX0;
            const u32x2* img = (const u32x2*)((const unsigned char*)i0 + ((size_t)(u.pt * 12 + (kind - EK_MIX0) * 4 + u.pn) << 16)) + (wr * 4 + wc) * 1024 + fq * 16 + fr;
            const int col0 = u.pn * BM + wc * 32 + 8 * fq; const float s = 1.f / 255.f;
#pragma unroll
            for (int ai = 0; ai < 2; ++ai)
#pragma unroll
                for (int bj = 0; bj < 2; ++bj) { const int col = col0 + bj * HALF; u32x2 gw[4]; u32x4 pv[4];
#pragma unroll
                    for (int m = 0; m < 4; ++m) { const int row = row0 + ai * HALF + m * 16; gw[m] = gld<u32x2>(img + ((ai * 2 + bj) * 4 + m) * 64);
                        pv[m] = (u32x4){0u, 0u, 0u, 0u}; if (addp) pv[m] = gld<u32x4>(Mx + (size_t)row * D + col); }
#pragma unroll
                    for (int m = 0; m < 4; ++m) { const int row = row0 + ai * HALF + m * 16; f32x4 a = acc[ai][bj][m][0], b = acc[ai][bj][m][1]; const u32x2 g = gw[m]; const u32x4 p = pv[m];
                        a[0] = a[0] * ((float)(g.x & 255u) * s) + bflo(p.x); a[1] = a[1] * ((float)((g.x >> 8) & 255u) * s) + bfhi(p.x); a[2] = a[2] * ((float)((g.x >> 16) & 255u) * s) + bflo(p.y); a[3] = a[3] * ((float)(g.x >> 24) * s) + bfhi(p.y);
                        b[0] = b[0] * ((float)(g.y & 255u) * s) + bflo(p.z); b[1] = b[1] * ((float)((g.y >> 8) & 255u) * s) + bfhi(p.z); b[2] = b[2] * ((float)((g.y >> 16) & 255u) * s) + bflo(p.w); b[3] = b[3] * ((float)(g.y >> 24) * s) + bfhi(p.w);
                        gst<u32x4>(Mx + (size_t)row * D + col, pack8(a, b)); }
                    EPI_FENCE(); }
        } else if (kind == EK_RESID) {
            bf16_t* H = (bf16_t*)o0; const int col0 = u.pn * BM + wc * 32 + 8 * fq;
#pragma unroll
            for (int ai = 0; ai < 2; ++ai)
#pragma unroll
                for (int bj = 0; bj < 2; ++bj) { u32x4 x[4];
#pragma unroll
                    for (int m = 0; m < 4; ++m) x[m] = gld<u32x4>(H + (size_t)(row0 + ai * HALF + m * 16) * D + col0 + bj * HALF);
#pragma unroll
                    for (int m = 0; m < 4; ++m) { const f32x4 a = acc[ai][bj][m][0] * isc + (f32x4){bflo(x[m].x), bfhi(x[m].x), bflo(x[m].y), bfhi(x[m].y)}, b = acc[ai][bj][m][1] * isc + (f32x4){bflo(x[m].z), bfhi(x[m].z), bflo(x[m].w), bfhi(x[m].w)};
                        gst<u32x4>(H + (size_t)(row0 + ai * HALF + m * 16) * D + col0 + bj * HALF, pack8(a, b)); }
                    EPI_FENCE(); }
        } else if (kind == EK_SWIGLU) {
            bf16_t* O = (bf16_t*)o0; const int col0 = u.pn * HALF + wc * 32 + 8 * fq; const float c1 = -1.4426950408889634f * isc, c2 = isc * isc * (osc > 0.f ? osc : 1.f);
#pragma unroll
            for (int ai = 0; ai < 2; ++ai)
#pragma unroll
                for (int m = 0; m < 4; ++m) { f32x4 h[2];
#pragma unroll
                    for (int n = 0; n < 2; ++n)
#pragma unroll
                        for (int e = 0; e < 4; ++e) { const float ga = acc[ai][0][m][n][e], ua = acc[ai][1][m][n][e];
                            h[n][e] = ga * ua * c2 * frcp(1.f + __builtin_amdgcn_exp2f(ga * c1)); }
                    if (osc > 0.f) { u32x2 w8; w8.x = fp8x4(h[0]); w8.y = fp8x4(h[1]); gst<u32x2>((unsigned char*)o0 + (size_t)(row0 + ai * HALF + m * 16) * ldo + col0, w8); }
                    else gst<u32x4>(O + (size_t)(row0 + ai * HALF + m * 16) * ldo + col0, pack8(h[0], h[1])); }
        } else if (kind == EK_MLA) {
            bf16_t* Qb = (bf16_t*)o0; bf16_t* Kb = (bf16_t*)o1; bf16_t* Vb = (bf16_t*)i0;
#pragma unroll
            for (int ai = 0; ai < 2; ++ai)
#pragma unroll
                for (int m = 0; m < 4; ++m) { const size_t row = (size_t)(row0 + ai * HALF + m * 16);
#pragma unroll
                    for (int bj = 0; bj < 2; ++bj) { const u32x4 w = pack8(acc[ai][bj][m][0], acc[ai][bj][m][1]);
                        const int pn_ = u.pn + fin;
                        if (pn_ < 3) gst<u32x4>(Qb + row * QKW + pn_ * BM + bj * HALF + wc * 32 + 8 * fq, w);
                        else { const int c = (pn_ - 3) * BM + bj * HALF + wc * 32 + 8 * fq, hh = c >> 7, d = c & 127;
                            if (d < 64) gst<u32x4>(Kb + row * QKW + hh * 96 + d, w); else gst<u32x4>(Vb + row * VW + hh * 64 + d - 64, w); } } }
        } else {
            bf16_t* H = (bf16_t*)o0; float* out = (float*)o1; const int* slot_tok = (const int*)i0; const float* slot_w = (const float*)i1;
            const int col0 = u.pn * BM + wc * 32 + 8 * fq;
#pragma unroll
            for (int ai = 0; ai < 2; ++ai) { int tk[4]; float wv[4];
#pragma unroll
                for (int m = 0; m < 4; ++m) { const int slot = row0 + ai * HALF + m * 16; tk[m] = gld<int>(slot_tok + slot); wv[m] = gld<float>(slot_w + slot) * osc; }
#pragma unroll
                for (int bj = 0; bj < 2; ++bj) { u32x4 x[4];
#pragma unroll
                    for (int m = 0; m < 4; ++m) { const int t_ = tk[m] < 0 ? 0 : tk[m]; x[m] = gld<u32x4>(H + (size_t)t_ * D + col0 + bj * HALF); }
#pragma unroll
                    for (int m = 0; m < 4; ++m) if (tk[m] >= 0) {
                        const f32x4 a = acc[ai][bj][m][0] * wv[m] + (f32x4){bflo(x[m].x), bfhi(x[m].x), bflo(x[m].y), bfhi(x[m].y)}, b = acc[ai][bj][m][1] * wv[m] + (f32x4){bflo(x[m].z), bfhi(x[m].z), bflo(x[m].w), bfhi(x[m].w)};
                        if (fin) { const int bb = tk[m] / LP, p = tk[m] - bb * LP; f32x4* q = (f32x4*)(out + ((size_t)bb * SEQ + (p - 128)) * D + col0 + bj * HALF); gst<f32x4>(q, a); gst<f32x4>(q + 1, b); }
                        else gst<u32x4>(H + (size_t)tk[m] * D + col0 + bj * HALF, pack8(a, b)); }
                    EPI_FENCE(); } }
        }
    }
};
}

#define XB_TMO      128
#define XB_XCNT(j)  (256  + 64 * (j))
#define XB_XSUB(j)  (1280 + 64 * (j))
#define XB_XGEN(j)  (2304 + 64 * (j))
#define XB_TOP      3328
#define XB_TOPGEN   3392
#define XCD_BAR_WORDS 3456
#define XB_SPIN_CAP (1u << 25)
__device__ __forceinline__ unsigned xb_ld(unsigned* p)              { return __hip_atomic_load(p, __ATOMIC_RELAXED, __HIP_MEMORY_SCOPE_AGENT); }
__device__ __forceinline__ unsigned xb_add(unsigned* p, unsigned v) { return __hip_atomic_fetch_add(p, v, __ATOMIC_RELAXED, __HIP_MEMORY_SCOPE_AGENT); }
__device__ __forceinline__ unsigned xb_xcc_id() { return (unsigned)__builtin_amdgcn_s_getreg((3 << 11) | 20) & 0xFu; }
#define XB_SPIN(cond, bar) do { unsigned _sp = 0; while (cond) { __builtin_amdgcn_s_sleep(1); \
    if ((++_sp & 255u) == 0u) { if (xb_ld(&(bar)[XB_TMO])) break; if (_sp > XB_SPIN_CAP) { atomicAdd(&(bar)[XB_TMO], 1u); break; } } } } while (0)
struct XcdBarrier { unsigned* bar; unsigned x; volatile LAS unsigned* st; };
__device__ __forceinline__ XcdBarrier xcd_barrier_post(unsigned* bar, volatile LAS unsigned* st) {
    XcdBarrier b; b.bar = bar; b.x = xb_xcc_id(); b.st = st;
    if (threadIdx.x == 0) (void)xb_add(&bar[XB_XCNT(b.x)], 1u);
    return b;
}
__device__ __forceinline__ void xcd_barrier_complete(unsigned* bar, unsigned x, unsigned& nloc, unsigned& nx) {
    const unsigned G = gridDim.x * gridDim.y * gridDim.z;
    unsigned sum, cnt, mine, sp = 0u;
    for (;;) {
        sum = 0u; cnt = 0u; mine = 0u;
#pragma unroll
        for (unsigned j = 0; j < 16; ++j) { const unsigned c = xb_ld(&bar[XB_XCNT(j)]); sum += c; cnt += (c > 0u) ? 1u : 0u; mine = (j == x) ? c : mine; }
        if (sum == G) break;
        __builtin_amdgcn_s_sleep(1);
        if ((++sp & 255u) == 0u) { if (xb_ld(&bar[XB_TMO])) break; if (sp > XB_SPIN_CAP) { atomicAdd(&bar[XB_TMO], 1u); break; } }
    }
    nloc = mine > 0u ? mine : 1u; nx = cnt > 0u ? cnt : 1u;
}
__device__ __forceinline__ void xcd_barrier(const XcdBarrier& b) {
    asm volatile("s_waitcnt vmcnt(0)" ::: "memory");
    __syncthreads();
    if (threadIdx.x == 0) {
        unsigned* bar = b.bar;
        __builtin_amdgcn_s_waitcnt(0);
        unsigned nloc = b.st[0], nx = b.st[1];
        if (nloc == 0u) { xcd_barrier_complete(bar, b.x, nloc, nx); b.st[0] = nloc; b.st[1] = nx; }
        const unsigned old = xb_add(&bar[XB_XSUB(b.x)], 1u);
        const unsigned gen = old / nloc;
        if (old + 1u == (gen + 1u) * nloc) {
            __builtin_amdgcn_fence(__ATOMIC_RELEASE, "agent");
            asm volatile("s_waitcnt vmcnt(0)" ::: "memory");
            const unsigned og = xb_add(&bar[XB_TOP], 1u);
            const unsigned tg = og / nx;
            if (og + 1u == (tg + 1u) * nx) xb_add(&bar[XB_TOPGEN], 1u);
            else XB_SPIN(xb_ld(&bar[XB_TOPGEN]) == tg, bar);
            __builtin_amdgcn_fence(__ATOMIC_ACQUIRE, "agent");
            xb_add(&bar[XB_XGEN(b.x)], 1u);
            asm volatile("s_waitcnt vmcnt(0)" ::: "memory");
        } else {
            XB_SPIN(xb_ld(&bar[XB_XGEN(b.x)]) == gen, bar);
            __builtin_amdgcn_fence(__ATOMIC_ACQUIRE, "agent");
            asm volatile("s_waitcnt vmcnt(0)" ::: "memory");
        }
    }
    __syncthreads();
}

struct Args { const float* in[28]; float* out; unsigned char* ws; int ph_lo, ph_hi; };
struct Frame {
    LAS unsigned char* lds; unsigned char* ws; unsigned char* dout;
    int tid, lane, wave, G, bid, gw, NGW, dry;
};

template <bool F8>
__device__ __forceinline__ void transpose_tile(const float* W, size_t ldw, int k0, int ncol0, int nvalid, bf16* WT, size_t ldt, int drow0, int dk0, const float* gain, float scale, LAS float* scr, int lane) {
    const int n_ = lane & 31;
    float tv[32];
#pragma unroll
    for (int i = 0; i < 32; ++i) { const int kk = 2 * i + (lane >> 5); tv[i] = 0.f; if (n_ < nvalid) tv[i] = *(const GAS float*)gp(W + (size_t)(k0 + kk) * ldw + ncol0 + n_); }
    { const float* gsrc = gain ? gain : W;
      const bool hasg = gain != nullptr;
#pragma unroll
      for (int i = 0; i < 32; ++i) { const float gv = *(const GAS float*)gp(gsrc + k0 + 2 * i + (lane >> 5)); tv[i] *= hasg ? gv : 1.f; } }
#pragma unroll
    for (int i = 0; i < 32; ++i) scr[(2 * i + (lane >> 5)) * 33 + n_] = tv[i] * scale;
    WAVE_SYNC();
    const int c = lane & 7;
#pragma unroll
    for (int j = 0; j < 4; ++j) { const LAS float* s = scr + (8 * c) * 33 + (lane >> 3) + 8 * j;
#pragma unroll
        for (int q = 0; q < 8; ++q) tv[8 * j + q] = s[q * 33]; }
#pragma unroll
    for (int j = 0; j < 4; ++j) { const int n = (lane >> 3) + 8 * j; const float* s = tv + 8 * j;
        if (F8) { u32x2 o; o.x = pg8::fp8x4((f32x4){s[0], s[1], s[2], s[3]}); o.y = pg8::fp8x4((f32x4){s[4], s[5], s[6], s[7]});
            if (n < nvalid) *(GAS u32x2*)gpw((u32x2*)((unsigned char*)WT + (size_t)(drow0 + n) * ldt + dk0 + 8 * c)) = o; }
        else { u32x4 o; o.x = pk2(s[0], s[1]); o.y = pk2(s[2], s[3]); o.z = pk2(s[4], s[5]); o.w = pk2(s[6], s[7]);
            if (n < nvalid) *(GAS u32x4*)gpw((u32x4*)(WT + (size_t)(drow0 + n) * ldt + dk0 + 8 * c)) = o; } }
    WAVE_SYNC();
}
template <int MODE, bool F8 = false>
__device__ __forceinline__ void conv_matrix(const Frame& F, const float* W, int K, int Ncols, size_t ldw, int ncol_base, bf16* WT, size_t ldt, int drow_base, const float* gain, int dk_base = 0, float scale = 1.f) {
    LAS float* scr = (LAS float*)(F.lds + F.wave * 16384);
    const int nkb = K / 64, nnb = (Ncols + 31) / 32, ntile = nkb * nnb;
    for (int it = F.gw; it < ntile; it += F.NGW) {
        const int kb = it / nnb, nb = it % nnb, n0 = nb * 32, nvalid = (Ncols - n0) < 32 ? (Ncols - n0) : 32;
        int drow0 = drow_base + n0, dk0 = dk_base + kb * 64;
        if (MODE == 1) drow0 = 256 * (n0 / 128) + (n0 % 128) + drow_base;
        if (MODE == 2) dk0 = kb * 96;
        transpose_tile<F8>(W, ldw, kb * 64, ncol_base + n0, nvalid, WT, ldt, drow0, dk0, gain, scale, scr, F.lane);
    }
}
__device__ __forceinline__ void zero_fill16(const Frame& F, void* p, size_t bytes) {
    u32x4* q = (u32x4*)p; const size_t n = bytes / 16;
    const u32x4 z4 = zero4();
    for (size_t i = (size_t)F.bid * NTHREADS + F.tid; i < n; i += (size_t)F.G * NTHREADS) q[i] = z4;
}
__device__ __forceinline__ void convert_layer_weights(const Frame& F, int layer) {
    unsigned char* wl = F.ws + WS_WL;
    bf16* WinT = (bf16*)(wl + WL_IN); bf16* uq = (bf16*)(wl + WL_UQKV);
    const float* w_in = inptr(3) + (size_t)layer * D * IN_COLS;
    LAS float* scr = (LAS float*)(F.lds + F.wave * 16384);
    constexpr int T0 = 16 * 126, T1 = T0 + 16 * 96, T2 = T1 + 4 * 24, T3 = T2 + 2 * 32, T4 = T3 + 8 * 32, T5 = T4 + 8 * 32, T6 = T5 + 8 * 32, T7 = T6 + 16 * 32;
    for (int it = F.gw; it < T7; it += F.NGW) {
        const float* W; const float* gain = nullptr; bf16* WT; int Ncols, ldw, ncol_base = 0, ldt, drow_base = 0, nnb, t;
        if (it < T0)      { t = it;      W = w_in; Ncols = C_END; ldw = IN_COLS; WT = WinT; ldt = D; nnb = 126; }
        else if (it < T1) { t = it - T0; W = w_in; Ncols = NGATE; ldw = IN_COLS; ncol_base = C_END; WT = WinT; ldt = D; drow_base = YW; nnb = 96; }
        else if (it < T2) { t = it - T1; W = inptr(5) + (size_t)layer * 256 * 768; Ncols = 768; ldw = 768; WT = uq; ldt = 256; gain = inptr(4) + layer * 256; nnb = 24; }
        else if (it < T3) { t = it - T2; W = inptr(7) + (size_t)layer * 128 * 1024; Ncols = 1024; ldw = 1024; WT = uq; ldt = 256; drow_base = 768; gain = inptr(6) + layer * 128; nnb = 32; }
        else if (it < T4) { t = it - T3; W = inptr(15) + (size_t)layer * 512 * 1024; Ncols = 1024; ldw = 1024; WT = (bf16*)(wl + WL_OM); ldt = 512; nnb = 32; }
        else if (it < T5) { t = it - T4; W = inptr(16) + (size_t)layer * 512 * 1024; Ncols = 1024; ldw = 1024; WT = (bf16*)(wl + WL_OG); ldt = 512; nnb = 32; }
        else if (it < T6) { t = it - T5; W = inptr(17) + (size_t)layer * 512 * 1024; Ncols = 1024; ldw = 1024; WT = (bf16*)(wl + WL_OH); ldt = 512; nnb = 32; }
        else              { t = it - T6; W = inptr(18) + (size_t)layer * 1024 * 1024; Ncols = 1024; ldw = 1024; WT = (bf16*)(wl + WL_OUT); ldt = 1024; nnb = 32; }
        const int kb = t / nnb, n0 = (t % nnb) * 32, nvalid = (Ncols - n0) < 32 ? (Ncols - n0) : 32;
        transpose_tile<false>(W, (size_t)ldw, kb * 64, ncol_base + n0, nvalid, WT, (size_t)ldt, drow_base + n0, kb * 64, gain, 1.f, scr, F.lane);
    }
    zero_fill16(F, WinT + (size_t)C_END * D, (size_t)(YW - C_END) * D * 2);
    { const u32x4 z4 = zero4();
      for (int i = F.bid * NTHREADS + F.tid; i < 1024 * 16; i += F.G * NTHREADS) { const int row = 768 + (i >> 4), c = 16 + (i & 15); *(u32x4*)(uq + (size_t)row * 256 + 8 * c) = z4; } }
}

__device__ __forceinline__ float row_rstd(const Frame& F, const f32x4 (&v)[4]) {
    float s = 0.f;
#pragma unroll
    for (int j = 0; j < 4; ++j) s += (v[j].x * v[j].x + v[j].y * v[j].y) + (v[j].z * v[j].z + v[j].w * v[j].w);
    return frsq(wave_sum(F.lane, s) * (1.f / D) + EPS);
}
__device__ __forceinline__ void store_row_bf16(bf16* orow, const f32x4 (&v)[4], float rstd, const float* gain, int lane) {
    unsigned long long* o8 = (unsigned long long*)orow + lane;
#pragma unroll
    for (int j = 0; j < 4; ++j) { const f32x4 g = gld<f32x4>((const f32x4*)gain + lane + 64 * j);
        gst<u32x2>(o8 + 64 * j, (u32x2){pk2(v[j].x * rstd * g.x, v[j].y * rstd * g.y), pk2(v[j].z * rstd * g.z, v[j].w * rstd * g.w)}); }
}
__device__ __forceinline__ void store_row_bf16g(bf16* orow, const f32x4 (&v)[4], float rstd, const f32x4 (&g)[4], int lane) {
    unsigned long long* o8 = (unsigned long long*)orow + lane;
#pragma unroll
    for (int j = 0; j < 4; ++j) gst<u32x2>(o8 + 64 * j, (u32x2){pk2(v[j].x * rstd * g[j].x, v[j].y * rstd * g[j].y), pk2(v[j].z * rstd * g[j].z, v[j].w * rstd * g[j].w)});
}
__device__ __forceinline__ void store_row_fp8(unsigned char* orow, const f32x4 (&v)[4], float rstd, const float* gain, float scale, int lane) {
    unsigned* o4 = (unsigned*)orow + lane;
#pragma unroll
    for (int j = 0; j < 4; ++j) { const f32x4 g = gld<f32x4>((const f32x4*)gain + lane + 64 * j); const float sc = rstd * scale;
        gst<unsigned>(o4 + 64 * j, pg8::fp8x4((f32x4){v[j].x * sc * g.x, v[j].y * sc * g.y, v[j].z * sc * g.z, v[j].w * sc * g.w})); }
}
__device__ __forceinline__ void load_h_row(const bf16* hrow, int lane, f32x4 (&v)[4]) {
#pragma unroll
    for (int j = 0; j < 4; ++j) { const u32x2 w = *(const GAS u32x2*)gp((const u32x2*)hrow + lane + 64 * j); v[j] = (f32x4){bflo(w.x), bfhi(w.x), bflo(w.y), bfhi(w.y)}; }
}
__device__ __forceinline__ void store_h_row(bf16* hrow, int lane, const f32x4 (&v)[4]) {
#pragma unroll
    for (int j = 0; j < 4; ++j) { u32x2 w; w.x = pk2(v[j].x, v[j].y); w.y = pk2(v[j].z, v[j].w); gst<u32x2>((u32x2*)hrow + lane + 64 * j, w); }
}
__device__ __forceinline__ void phase_init_rows(const Frame& F, const float* gain) {
    bf16* H = (bf16*)(F.ws + WS_H); bf16* U = (bf16*)(F.dout + DO_U);
    const float* x = inptr(0); const float* meta = inptr(1);
    f32x4 gn[4];
#pragma unroll
    for (int j = 0; j < 4; ++j) gn[j] = gld<f32x4>((const f32x4*)gain + F.lane + 64 * j);
    f32x4 vr[2][4];
    auto issue = [&](int q, int r_) { const int r = r_ < M ? r_ : F.gw; const int b = r / LP, p = r - b * LP;
        const float* src = (p < 128) ? meta + (size_t)(p < PADL ? 0 : p - PADL) * D : x + ((size_t)b * SEQ + (p - 128)) * D;
#pragma unroll
        for (int j = 0; j < 4; ++j) vr[q][j] = *(const GAS f32x4*)gp((const f32x4*)src + F.lane + 64 * j); };
    issue(0, F.gw); issue(1, F.gw + F.NGW);
    for (int r0 = F.gw; r0 < M; r0 += 2 * F.NGW)
#pragma unroll
        for (int q = 0; q < 2; ++q) { const int r = r0 + q * F.NGW; if (r >= M) break;
            f32x4 v[4]; const int p = r % LP;
#pragma unroll
            for (int j = 0; j < 4; ++j) { v[j] = vr[q][j]; if (p < PADL) v[j] = (f32x4){0.f, 0.f, 0.f, 0.f}; }
            issue(q, r + 2 * F.NGW);
            store_h_row(H + (size_t)r * D, F.lane, v);
            const float rstd = row_rstd(F, v);
            store_row_bf16g(U + (size_t)r * D, v, rstd, gn, F.lane); }
}
__device__ __forceinline__ void phase_norm_rows(const Frame& F, const float* gain, bf16* U) {
    const bf16* H = (const bf16*)(F.ws + WS_H);
    f32x4 gn[4];
#pragma unroll
    for (int j = 0; j < 4; ++j) gn[j] = gld<f32x4>((const f32x4*)gain + F.lane + 64 * j);
    u32x2 rw[4][4];
#pragma unroll
    for (int q = 0; q < 4; ++q) { const int r = F.gw + q * F.NGW < M ? F.gw + q * F.NGW : F.gw;
#pragma unroll
        for (int j = 0; j < 4; ++j) rw[q][j] = *(const GAS u32x2*)gp((const u32x2*)(H + (size_t)r * D) + F.lane + 64 * j); }
    for (int r0 = F.gw; r0 < M; r0 += 4 * F.NGW)
#pragma unroll
        for (int q = 0; q < 4; ++q) { const int r = r0 + q * F.NGW; if (r >= M) break;
            f32x4 v[4];
#pragma unroll
            for (int j = 0; j < 4; ++j) { const u32x2 w = rw[q][j]; v[j] = (f32x4){bflo(w.x), bfhi(w.x), bflo(w.y), bfhi(w.y)}; }
            { const int rn = r + 4 * F.NGW < M ? r + 4 * F.NGW : r;
#pragma unroll
              for (int j = 0; j < 4; ++j) rw[q][j] = *(const GAS u32x2*)gp((const u32x2*)(H + (size_t)rn * D) + F.lane + 64 * j); }
            const float rstd = row_rstd(F, v);
            store_row_bf16g(U + (size_t)r * D, v, rstd, gn, F.lane); }
}
__device__ __forceinline__ void phase_rope_table(const Frame& F) {
    float* ct = (float*)(F.ws + WS_ROPE); float* st = ct + LP * 16;
    for (int i = F.bid * NTHREADS + F.tid; i < LP * 16; i += F.G * NTHREADS) {
        const int p = i >> 4, k = i & 15; const int pos = p - PADL;
        const float inv = exp2f(-(float)k * 0.83048202372184059f);
        const float ang = (float)(pos < 0 ? 0 : pos) * inv;
        const float c_hi = 0.15915494309189535f;
        const float c_lo = 6.420638326565253e-09f;
        const float t_hi = ang * c_hi; const float e = fmaf(ang, c_hi, -t_hi);
        float fr = t_hi - rintf(t_hi); fr += e + ang * c_lo;
        ct[i] = __builtin_amdgcn_cosf(fr); st[i] = __builtin_amdgcn_sinf(fr);
    }
}

namespace att {
typedef float f32x16 __attribute__((ext_vector_type(16)));
typedef short s16x4 __attribute__((ext_vector_type(4)));
typedef short v4i16_t __attribute__((ext_vector_type(4)));
constexpr int KS = 208, VS = 192, KBUF = 64 * KS, VBUF = 64 * VS, BUF = KBUF + VBUF;
constexpr int NUNIT = BATCH * 8 * 33;
__device__ __forceinline__ int crow(int r, int hi) { return (r & 3) + 8 * (r >> 2) + 4 * hi; }
__device__ __forceinline__ unsigned cvtpk(float lo, float hi) { unsigned r; asm volatile("v_cvt_pk_bf16_f32 %0, %1, %2" : "=v"(r) : "v"(lo), "v"(hi)); return r; }
__device__ __forceinline__ s16x4 vtr(const LAS unsigned char* p) { return __builtin_bit_cast(s16x4, __builtin_amdgcn_ds_read_tr16_b64_v4i16((LAS v4i16_t*)p)); }
__device__ __forceinline__ float xhalf_max(float m) { auto rr = __builtin_amdgcn_permlane32_swap(__float_as_uint(m), __float_as_uint(m), false, false); return fmaxf(__uint_as_float(rr[0]), __uint_as_float(rr[1])); }
__device__ __forceinline__ float xhalf_sum(float m) { auto rr = __builtin_amdgcn_permlane32_swap(__float_as_uint(m), __float_as_uint(m), false, false); return __uint_as_float(rr[0]) + __uint_as_float(rr[1]); }

__device__ __forceinline__ void unit(const Frame& F, int b, int h, int qb) {
    const int tid = F.tid, lane = F.lane, wave = F.wave, r32 = lane & 31, hi = lane >> 5;
    bf16* Q = (bf16*)(F.dout + DO_Q); const bf16* Kg = (const bf16*)(F.dout + DO_K) + (size_t)b * LP * QKW + h * 96; const bf16* Vg = (const bf16*)(F.ws + WS_V) + (size_t)b * LP * VW + h * 64;
    const int pw = 256 * qb + 32 * wave;
    const int Tl = (4 * qb + 3) < 129 ? (4 * qb + 3) : 129;
    const int twr = pw >> 6;
    const int tw = (pw >= LP) ? 0 : (twr < 129 ? twr : 129);
    const int qp = pw + r32, qpc = qp < LP ? qp : LP - 1;
    bf16x8 qf[6];
    { const bf16* qrow = Q + ((size_t)b * LP + qpc) * QKW + h * 96 + 8 * hi;
#pragma unroll
      for (int ks = 0; ks < 6; ++ks) qf[ks] = *(const GAS bf16x8*)gp(qrow + 16 * ks); }
    const int kr0 = tid / 12, kc0 = tid % 12, kr1 = (512 + tid) / 12, kc1 = (512 + tid) % 12, vr = tid >> 3, vc = tid & 7;
    const bf16* kg0 = Kg + (size_t)kr0 * QKW + kc0 * 8; const bf16* kg1 = Kg + (size_t)kr1 * QKW + kc1 * 8; const bf16* vg = Vg + (size_t)vr * VW + vc * 8;
    LAS unsigned char* lds = F.lds;
    const int kl0 = kr0 * KS + kc0 * 16, kl1 = kr1 * KS + kc1 * 16, vl = KBUF + vr * VS + vc * 16;
    const int koff = r32 * KS + 16 * hi;
    const int voff = KBUF + (4 * hi + ((lane & 15) >> 2)) * VS + (16 * ((lane >> 4) & 1) + 4 * (lane & 3)) * 2;
    u32x4 kA0, kA1 = zero4(), vA;
#define ATT_LOAD(k0_, k1_, v_, tt) do { const int tc_ = (tt) <= Tl ? (tt) : Tl; const size_t ko_ = (size_t)(64 * tc_) * QKW, vo_ = (size_t)(64 * tc_) * VW; \
        k0_ = *(const GAS u32x4*)gp(kg0 + ko_); if (tid < 256) k1_ = *(const GAS u32x4*)gp(kg1 + ko_); v_ = *(const GAS u32x4*)gp(vg + vo_); } while (0)
#define ATT_WRITE(k0_, k1_, v_, bufi) do { LAS unsigned char* nb_ = lds + (bufi) * BUF; *(LAS u32x4*)(nb_ + kl0) = k0_; if (tid < 256) *(LAS u32x4*)(nb_ + kl1) = k1_; *(LAS u32x4*)(nb_ + vl) = v_; } while (0)
#define ATT_QK(P0, P1, bufi) do { const LAS unsigned char* kq_ = lds + (bufi) * BUF + koff; \
        _Pragma("unroll") for (int ks = 0; ks < 6; ++ks) { const bf16x8 a0 = *(const LAS bf16x8*)(kq_ + 32 * ks), a1 = *(const LAS bf16x8*)(kq_ + 32 * KS + 32 * ks); \
            P0 = __builtin_amdgcn_mfma_f32_32x32x16_bf16(a0, qf[ks], P0, 0, 0, 0); P1 = __builtin_amdgcn_mfma_f32_32x32x16_bf16(a1, qf[ks], P1, 0, 0, 0); } } while (0)
#define ATT_MASK(P0, P1, tt) do { const int kbase = 64 * (tt) + 4 * hi; \
        _Pragma("unroll") for (int r = 0; r < 16; ++r) { const int key = kbase + (r & 3) + 8 * (r >> 2); \
            if (key > qp || key < PADL) P0[r] = -1e30f; if (key + 32 > qp || key + 32 < PADL) P1[r] = -1e30f; } } while (0)
    ATT_LOAD(kA0, kA1, vA, 1); ATT_WRITE(kA0, kA1, vA, 0);
    ATT_LOAD(kA0, kA1, vA, 2); ATT_WRITE(kA0, kA1, vA, 1);
    __syncthreads();
    float m = -1e30f, l = 0.f; f32x16 o0 = {}, o1 = {}, p0 = {}, p1 = {};
    if (tw >= 1) { ATT_QK(p0, p1, 0); ATT_MASK(p0, p1, 1); }
    int cur = 0;
    for (int t = 1; t <= Tl; ++t) {
        ATT_LOAD(kA0, kA1, vA, t + 2);
        const int nx1 = cur == 2 ? 0 : cur + 1, nx2 = nx1 == 2 ? 0 : nx1 + 1;
        if (t <= tw) {
            const LAS unsigned char* kb = lds + cur * BUF; const LAS unsigned char* kq_ = lds + nx1 * BUF + koff;
            bf16x8 kf0[3], kf1[3];
#pragma unroll
            for (int ks = 0; ks < 3; ++ks) { kf0[ks] = *(const LAS bf16x8*)(kq_ + 32 * ks); kf1[ks] = *(const LAS bf16x8*)(kq_ + 32 * KS + 32 * ks); }
            __builtin_amdgcn_sched_barrier(0);
            float rm = fmaxf(p0[0], p1[0]);
#pragma unroll
            for (int r = 1; r < 16; ++r) rm = fmaxf(rm, fmaxf(p0[r], p1[r]));
            rm = xhalf_max(rm);
            const float mn = fmaxf(m, rm), alpha = __builtin_amdgcn_exp2f(m - mn); m = mn;
            __builtin_amdgcn_sched_barrier(0);
            f32x16 n0 = {}, n1 = {};
#pragma unroll
            for (int ks = 0; ks < 3; ++ks) { n0 = __builtin_amdgcn_mfma_f32_32x32x16_bf16(kf0[ks], qf[ks], n0, 0, 0, 0); n1 = __builtin_amdgcn_mfma_f32_32x32x16_bf16(kf1[ks], qf[ks], n1, 0, 0, 0); }
            __builtin_amdgcn_sched_barrier(0);
#pragma unroll
            for (int ks = 0; ks < 3; ++ks) { kf0[ks] = *(const LAS bf16x8*)(kq_ + 32 * (ks + 3)); kf1[ks] = *(const LAS bf16x8*)(kq_ + 32 * KS + 32 * (ks + 3)); }
            __builtin_amdgcn_sched_barrier(0);
            float ls = 0.f;
#pragma unroll
            for (int r = 0; r < 16; ++r) { p0[r] = __builtin_amdgcn_exp2f(p0[r] - mn); ls += p0[r]; }
            __builtin_amdgcn_sched_barrier(0);
#pragma unroll
            for (int ks = 0; ks < 3; ++ks) { n0 = __builtin_amdgcn_mfma_f32_32x32x16_bf16(kf0[ks], qf[ks + 3], n0, 0, 0, 0); n1 = __builtin_amdgcn_mfma_f32_32x32x16_bf16(kf1[ks], qf[ks + 3], n1, 0, 0, 0); }
            __builtin_amdgcn_sched_barrier(0);
            s16x4 vlo[8], vhi[8];
#pragma unroll
            for (int s_ = 0; s_ < 4; ++s_)
#pragma unroll
                for (int d0 = 0; d0 < 2; ++d0) { const LAS unsigned char* vp = kb + voff + (32 * (s_ >> 1) + 16 * (s_ & 1)) * VS + 64 * d0; vlo[2 * s_ + d0] = vtr(vp); vhi[2 * s_ + d0] = vtr(vp + 8 * VS); }
            __builtin_amdgcn_sched_barrier(0);
#pragma unroll
            for (int r = 0; r < 16; ++r) { p1[r] = __builtin_amdgcn_exp2f(p1[r] - mn); ls += p1[r]; }
            l = l * alpha + ls;
            if (!__all(alpha == 1.f)) {
#pragma unroll
                for (int r = 0; r < 16; ++r) { o0[r] *= alpha; o1[r] *= alpha; } }
            bf16x8 pb[4];
#pragma unroll
            for (int s_ = 0; s_ < 4; ++s_) { u32x4 w;
                if (s_ < 2) { w.x = cvtpk(p0[8 * s_], p0[8 * s_ + 1]); w.y = cvtpk(p0[8 * s_ + 2], p0[8 * s_ + 3]); w.z = cvtpk(p0[8 * s_ + 4], p0[8 * s_ + 5]); w.w = cvtpk(p0[8 * s_ + 6], p0[8 * s_ + 7]); }
                else { const int q_ = 8 * (s_ - 2); w.x = cvtpk(p1[q_], p1[q_ + 1]); w.y = cvtpk(p1[q_ + 2], p1[q_ + 3]); w.z = cvtpk(p1[q_ + 4], p1[q_ + 5]); w.w = cvtpk(p1[q_ + 6], p1[q_ + 7]); }
                pb[s_] = __builtin_bit_cast(bf16x8, w); }
#pragma unroll
            for (int s_ = 0; s_ < 4; ++s_) {
                const bf16x8 af0 = (bf16x8){vlo[2 * s_][0], vlo[2 * s_][1], vlo[2 * s_][2], vlo[2 * s_][3], vhi[2 * s_][0], vhi[2 * s_][1], vhi[2 * s_][2], vhi[2 * s_][3]};
                const bf16x8 af1 = (bf16x8){vlo[2 * s_ + 1][0], vlo[2 * s_ + 1][1], vlo[2 * s_ + 1][2], vlo[2 * s_ + 1][3], vhi[2 * s_ + 1][0], vhi[2 * s_ + 1][1], vhi[2 * s_ + 1][2], vhi[2 * s_ + 1][3]};
                o0 = __builtin_amdgcn_mfma_f32_32x32x16_bf16(af0, pb[s_], o0, 0, 0, 0); o1 = __builtin_amdgcn_mfma_f32_32x32x16_bf16(af1, pb[s_], o1, 0, 0, 0); }
            if (t + 1 == twr) ATT_MASK(n0, n1, t + 1);
            p0 = n0; p1 = n1;
        }
        ATT_WRITE(kA0, kA1, vA, nx2); __syncthreads(); cur = nx1;
    }
#undef ATT_LOAD
#undef ATT_WRITE
#undef ATT_QK
#undef ATT_MASK
    const float lt = xhalf_sum(l); const float inv = (qp >= PADL && lt > 0.f) ? 1.f / lt : 0.f;
    if (qp < LP && !F.dry) { bf16* orow = (bf16*)(F.ws + WS_O) + ((size_t)b * LP + qp) * 512 + h * 64 + 4 * hi;
#pragma unroll
        for (int g4 = 0; g4 < 4; ++g4) { u32x2 w0, w1;
            w0.x = cvtpk(o0[4 * g4] * inv, o0[4 * g4 + 1] * inv); w0.y = cvtpk(o0[4 * g4 + 2] * inv, o0[4 * g4 + 3] * inv);
            w1.x = cvtpk(o1[4 * g4] * inv, o1[4 * g4 + 1] * inv); w1.y = cvtpk(o1[4 * g4 + 2] * inv, o1[4 * g4 + 3] * inv);
            gst<u32x2>(orow + 8 * g4, w0); gst<u32x2>(orow + 32 + 8 * g4, w1); } }
}
__device__ __forceinline__ void phase(const Frame& F, int layer) {
    const int xg = F.bid & 7;
    unsigned* ctl = (unsigned*)(F.ws + WS_CTL) + CW_ATTQ + 64 * ((2 * layer + F.dry) * 8 + xg);
    volatile LAS int* slot = (volatile LAS int*)(F.lds + MISC_OFF + 64);
    for (;;) {
        if (F.tid == 0) slot[0] = (int)atomicAdd(ctl, 1u);
        __syncthreads();
        const int i = __builtin_amdgcn_readfirstlane(slot[0]);
        __syncthreads();
        if (i >= NUNIT / 8) break;
        const int qb = 32 - (i >> 2), bh = 4 * xg + (i & 3);
        unit(F, bh >> 3, bh & 7, qb);
    }
}
}

namespace mla {
__device__ __forceinline__ void fix(const Frame& F, int layer) {
    const bf16* Ym = (const bf16*)(F.ws + WS_YM);
    bf16* Q = (bf16*)(F.dout + DO_Q); bf16* Kb = (bf16*)(F.dout + DO_K); bf16* V = (bf16*)(F.ws + WS_V);
    const float* qn = inptr(8) + layer * 96; const float* kn = inptr(9) + layer * 96;
    const float* ct = (const float*)(F.ws + WS_ROPE); const float* st = ct + LP * 16;
    const int lane = F.lane, h = lane >> 3, sub = lane & 7;
    f32x4 qg0 = *(const GAS f32x4*)gp(qn + 8 * sub), qg1 = *(const GAS f32x4*)gp(qn + 8 * sub + 4), kg0 = *(const GAS f32x4*)gp(kn + 8 * sub), kg1 = *(const GAS f32x4*)gp(kn + 8 * sub + 4);
    const f32x2 qr1 = *(const GAS f32x2*)gp(qn + 64 + 2 * sub), qr2 = *(const GAS f32x2*)gp(qn + 80 + 2 * sub), kr1 = *(const GAS f32x2*)gp(kn + 64 + 2 * sub), kr2 = *(const GAS f32x2*)gp(kn + 80 + 2 * sub);
    struct Ld { u32x2 dqw; unsigned dkw, krw, qa, qb, ka, kb_; u32x4 qw, kw, vw; f32x2 c, sn; };
    auto load_row = [&](int r) { Ld d; const int rc = r < M ? r : F.gw; const int p = rc % LP; const bf16* y = Ym + (size_t)rc * YW;
        const bf16* qrow = Q + (size_t)rc * QKW + h * 96; const bf16* krow = Kb + (size_t)rc * QKW + h * 96; const bf16* vrow = V + (size_t)rc * VW + h * 64;
        d.dqw = *(const GAS u32x2*)gp(y + C_DQ + 4 * lane); d.dkw = *(const GAS unsigned*)gp(y + C_DKV + 2 * lane);
        d.krw = *(const GAS unsigned*)gp(y + C_KR + 2 * (lane & 15));
        d.qw = *(const GAS u32x4*)gp(qrow + 8 * sub); d.qa = *(const GAS unsigned*)gp(qrow + 64 + 2 * sub); d.qb = *(const GAS unsigned*)gp(qrow + 80 + 2 * sub);
        d.kw = *(const GAS u32x4*)gp(krow + 8 * sub); d.vw = *(const GAS u32x4*)gp(vrow + 8 * sub);
        d.ka = *(const GAS unsigned*)gp(y + C_KR + 2 * sub); d.kb_ = *(const GAS unsigned*)gp(y + C_KR + 16 + 2 * sub);
        d.c = *(const GAS f32x2*)gp(ct + (size_t)p * 16 + 2 * sub); d.sn = *(const GAS f32x2*)gp(st + (size_t)p * 16 + 2 * sub); return d; };
    Ld nx = load_row(F.gw);
    for (int r = F.gw; r < M; r += F.NGW) {
        const Ld d = nx; nx = load_row(r + F.NGW);
        bf16* qrow = Q + (size_t)r * QKW + h * 96; bf16* krow = Kb + (size_t)r * QKW + h * 96; bf16* vrow = V + (size_t)r * VW + h * 64;
        const u32x2 dqw = d.dqw; const unsigned dkw = d.dkw, krw = d.krw, qa = d.qa, qb = d.qb, ka = d.ka, kb_ = d.kb_; const u32x4 qw = d.qw, kw = d.kw, vw = d.vw; const f32x2 c = d.c, sn = d.sn;
        const float rsq = frsq(wave_sum(F.lane, bflo(dqw.x) * bflo(dqw.x) + bfhi(dqw.x) * bfhi(dqw.x) + bflo(dqw.y) * bflo(dqw.y) + bfhi(dqw.y) * bfhi(dqw.y)) * (1.f / 256.f) + EPS);
        const float rskv = frsq(wave_sum(F.lane, bflo(dkw) * bflo(dkw) + bfhi(dkw) * bfhi(dkw)) * (1.f / 128.f) + EPS);
        float krs = bflo(krw) * bflo(krw) + bfhi(krw) * bfhi(krw);
        krs = sum16(krs);
        { float e[8] = {bflo(qw.x), bfhi(qw.x), bflo(qw.y), bfhi(qw.y), bflo(qw.z), bfhi(qw.z), bflo(qw.w), bfhi(qw.w)}; float x1[2] = {bflo(qa), bfhi(qa)}, x2[2] = {bflo(qb), bfhi(qb)};
          float ss = 0.f;
#pragma unroll
          for (int i = 0; i < 8; ++i) { e[i] *= rsq; ss += e[i] * e[i]; }
#pragma unroll
          for (int i = 0; i < 2; ++i) { x1[i] *= rsq; x2[i] *= rsq; ss += x1[i] * x1[i] + x2[i] * x2[i]; }
          ss = sum8(ss);
          const float sc = QSCALE * frsq(ss * (1.f / 96.f) + EPS);
          u32x4 w; w.x = pk2(e[0] * sc * qg0[0], e[1] * sc * qg0[1]); w.y = pk2(e[2] * sc * qg0[2], e[3] * sc * qg0[3]); w.z = pk2(e[4] * sc * qg1[0], e[5] * sc * qg1[1]); w.w = pk2(e[6] * sc * qg1[2], e[7] * sc * qg1[3]);
          if (!F.dry) *(GAS u32x4*)gpw(qrow + 8 * sub) = w;
          const float a0 = x1[0] * sc * qr1[0], a1 = x1[1] * sc * qr1[1], b0 = x2[0] * sc * qr2[0], b1 = x2[1] * sc * qr2[1];
          if (!F.dry) *(GAS unsigned*)gpw(qrow + 64 + 2 * sub) = pk2(a0 * c[0] - b0 * sn[0], a1 * c[1] - b1 * sn[1]); if (!F.dry) *(GAS unsigned*)gpw(qrow + 80 + 2 * sub) = pk2(a0 * sn[0] + b0 * c[0], a1 * sn[1] + b1 * c[1]); }
        { float e[8] = {bflo(kw.x), bfhi(kw.x), bflo(kw.y), bfhi(kw.y), bflo(kw.z), bfhi(kw.z), bflo(kw.w), bfhi(kw.w)}; float ss = 0.f;
#pragma unroll
          for (int i = 0; i < 8; ++i) { e[i] *= rskv; ss += e[i] * e[i]; }
          ss = sum8(ss);
          const float sc = frsq((ss + krs) * (1.f / 96.f) + EPS);
          u32x4 w; w.x = pk2(e[0] * sc * kg0[0], e[1] * sc * kg0[1]); w.y = pk2(e[2] * sc * kg0[2], e[3] * sc * kg0[3]); w.z = pk2(e[4] * sc * kg1[0], e[5] * sc * kg1[1]); w.w = pk2(e[6] * sc * kg1[2], e[7] * sc * kg1[3]);
          if (!F.dry) *(GAS u32x4*)gpw(krow + 8 * sub) = w;
          const float a0 = bflo(ka) * sc * kr1[0], a1 = bfhi(ka) * sc * kr1[1], b0 = bflo(kb_) * sc * kr2[0], b1 = bfhi(kb_) * sc * kr2[1];
          if (!F.dry) *(GAS unsigned*)gpw(krow + 64 + 2 * sub) = pk2(a0 * c[0] - b0 * sn[0], a1 * c[1] - b1 * sn[1]); if (!F.dry) *(GAS unsigned*)gpw(krow + 80 + 2 * sub) = pk2(a0 * sn[0] + b0 * c[0], a1 * sn[1] + b1 * c[1]);
          u32x4 wv; wv.x = pk2(bflo(vw.x) * rskv, bfhi(vw.x) * rskv); wv.y = pk2(bflo(vw.y) * rskv, bfhi(vw.y) * rskv); wv.z = pk2(bflo(vw.z) * rskv, bfhi(vw.z) * rskv); wv.w = pk2(bflo(vw.w) * rskv, bfhi(vw.w) * rskv);
          if (!F.dry) *(GAS u32x4*)gpw(vrow + 8 * sub) = wv; }
    }
}
}

constexpr size_t WS_C12 = 551 * MiB;
constexpr int NCHUNK = LP / 64;
__device__ __forceinline__ void phase_lin_prep(const Frame& F, int layer) {
    bf16* Ym = (bf16*)(F.ws + WS_YM); float* c1g = (float*)(F.ws + WS_C12);
    const int lane = F.lane;
    LAS float* bbl = (LAS float*)(F.lds + F.wave * 16384) + lane;
    for (int u = F.gw; u < BATCH * NCHUNK * 12; u += F.NGW) {
        const int chunk = u / 12, sub = u % 12, b = chunk / NCHUNK, n = chunk % NCHUNK;
        const bool HG = sub >= 4; const int h = HG ? (sub - 4) >> 1 : sub; const int i = HG ? ((sub - 4) & 1) * 64 + lane : lane; const int DK = HG ? 128 : 64;
        const int ch = h * DK + i; const int cq = (HG ? C_HQ : C_GQ) + ch, ck = (HG ? C_HF : C_GK) + ch;
        bf16* y0 = Ym + ((size_t)b * LP + 64 * n) * YW;
        const int tpad = PADL - 64 * n;
        float run = 0.f, lb = 0.f;
        unsigned kq[128];
#define LP_ISSUE() do { _Pragma("unroll") for (int t = 0; t < 64; ++t) { const bf16* y = y0 + (size_t)t * YW; kq[t] = gld<bf16>(y + ck); kq[64 + t] = gld<bf16>(y + cq); } } while (0)
        if (!HG) { const float* w_g2 = inptr(10) + (size_t)layer * 16 * 256; const float bg = inptr(11)[layer * 256 + ch]; float wg[16];
#pragma unroll
            for (int rr = 0; rr < 16; ++rr) wg[rr] = gld<float>(w_g2 + rr * 256 + ch);
#pragma unroll 16
            for (int t = 0; t < 64; ++t) { const bf16* y = y0 + (size_t)t * YW; const u32x4 g0 = gld<u32x4>(y + C_GGD), g1 = gld<u32x4>(y + C_GGD + 8);
                const float z = bg + bflo(g0.x) * wg[0] + bfhi(g0.x) * wg[1] + bflo(g0.y) * wg[2] + bfhi(g0.y) * wg[3] + bflo(g0.z) * wg[4] + bfhi(g0.z) * wg[5] + bflo(g0.w) * wg[6] + bfhi(g0.w) * wg[7]
                              + bflo(g1.x) * wg[8] + bfhi(g1.x) * wg[9] + bflo(g1.y) * wg[10] + bfhi(g1.y) * wg[11] + bflo(g1.z) * wg[12] + bfhi(g1.z) * wg[13] + bflo(g1.w) * wg[14] + bfhi(g1.w) * wg[15];
                float lg = -(fmaxf(-z, 0.f) + flog(1.f + __expf(-fabsf(z)))) * (1.f / 16.f);
                if (t < tpad) lg = 0.f;
                run += lg; bbl[64 * t] = run; }
            LP_ISSUE();
        } else { if (layer == 1) { const float* lbp = inptr(13); lb = 1.f / (1.f + __expf(lbp[ch] - lbp[512 + ch])); }
            LP_ISSUE();
#pragma unroll
            for (int t = 0; t < 64; ++t) { const float f = lb + (1.f - lb) * sigmoidf_(bf2f((bf16)kq[t])); float lg = flog(fmaxf(f, 1e-30f));
                kq[t] = __builtin_bit_cast(unsigned, f);
                if (t < tpad) lg = 0.f;
                run += lg; bbl[64 * t] = run; } }
#undef LP_ISSUE
        const float bref = run;
#pragma unroll
        for (int t = 0; t < 64; ++t) { bf16* y = y0 + (size_t)t * YW; float q, k;
            if (!HG) { q = bf2f((bf16)kq[64 + t]) * 0.125f; k = bf2f((bf16)kq[t]); }
            else { q = siluf_(bf2f((bf16)kq[64 + t])); k = 1.f - __builtin_bit_cast(float, kq[t]); }
            if (t < tpad) { q = 0.f; k = 0.f; }
            const float d = fminf(bbl[64 * t] - bref, 80.f);
            if (!F.dry) { gst<bf16>(y + cq, (bf16)f2bf(q * __expf(d))); gst<bf16>(y + ck, (bf16)f2bf(k * __expf(-d))); } }
        if (!F.dry) gst<float>(c1g + chunk * 768 + (HG ? 256 + ch : ch), __expf(bref));
    }
}
namespace lin {
typedef float f32x16 __attribute__((ext_vector_type(16)));
using att::vtr; using att::cvtpk; using att::crow; using att::xhalf_sum; typedef att::s16x4 s16x4;
constexpr int NSEG = 4;
constexpr size_t WS_SLOC = 553 * MiB;
constexpr size_t WS_DTOT = 561 * MiB;
template <int DK, bool HG>
__device__ __forceinline__ void pass1(const Frame& F, int b, int h, int n0, int nc, float* sloc, float* dtot) {
    constexpr int QS = DK * 2 + 16, VSt = 320, QB = 64 * QS, VB = 64 * VSt, CB = DK * 4, BUFB = QB + VB + CB, NI = DK / 32, NO = NI / 2, QCH = DK / 8;
    constexpr int NQC = 64 * QCH, NL = (NQC + 1024) / NTHREADS; static_assert(NQC % NTHREADS == 0 && 2 * BUFB <= RING_BYTES, "pass1 staging");
    const bf16* Ym = (const bf16*)(F.ws + WS_YM); const float* c1g = (const float*)(F.ws + WS_C12);
    const int tid = F.tid, lane = F.lane, wave = F.wave, j = wave & 3, th = wave >> 2, hi = lane >> 5;
    const int ck = (HG ? C_HF : C_GK) + h * DK, cv = (HG ? C_HI : C_GV) + h * 128, cc = (HG ? 256 : 0) + h * DK;
    LAS unsigned char* lds = F.lds;
    unsigned gsrc[NL]; int ldst[NL];
#pragma unroll
    for (int k = 0; k < NL; ++k) { const int reg = (NTHREADS * k) / NQC;
        if (reg < 1) { const int e2 = tid + NTHREADS * k, r = e2 / QCH, c = e2 % QCH; gsrc[k] = (unsigned)(r * YW + ck + 8 * c); ldst[k] = r * QS + 16 * c; }
        else { const int e3 = tid + NTHREADS * k - NQC, r = e3 >> 4, c = e3 & 15; gsrc[k] = (unsigned)(r * YW + cv + 8 * c); ldst[k] = QB + r * VSt + 16 * c; } }
    const size_t rowb = (size_t)b * LP;
    float S[NO][16];
#pragma unroll
    for (int i = 0; i < NO; ++i)
#pragma unroll
        for (int r = 0; r < 16; ++r) S[i][r] = 0.f;
    f32x4 prod;
    { const size_t ro = (rowb + 64 * n0) * YW; u32x4 st[NL];
#pragma unroll
      for (int k = 0; k < NL; ++k) st[k] = *(const GAS u32x4*)gp(Ym + ro + gsrc[k]);
      const f32x4 cst = *(const GAS f32x4*)gp(c1g + (size_t)(b * NCHUNK + n0) * 768 + cc + 4 * (tid & (DK / 4 - 1)));
#pragma unroll
      for (int k = 0; k < NL; ++k) *(LAS u32x4*)(lds + ldst[k]) = st[k];
      if (tid < DK / 4) *(LAS f32x4*)(lds + QB + VB + 16 * tid) = cst;
      prod = cst; }
    __syncthreads();
    const int trq = (lane & 15) >> 2, trc = (16 * ((lane >> 4) & 1) + 4 * (lane & 3)) * 2;
    int cur = 0;
    for (int c = 0; c < nc; ++c) {
        const bool more = c + 1 < nc; const int nn = n0 + c + (more ? 1 : 0); const size_t ron = (rowb + 64 * nn) * YW; LAS unsigned char* nb = lds + (cur ^ 1) * BUFB;
        u32x4 st[NL];
#pragma unroll
        for (int k = 0; k < NL; ++k) st[k] = *(const GAS u32x4*)gp(Ym + ron + gsrc[k]);
        const f32x4 cst = *(const GAS f32x4*)gp(c1g + (size_t)(b * NCHUNK + nn) * 768 + cc + 4 * (tid & (DK / 4 - 1)));
        const LAS unsigned char* kt = lds + cur * BUFB; const LAS unsigned char* vt = kt + QB; const LAS float* c1l = (const LAS float*)(vt + VB);
#pragma unroll
        for (int ii = 0; ii < NO; ++ii) { const int i = th + 2 * ii;
#pragma unroll
            for (int g4 = 0; g4 < 4; ++g4) { const f32x4 dc = *(const LAS f32x4*)(c1l + 32 * i + 8 * g4 + 4 * hi);
#pragma unroll
                for (int e = 0; e < 4; ++e) S[ii][4 * g4 + e] *= dc[e]; }
            f32x16 T = {};
#pragma unroll
            for (int s_ = 0; s_ < 4; ++s_) { const LAS unsigned char* kp = kt + (16 * s_ + 8 * hi + trq) * QS + 64 * i + trc; const LAS unsigned char* vp = vt + (16 * s_ + 8 * hi + trq) * VSt + 64 * j + trc;
                const s16x4 ka = vtr(kp), kb2 = vtr(kp + 4 * QS), va = vtr(vp), vb2 = vtr(vp + 4 * VSt);
                T = __builtin_amdgcn_mfma_f32_32x32x16_bf16((bf16x8){ka[0], ka[1], ka[2], ka[3], kb2[0], kb2[1], kb2[2], kb2[3]}, (bf16x8){va[0], va[1], va[2], va[3], vb2[0], vb2[1], vb2[2], vb2[3]}, T, 0, 0, 0); }
#pragma unroll
            for (int r = 0; r < 16; ++r) S[ii][r] += T[r]; }
#pragma unroll
        for (int k = 0; k < NL; ++k) *(LAS u32x4*)(nb + ldst[k]) = st[k];
        if (tid < DK / 4) *(LAS f32x4*)(nb + QB + VB + 16 * tid) = cst;
        if (more) prod = prod * cst;
        __syncthreads();
        cur ^= 1;
    }
#pragma unroll
    for (int ii = 0; ii < NO; ++ii) { const int i = th + 2 * ii;
#pragma unroll
        for (int r = 0; r < 16; ++r) *(GAS float*)gpw(sloc + (size_t)(((i * 4 + j) * 16 + r) * 64 + lane)) = S[ii][r]; }
    if (tid < DK / 4) *(GAS f32x4*)gpw((f32x4*)dtot + tid) = prod;
}
template <int DK, bool HG>
__device__ __forceinline__ void unit(const Frame& F, int layer, int b, int h, int seg, int uidx) {
    const int n0 = seg == 0 ? 1 : 34 + 32 * (seg - 1), nc = seg == 0 ? 33 : 32, nend = n0 + nc;
    float* slocb = (float*)(F.ws + WS_SLOC) + (size_t)uidx * NSEG * 16384; float* dtotb = (float*)(F.ws + WS_DTOT) + (size_t)uidx * NSEG * 128;
    unsigned* cnt = (unsigned*)(F.ws + WS_CTL) + CW_LINC + 64 * ((2 * layer + F.dry) * 32 + uidx);
    pass1<DK, HG>(F, b, h, n0, nc, slocb + (size_t)seg * 16384, dtotb + seg * 128);
    asm volatile("s_waitcnt vmcnt(0)" ::: "memory");
    __syncthreads();
    if (F.tid == 0) { __builtin_amdgcn_fence(__ATOMIC_RELEASE, "agent"); asm volatile("s_waitcnt vmcnt(0)" ::: "memory"); (void)xb_add(cnt, 1u);
        if (seg > 0) { unsigned sp = 0; while (xb_ld(cnt) < (unsigned)NSEG) { __builtin_amdgcn_s_sleep(2); if (++sp > (1u << 22)) break; }
            __builtin_amdgcn_fence(__ATOMIC_ACQUIRE, "agent"); asm volatile("s_waitcnt vmcnt(0)" ::: "memory"); } }
    __syncthreads();
    constexpr int QS = DK * 2 + 16, VSt = 320, QB = 64 * QS, VB = 64 * VSt, CB = DK * 4, BUFB = 2 * QB + VB + CB, XCO = BUFB, SSO = XCO + 32768, ONO = SSO + 1024, NI = DK / 32, NO = NI / 2, QCH = DK / 8;
    static_assert(ONO + 512 <= RING_BYTES, "lin LDS");
    constexpr int NQC = 64 * QCH, NLD = (2 * NQC + 1024) / NTHREADS; static_assert(NQC % NTHREADS == 0, "staging regions");
    bf16* Ym = (bf16*)(F.ws + WS_YM); const float* c1g = (const float*)(F.ws + WS_C12);
    const int tid = F.tid, lane = F.lane, wave = F.wave, j = wave & 3, th = wave >> 2, r32 = lane & 31, hi = lane >> 5;
    const int cq = (HG ? C_HQ : C_GQ) + h * DK, ck = (HG ? C_HF : C_GK) + h * DK, cv = (HG ? C_HI : C_GV) + h * 128, cg = (HG ? C_HG : C_GR) + h * 128, cc = (HG ? 256 : 0) + h * DK;
    LAS unsigned char* lds = F.lds;
    unsigned gsrc[NLD]; int ldst[NLD];
#pragma unroll
    for (int k = 0; k < NLD; ++k) { const int reg = (NTHREADS * k) / NQC;
        if (reg < 2) { const int e2 = tid + NTHREADS * k - reg * NQC, r = e2 / QCH, c = e2 % QCH; gsrc[k] = (unsigned)(r * YW + (reg == 0 ? cq : ck) + 8 * c); ldst[k] = reg * QB + r * QS + 16 * c; }
        else { const int e3 = tid + NTHREADS * k - 2 * NQC, r = e3 >> 4, c = e3 & 15; gsrc[k] = (unsigned)(r * YW + cv + 8 * c); ldst[k] = 2 * QB + r * VSt + 16 * c; } }
    const size_t rowb = (size_t)b * LP;
    if (tid < 128) ((LAS float*)(lds + ONO))[tid] = (inptr(HG ? 14 : 12) + layer * 128)[tid];
    float S[NO][16];
#pragma unroll
    for (int i = 0; i < NO; ++i)
#pragma unroll
        for (int r = 0; r < 16; ++r) S[i][r] = 0.f;
#pragma unroll 1
    for (int g = 0; g < seg; ++g) {
#pragma unroll
        for (int ii = 0; ii < NO; ++ii) { const int i = th + 2 * ii;
#pragma unroll
            for (int g4 = 0; g4 < 4; ++g4) { const f32x4 dd = *(const GAS f32x4*)gp(dtotb + g * 128 + 32 * i + 8 * g4 + 4 * hi);
#pragma unroll
                for (int e = 0; e < 4; ++e) { const int r = 4 * g4 + e; S[ii][r] = dd[e] * S[ii][r] + *(const GAS float*)gp(slocb + (size_t)g * 16384 + ((i * 4 + j) * 16 + r) * 64 + lane); } } } }
    { const size_t ro = (rowb + 64 * n0) * YW;
#pragma unroll
      for (int k = 0; k < NLD; ++k) { const u32x4 v = *(const GAS u32x4*)gp(Ym + ro + gsrc[k]); *(LAS u32x4*)(lds + ldst[k]) = v; }
      if (tid < DK / 4) { const f32x4 cst = *(const GAS f32x4*)gp(c1g + (size_t)(b * NCHUNK + n0) * 768 + cc + 4 * tid); *(LAS f32x4*)(lds + 2 * QB + VB + 16 * tid) = cst; } }
    __syncthreads();
    const LAS unsigned char* qt = lds; const LAS unsigned char* kt = qt + QB; const LAS unsigned char* vt = kt + QB; const LAS float* c1l = (const LAS float*)(vt + VB);
    const int trq = (lane & 15) >> 2, trc = (16 * ((lane >> 4) & 1) + 4 * (lane & 3)) * 2;
    for (int n = n0; n < nend; ++n) {
        const int nn = n + 1 < nend ? n + 1 : n; const size_t ron = (rowb + 64 * nn) * YW;
        u32x4 st[NLD];
#pragma unroll
        for (int k = 0; k < NLD; ++k) st[k] = *(const GAS u32x4*)gp(Ym + ron + gsrc[k]);
        const f32x4 cst = *(const GAS f32x4*)gp(c1g + (size_t)(b * NCHUNK + nn) * 768 + cc + 4 * (tid & (DK / 4 - 1)));
        bf16* yrow = Ym + (rowb + 64 * n + 32 * th + r32) * YW;
        u32x2 gt[4];
#pragma unroll
        for (int g4 = 0; g4 < 4; ++g4) gt[g4] = *(const GAS u32x2*)gp(yrow + cg + 32 * j + 8 * g4 + 4 * hi);
        f32x16 o = {};
#pragma unroll
        for (int jb = 0; jb < 2; ++jb) { f32x16 AT = {};
#pragma unroll
            for (int ks = 0; ks < DK / 16; ++ks) { const bf16x8 bq = *(const LAS bf16x8*)(qt + (32 * th + r32) * QS + 32 * ks + 16 * hi);
                const bf16x8 ak = *(const LAS bf16x8*)(kt + (32 * jb + r32) * QS + 32 * ks + 16 * hi);
                AT = __builtin_amdgcn_mfma_f32_32x32x16_bf16(ak, bq, AT, 0, 0, 0); }
            int tq = 32 * th + r32 - 32 * jb;
            asm volatile("" : "+v"(tq));
#pragma unroll
            for (int r = 0; r < 16; ++r) AT[r] = (crow(r, hi) > tq) ? 0.f : AT[r];
#pragma unroll
            for (int sp = 0; sp < 2; ++sp) { u32x4 w; w.x = cvtpk(AT[8 * sp], AT[8 * sp + 1]); w.y = cvtpk(AT[8 * sp + 2], AT[8 * sp + 3]); w.z = cvtpk(AT[8 * sp + 4], AT[8 * sp + 5]); w.w = cvtpk(AT[8 * sp + 6], AT[8 * sp + 7]);
                const LAS unsigned char* vp = vt + (32 * jb + 16 * sp + 4 * hi + trq) * VSt + 64 * j + trc;
                const s16x4 lo = vtr(vp), h4 = vtr(vp + 8 * VSt);
                o = __builtin_amdgcn_mfma_f32_32x32x16_bf16((bf16x8){lo[0], lo[1], lo[2], lo[3], h4[0], h4[1], h4[2], h4[3]}, __builtin_bit_cast(bf16x8, w), o, 0, 0, 0); }
            __builtin_amdgcn_sched_barrier(0); }
        f32x16 op = {};
#pragma unroll
        for (int ii = 0; ii < NO; ++ii) { const int i = th + 2 * ii;
#pragma unroll
            for (int g4 = 0; g4 < 4; ++g4) { const f32x4 dc = *(const LAS f32x4*)(c1l + 32 * i + 8 * g4 + 4 * hi);
#pragma unroll
                for (int e = 0; e < 4; ++e) S[ii][4 * g4 + e] *= dc[e]; }
#pragma unroll
            for (int sp = 0; sp < 2; ++sp) { u32x4 w; w.x = cvtpk(S[ii][8 * sp], S[ii][8 * sp + 1]); w.y = cvtpk(S[ii][8 * sp + 2], S[ii][8 * sp + 3]); w.z = cvtpk(S[ii][8 * sp + 4], S[ii][8 * sp + 5]); w.w = cvtpk(S[ii][8 * sp + 6], S[ii][8 * sp + 7]);
                const LAS unsigned char* qo_ = qt + (32 * th + r32) * QS + (32 * i + 16 * sp + 4 * hi) * 2; const LAS unsigned char* qp_ = qt + (32 * (th ^ 1) + r32) * QS + (32 * i + 16 * sp + 4 * hi) * 2;
                const u32x2 b0 = *(const LAS u32x2*)qo_, b1 = *(const LAS u32x2*)(qo_ + 16), c0 = *(const LAS u32x2*)qp_, c1 = *(const LAS u32x2*)(qp_ + 16);
                o = __builtin_amdgcn_mfma_f32_32x32x16_bf16(__builtin_bit_cast(bf16x8, w), __builtin_bit_cast(bf16x8, (u32x4){b0.x, b0.y, b1.x, b1.y}), o, 0, 0, 0);
                op = __builtin_amdgcn_mfma_f32_32x32x16_bf16(__builtin_bit_cast(bf16x8, w), __builtin_bit_cast(bf16x8, (u32x4){c0.x, c0.y, c1.x, c1.y}), op, 0, 0, 0); }
            f32x16 T = {};
#pragma unroll
            for (int s_ = 0; s_ < 4; ++s_) { const LAS unsigned char* kp = kt + (16 * s_ + 8 * hi + trq) * QS + 64 * i + trc; const LAS unsigned char* vp = vt + (16 * s_ + 8 * hi + trq) * VSt + 64 * j + trc;
                const s16x4 ka = vtr(kp), kb2 = vtr(kp + 4 * QS), va = vtr(vp), vb2 = vtr(vp + 4 * VSt);
                T = __builtin_amdgcn_mfma_f32_32x32x16_bf16((bf16x8){ka[0], ka[1], ka[2], ka[3], kb2[0], kb2[1], kb2[2], kb2[3]}, (bf16x8){va[0], va[1], va[2], va[3], vb2[0], vb2[1], vb2[2], vb2[3]}, T, 0, 0, 0); }
#pragma unroll
            for (int r = 0; r < 16; ++r) S[ii][r] += T[r];
            __builtin_amdgcn_sched_barrier(0); }
        { LAS float* xo = (LAS float*)(lds + XCO) + wave * 1024 + lane;
#pragma unroll
          for (int r = 0; r < 16; ++r) xo[64 * r] = op[r]; }
        __syncthreads();
        { const LAS float* xi = (const LAS float*)(lds + XCO) + (wave ^ 4) * 1024 + lane;
#pragma unroll
          for (int r = 0; r < 16; ++r) o[r] += xi[64 * r]; }
        float ssq = 0.f;
#pragma unroll
        for (int r = 0; r < 16; ++r) ssq += o[r] * o[r];
        ssq = xhalf_sum(ssq);
        LAS float* ssb = (LAS float*)(lds + SSO);
        if (hi == 0) ssb[(th * 4 + j) * 32 + r32] = ssq;
#pragma unroll
        for (int k = 0; k < NLD; ++k) *(LAS u32x4*)(lds + ldst[k]) = st[k];
        if (tid < DK / 4) *(LAS f32x4*)(lds + 2 * QB + VB + 16 * tid) = cst;
        __syncthreads();
        const float tot = ssb[(th * 4 + 0) * 32 + r32] + ssb[(th * 4 + 1) * 32 + r32] + ssb[(th * 4 + 2) * 32 + r32] + ssb[(th * 4 + 3) * 32 + r32];
        const float rstd = frsq(tot * (1.f / 128.f) + EPS);
#pragma unroll
        for (int g4 = 0; g4 < 4; ++g4) { const f32x4 on = *(const LAS f32x4*)(lds + ONO + (32 * j + 8 * g4 + 4 * hi) * 4);
            const float v0 = o[4 * g4] * rstd * on[0] * siluf_(bflo(gt[g4].x)), v1 = o[4 * g4 + 1] * rstd * on[1] * siluf_(bfhi(gt[g4].x));
            const float v2 = o[4 * g4 + 2] * rstd * on[2] * siluf_(bflo(gt[g4].y)), v3 = o[4 * g4 + 3] * rstd * on[3] * siluf_(bfhi(gt[g4].y));
            u32x2 w; w.x = cvtpk(v0, v1); w.y = cvtpk(v2, v3); if (!F.dry) *(GAS u32x2*)gpw(yrow + cv + 32 * j + 8 * g4 + 4 * hi) = w; }
    }
    __syncthreads();
}
}
__device__ __forceinline__ void phase_linattn(const Frame& F, int layer) {
    if (F.bid < 32 * lin::NSEG) { const int seg = F.bid >> 5, u = F.bid & 31, br = u >> 4, b = (u >> 2) & 3, h = u & 3;
        if (br == 0) lin::unit<64, false>(F, layer, b, h, seg, u); else lin::unit<128, true>(F, layer, b, h, seg, u); }
}

__device__ __forceinline__ void phase_route(const Frame& F, const float* gain) {
    const bf16* H = (const bf16*)(F.ws + WS_H); const float* wr_ = inptr(23); const float* br_ = inptr(24);
    int* asg_e = (int*)(F.ws + WS_SMALL + SM_ASG_E); int* asg_i = (int*)(F.ws + WS_SMALL + SM_ASG_I); float* asg_w = (float*)(F.ws + WS_SMALL + SM_ASG_W);
    unsigned* ctl = (unsigned*)(F.ws + WS_CTL);
    f32x4 wa[4][4], wc[4][4];
#pragma unroll
    for (int j = 0; j < 4; ++j) { const f32x4 g = gld<f32x4>((const f32x4*)gain + F.lane + 64 * j); const f32x4* w0 = (const f32x4*)(wr_ + (size_t)(4 * (F.lane + 64 * j)) * 8);
#pragma unroll
        for (int kk = 0; kk < 4; ++kk) { wa[j][kk] = gld<f32x4>(w0 + 2 * kk) * g[kk]; wc[j][kk] = gld<f32x4>(w0 + 2 * kk + 1) * g[kk]; } }
    float brr[8];
#pragma unroll
    for (int e = 0; e < 8; ++e) brr[e] = gld<float>(br_ + e);
    constexpr int NT = BATCH * SEQ;
    int me1 = 0, me2 = 0, mt = -1, kit = 0; float mw1 = 0.f;
    u32x2 rw[4][4];
    const int npw_ = (NT + F.NGW - 1) / F.NGW, tw0 = F.gw * npw_, tw1 = (tw0 + npw_) < NT ? (tw0 + npw_) : NT;
#pragma unroll
    for (int q = 0; q < 4; ++q) { const int tq = tw0 + q < tw1 ? tw0 + q : tw0, b = tq / SEQ, r = b * LP + 128 + (tq - b * SEQ);
#pragma unroll
        for (int j = 0; j < 4; ++j) rw[q][j] = *(const GAS u32x2*)gp((const u32x2*)(H + (size_t)r * D) + F.lane + 64 * j); }
    for (int t0 = tw0; t0 < tw1; t0 += 4)
#pragma unroll
    for (int q = 0; q < 4; ++q) { const int t = t0 + q; if (t >= tw1) break;
        f32x4 v[4];
#pragma unroll
        for (int j = 0; j < 4; ++j) { const u32x2 w = rw[q][j]; v[j] = (f32x4){bflo(w.x), bfhi(w.x), bflo(w.y), bfhi(w.y)}; }
        { const int tn = t + 4 < tw1 ? t + 4 : t, b = tn / SEQ, r = b * LP + 128 + (tn - b * SEQ);
#pragma unroll
          for (int j = 0; j < 4; ++j) rw[q][j] = *(const GAS u32x2*)gp((const u32x2*)(H + (size_t)r * D) + F.lane + 64 * j); }
        const float rstd = row_rstd(F, v);
        float lg[8];
#pragma unroll
        for (int e = 0; e < 8; ++e) lg[e] = 0.f;
#pragma unroll
        for (int j = 0; j < 4; ++j) {
#pragma unroll
            for (int kk = 0; kk < 4; ++kk) { const float uu = v[j][kk] * rstd; const f32x4 a = wa[j][kk], c = wc[j][kk];
                lg[0] += uu * a.x; lg[1] += uu * a.y; lg[2] += uu * a.z; lg[3] += uu * a.w; lg[4] += uu * c.x; lg[5] += uu * c.y; lg[6] += uu * c.z; lg[7] += uu * c.w; } }
#pragma unroll
        for (int e = 0; e < 8; ++e) lg[e] = wave_sum(F.lane, lg[e]) + brr[e];
        int e1 = 0; float v1 = lg[0];
#pragma unroll
        for (int e = 1; e < 8; ++e) if (lg[e] > v1) { v1 = lg[e]; e1 = e; }
        int e2 = -1; float v2 = -INFINITY;
#pragma unroll
        for (int e = 0; e < 8; ++e) if (e != e1 && lg[e] > v2) { v2 = lg[e]; e2 = e; }
        const float w1 = 1.f / (1.f + __expf(v2 - v1)), w2 = 1.f - w1;
        if (F.lane == kit) { me1 = e1; me2 = e2; mw1 = w1; mt = t; }
        ++kit; (void)w2;
    }
    const int npw = (NT + F.NGW - 1) / F.NGW, K = NWAVES * npw;
    LAS int* le = (LAS int*)F.lds; LAS int* lt = le + 1024; LAS float* lw = (LAS float*)(le + 1536); LAS unsigned* lbase = (LAS unsigned*)(le + 2048);
    __syncthreads();
    if (F.lane < npw) { const int k = F.wave * npw + F.lane; le[k] = mt >= 0 ? me1 : -1; le[512 + k] = mt >= 0 ? me2 : -1; lt[k] = mt; lw[k] = mw1; }
    __syncthreads();
    int my_e[2] = {-1, -1}, my_r[2] = {0, 0}, my_k[2] = {0, 0};
#pragma unroll
    for (int q = 0; q < 2; ++q) { const int x = F.tid + q * NTHREADS; if (x < 2 * K) { const int rk = x / K, k = x - rk * K; const int e = le[rk * 512 + k]; int cnt = 0, rnk = 0;
            for (int k2 = 0; k2 < K; ++k2) { const int ee = le[rk * 512 + k2]; cnt += (ee == e) ? 1 : 0; rnk += (ee == e && k2 < k) ? 1 : 0; }
            my_e[q] = e; my_r[q] = rnk; my_k[q] = x;
            if (e >= 0 && rnk == 0 && !F.dry) lbase[rk * 8 + e] = atomicAdd(ctl + CW_CNT + 64 * (rk * 8 + e), (unsigned)cnt); } }
    __syncthreads();
#pragma unroll
    for (int q = 0; q < 2; ++q) if (my_e[q] >= 0 && !F.dry) { const int x = my_k[q], rk = x / K, k = x - rk * K, t = lt[k]; const float w1 = lw[k];
        asg_e[rk * 32768 + t] = my_e[q]; asg_i[rk * 32768 + t] = (int)(lbase[rk * 8 + my_e[q]] + (unsigned)my_r[q]); asg_w[rk * 32768 + t] = rk ? 1.f - w1 : w1; }
    __syncthreads();
}
__device__ __forceinline__ void phase_scatter(const Frame& F, const float* gain) {
    const bf16* H = (const bf16*)(F.ws + WS_H);
    const int* asg_e = (const int*)(F.ws + WS_SMALL + SM_ASG_E); const int* asg_i = (const int*)(F.ws + WS_SMALL + SM_ASG_I); const float* asg_w = (const float*)(F.ws + WS_SMALL + SM_ASG_W);
    int* slot_tok = (int*)(F.ws + WS_SMALL + SM_SLOT_TOK); float* slot_w = (float*)(F.ws + WS_SMALL + SM_SLOT_W);
    int* tile_e = (int*)(F.ws + WS_SMALL + SM_TILE_E); int* ntl = (int*)(F.ws + WS_SMALL + SM_NT);
    unsigned* ctl = (unsigned*)(F.ws + WS_CTL);
    unsigned char* xb[2] = {F.ws + WS_XB, F.ws + WS_XB + (size_t)MOE_ROWS * D};
    LAS int* tb = (LAS int*)(F.lds + TAB_OFF);
    if (F.tid < 16) tb[16 + F.tid] = (int)xb_ld(ctl + CW_CNT + 64 * F.tid);
    __syncthreads();
    if (F.tid == 0) {
#pragma unroll 1
        for (int rk = 0; rk < 2; ++rk) { int t = 0;
#pragma unroll 1
            for (int e = 0; e < 8; ++e) { tb[rk * 8 + e] = t; const int nt_ = (tb[16 + rk * 8 + e] + 255) >> 8;
                if (F.bid == 0) {
#pragma unroll 1
                    for (int q = 0; q < nt_; ++q) tile_e[rk * 256 + t + q] = e; }
                t += nt_; }
            if (F.bid == 0) ntl[rk] = t; } }
    __syncthreads();
    for (int g = 0; g < 16; ++g) { const int rk = g >> 3, cnt = tb[16 + g], base = tb[g] * 256, end = base + ((cnt + 255) >> 8) * 256;
        for (int s = base + cnt + F.gw; s < end; s += F.NGW) { if (F.lane == 0) { slot_tok[rk * MOE_ROWS + s] = -1; slot_w[rk * MOE_ROWS + s] = 0.f; }
            u32x4* xr = (u32x4*)(xb[rk] + (size_t)s * D); xr[F.lane] = zero4(); } }
    constexpr int NT = BATCH * SEQ;
    const int npw = (NT + F.NGW - 1) / F.NGW, tw0 = F.gw * npw, tw1 = (tw0 + npw) < NT ? (tw0 + npw) : NT;
    int ae[2], ai[2]; float aw[2];
    { const int tl = tw0 + F.lane < tw1 ? tw0 + F.lane : (tw0 < NT ? tw0 : 0);
#pragma unroll
      for (int rk = 0; rk < 2; ++rk) { ae[rk] = gld<int>(asg_e + rk * 32768 + tl); ai[rk] = gld<int>(asg_i + rk * 32768 + tl); aw[rk] = gld<float>(asg_w + rk * 32768 + tl); } }
    f32x4 gn[4];
#pragma unroll
    for (int j = 0; j < 4; ++j) gn[j] = gld<f32x4>((const f32x4*)gain + F.lane + 64 * j);
    u32x2 rw[4][4];
#pragma unroll
    for (int q = 0; q < 4; ++q) { const int tq = tw0 + q < tw1 ? tw0 + q : (tw0 < NT ? tw0 : 0), b = tq / SEQ, r = b * LP + 128 + (tq - b * SEQ);
#pragma unroll
        for (int j = 0; j < 4; ++j) rw[q][j] = *(const GAS u32x2*)gp((const u32x2*)(H + (size_t)r * D) + F.lane + 64 * j); }
    for (int t0 = tw0; t0 < tw1; t0 += 4)
#pragma unroll
    for (int q = 0; q < 4; ++q) { const int t = t0 + q; if (t >= tw1) break;
        const int b = t / SEQ, r = b * LP + 128 + (t - b * SEQ), k = t - tw0;
        f32x4 v[4];
#pragma unroll
        for (int j = 0; j < 4; ++j) { const u32x2 w = rw[q][j]; v[j] = (f32x4){bflo(w.x), bfhi(w.x), bflo(w.y), bfhi(w.y)}; }
        { const int tn = t + 4 < tw1 ? t + 4 : t, bn = tn / SEQ, rn = bn * LP + 128 + (tn - bn * SEQ);
#pragma unroll
          for (int j = 0; j < 4; ++j) rw[q][j] = *(const GAS u32x2*)gp((const u32x2*)(H + (size_t)rn * D) + F.lane + 64 * j); }
        const float rstd = row_rstd(F, v);
#pragma unroll
        for (int rk = 0; rk < 2; ++rk) { const int e = __builtin_amdgcn_readlane(ae[rk], k), s = tb[rk * 8 + e] * 256 + __builtin_amdgcn_readlane(ai[rk], k);
            const float wgt = __builtin_bit_cast(float, __builtin_amdgcn_readlane(__builtin_bit_cast(int, aw[rk]), k)); const float sc = rstd * XB_SCALE;
            unsigned* o4 = (unsigned*)(xb[rk] + (size_t)s * D) + F.lane;
#pragma unroll
            for (int j = 0; j < 4; ++j) gst<unsigned>(o4 + 64 * j, pg8::fp8x4((f32x4){v[j].x * sc * gn[j].x, v[j].y * sc * gn[j].y, v[j].z * sc * gn[j].z, v[j].w * sc * gn[j].w}));
            if (F.lane == 0) { gst<int>(slot_tok + rk * MOE_ROWS + s, r); gst<float>(slot_w + rk * MOE_ROWS + s, wgt); } }
    }
}
__device__ __forceinline__ void convert_expert_weights(const Frame& F) {
    unsigned char* GU = F.ws + WS_WEXP; unsigned char* DT = F.ws + WS_WEXP + (size_t)8 * 7168 * 1024;
    LAS float* scr = (LAS float*)(F.lds + F.wave * 16384);
    for (int it = F.gw; it < NEXP * 3 * 1792; it += F.NGW) {
        const int e = it / 5376, r = it - e * 5376, m = r / 1792, t = r - m * 1792;
        if (m < 2) { const int kb = t / 112, n0 = (t % 112) * 32; const float* W = inptr(m == 0 ? 25 : 26) + (size_t)e * D * DEXP;
            transpose_tile<true>(W, (size_t)DEXP, kb * 64, n0, 32, (bf16*)(GU + (size_t)e * 7168 * 1024), (size_t)D, 256 * (n0 / 128) + (n0 % 128) + 128 * m, kb * 64, nullptr, WU_SCALE, scr, F.lane); }
        else { const int kb = t / 32, n0 = (t % 32) * 32; const float* W = inptr(27) + (size_t)e * DEXP * D;
            transpose_tile<true>(W, (size_t)D, kb * 64, n0, 32, (bf16*)(DT + (size_t)e * 1024 * DEXP), (size_t)DEXP, n0, kb * 64, nullptr, WD_SCALE, scr, F.lane); }
    }
}
__device__ __forceinline__ void convert_ffn_weights(const Frame& F) {
    bf16* GU = (bf16*)(F.ws + WS_WFF); bf16* DT = GU + (size_t)2 * DFF * D;
    conv_matrix<1>(F, inptr(20), D, DFF, DFF, 0, GU, D, 0, nullptr);
    conv_matrix<1>(F, inptr(21), D, DFF, DFF, 0, GU, D, 128, nullptr);
    conv_matrix<0>(F, inptr(22), DFF, D, D, 0, DT, DFF, 0, nullptr);
}

namespace sk {
constexpr int CW_ERR = 32768;
constexpr size_t WS_DBG = 110 * MiB;
template <int NACC>
__device__ __forceinline__ void dot16(const bf16* A, size_t lda, const bf16* W0, const bf16* W1, size_t ldb, int nk, int lane, f32x4 (&acc)[NACC]) {
    const int i = lane & 15, kq = lane >> 4;
    const bf16* ap = A + (size_t)i * lda + 8 * kq; const bf16* w0 = W0 + (size_t)i * ldb + 8 * kq; const bf16* w1 = W1 + (size_t)i * ldb + 8 * kq;
#pragma unroll 1
    for (int s = 0; s < nk; s += 4) {
        bf16x8 a[4], b0[4], b1[4];
#pragma unroll
        for (int q = 0; q < 4; ++q) { const int ss = (s + q < nk) ? s + q : s;
            a[q] = *(const GAS bf16x8*)gp((const bf16x8*)(ap + 32 * ss)); b0[q] = *(const GAS bf16x8*)gp((const bf16x8*)(w0 + 32 * ss));
            if (NACC == 2) b1[q] = *(const GAS bf16x8*)gp((const bf16x8*)(w1 + 32 * ss)); }
#pragma unroll
        for (int q = 0; q < 4; ++q) if (s + q < nk) { acc[0] = __builtin_amdgcn_mfma_f32_16x16x32_bf16(b0[q], a[q], acc[0], 0, 0, 0);
            if (NACC == 2) acc[1] = __builtin_amdgcn_mfma_f32_16x16x32_bf16(b1[q], a[q], acc[1], 0, 0, 0); }
    }
}
template <int NACC>
__device__ __forceinline__ void reduce8(const Frame& F, f32x4 (&acc)[NACC]) {
    LAS f32x4* red = (LAS f32x4*)F.lds;
#pragma unroll
    for (int a = 0; a < NACC; ++a) red[(a * 8 + F.wave) * 64 + F.lane] = acc[a];
    __syncthreads();
    if (F.wave == 0) {
#pragma unroll
        for (int a = 0; a < NACC; ++a) { f32x4 s = red[(a * 8) * 64 + F.lane];
#pragma unroll
            for (int w = 1; w < 8; ++w) s += red[(a * 8 + w) * 64 + F.lane];
            acc[a] = s; } }
}
struct Cnt { unsigned n, e; };
__device__ __forceinline__ void chk(Cnt& C, float mine, float ref, float rel, float ab) {
#ifdef SK_EXACT
    rel = 0.f; ab = 0.f;
#endif
    C.n += 1u; if (!(fabsf(mine - ref) <= rel * fmaxf(fabsf(mine), fabsf(ref)) + ab)) C.e += 1u;
}
__device__ __forceinline__ void flush(const Frame& F, const Cnt& C) {
    unsigned* ctl = (unsigned*)(F.ws + WS_CTL);
    if (C.n) atomicAdd(ctl + CW_ERR + 64, C.n);
    if (C.e) atomicAdd(ctl + CW_ERR, C.e);
}
__device__ __forceinline__ u32x2 pack4(const f32x4 v) { u32x2 w; w.x = pg8::cvt_pk_bf16(v[0], v[1]); w.y = pg8::cvt_pk_bf16(v[2], v[3]); return w; }
template <bool CHECK>
__device__ __forceinline__ void put4(const Frame& F, Cnt& C, bf16* dst, size_t rs, const f32x4 v, int nb, float rel, float ab) {
    const u32x2 w = pack4(v);
#pragma unroll
    for (int b = 0; b < 4; ++b) if (b < nb) { u32x2* p = (u32x2*)(dst + (size_t)b * LP * rs);
        if (CHECK) { const u32x2 m = gld<u32x2>(p); chk(C, bflo(w.x), bflo(m.x), rel, ab); chk(C, bfhi(w.x), bfhi(m.x), rel, ab); chk(C, bflo(w.y), bflo(m.y), rel, ab); chk(C, bfhi(w.y), bfhi(m.y), rel, ab); }
        else if (!F.dry) gst<u32x2>(p, w); }
}
template <bool CHECK>
__device__ __forceinline__ void inproj(const Frame& F) { Cnt C{0u, 0u};
    const bf16* U = (const bf16*)(F.dout + DO_U) + (size_t)PADL * D; const bf16* W = (const bf16*)(F.ws + WS_WL + WL_IN);
    bf16* Ym = (bf16*)(F.ws + WS_YM); unsigned char* Yg = F.ws + WS_SKG;
    if (!CHECK && !F.dry) { const u32x4 z4 = zero4();
        for (int idx = F.bid * NTHREADS + F.tid; idx < BATCH * PADL * (YW / 8); idx += F.G * NTHREADS) { const int row = idx / (YW / 8), c8 = idx % (YW / 8), b = row / PADL, p = row % PADL;
            gst<u32x4>(Ym + ((size_t)b * LP + p) * YW + 8 * c8, z4); } }
    for (int g = F.bid; g < 251 + 192; g += F.G) {
        const int wrow = g < 251 ? 16 * g : YW + 16 * (g - 251);
        f32x4 acc[1] = {(f32x4){0.f, 0.f, 0.f, 0.f}};
        dot16<1>(U + 128 * F.wave, D, W + (size_t)wrow * D + 128 * F.wave, W, D, 4, F.lane, acc);
        reduce8<1>(F, acc);
        if (F.wave == 0) { const int i = F.lane & 15, c = 4 * (F.lane >> 4);
            if (g < 251) put4<CHECK>(F, C, Ym + (size_t)(PADL + i) * YW + 16 * g + c, YW, acc[0], 4, 0.01f, 1e-3f);
            else { const unsigned w = pg8::q8(acc[0][0]) | (pg8::q8(acc[0][1]) << 8) | (pg8::q8(acc[0][2]) << 16) | (pg8::q8(acc[0][3]) << 24);
                unsigned* p = (unsigned*)(Yg + (size_t)i * NGATE + 16 * (g - 251) + c);
                if (CHECK) { const unsigned m = w;
#pragma unroll
                    for (int e = 0; e < 4; ++e) chk(C, (float)((w >> (8 * e)) & 255u), (float)((m >> (8 * e)) & 255u), 0.f, 1.f); }
                else if (!F.dry) *p = w; } }
        __syncthreads();
    }
    if (CHECK) flush(F, C);
}
template <bool CHECK>
__device__ __forceinline__ void mlaprep(const Frame& F) { Cnt C{0u, 0u};
    const bf16* Ym0 = (const bf16*)(F.ws + WS_YM) + (size_t)PADL * YW; const bf16* W = (const bf16*)(F.ws + WS_WL + WL_UQKV);
    bf16* Q = (bf16*)(F.dout + DO_Q); bf16* Kb = (bf16*)(F.dout + DO_K); bf16* V = (bf16*)(F.ws + WS_V);
    if (!CHECK && !F.dry) { const u32x4 z4 = zero4();
        for (int idx = F.bid * NTHREADS + F.tid; idx < BATCH * PADL * 256; idx += F.G * NTHREADS) { const int row = idx >> 8, c = idx & 255, b = row / PADL, p = row % PADL; const size_t r = (size_t)b * LP + p;
            if (c < 96) gst<u32x4>(Q + r * QKW + 8 * c, z4); else if (c < 192) gst<u32x4>(Kb + r * QKW + 8 * (c - 96), z4); else gst<u32x4>(V + r * VW + 8 * (c - 192), z4); } }
    for (int g = F.bid; g < 48 + 64; g += F.G) {
        const bool kv = g >= 48; const int n0 = kv ? 16 * (g - 48) : 16 * g;
        f32x4 acc[1] = {(f32x4){0.f, 0.f, 0.f, 0.f}};
        dot16<1>(Ym0 + (kv ? C_DKV : C_DQ) + 32 * F.wave, YW, W + (size_t)((kv ? 768 : 0) + n0) * 256 + 32 * F.wave, W, 256, 1, F.lane, acc);
        reduce8<1>(F, acc);
        if (F.wave == 0) { const int i = F.lane & 15, c = n0 + 4 * (F.lane >> 4); const size_t r = (size_t)(PADL + i);
            if (!kv) put4<CHECK>(F, C, Q + r * QKW + c, QKW, acc[0], 4, 0.01f, 1e-3f);
            else { const int hh = c >> 7, d = c & 127;
                if (d < 64) put4<CHECK>(F, C, Kb + r * QKW + hh * 96 + d, QKW, acc[0], 4, 0.01f, 1e-3f); else put4<CHECK>(F, C, V + r * VW + hh * 64 + d - 64, VW, acc[0], 4, 0.01f, 1e-3f); } }
        __syncthreads();
    }
    if (CHECK) flush(F, C);
}
template <bool CHECK>
__device__ __forceinline__ void mix(const Frame& F) { Cnt C{0u, 0u};
    const bf16* Ym0 = (const bf16*)(F.ws + WS_YM) + (size_t)PADL * YW; const bf16* O0 = (const bf16*)(F.ws + WS_O) + (size_t)PADL * 512; const unsigned char* Yg0 = F.ws + WS_SKG;
    bf16* Mx = (bf16*)(F.dout + DO_MIX); unsigned char* wl = F.ws + WS_WL;
    const int w = F.wave, I = w < 4 ? 0 : (w < 6 ? 1 : 2);
    const bf16* A = I == 0 ? O0 + 128 * w : (I == 1 ? Ym0 + C_GV + 256 * (w - 4) : Ym0 + C_HI + 256 * (w - 6));
    const size_t lda = I == 0 ? 512 : YW, ldb = 512; const int nk = I == 0 ? 4 : 8;
    const bf16* Wb = I == 0 ? (const bf16*)(wl + WL_OM) + 128 * w : (I == 1 ? (const bf16*)(wl + WL_OG) + 256 * (w - 4) : (const bf16*)(wl + WL_OH) + 256 * (w - 6));
    for (int g = F.bid; g < 64; g += F.G) {
        f32x4 acc[1] = {(f32x4){0.f, 0.f, 0.f, 0.f}};
        dot16<1>(A, lda, Wb + (size_t)(16 * g) * ldb, Wb, ldb, nk, F.lane, acc);
        const int i = F.lane & 15, c = 16 * g + 4 * (F.lane >> 4);
        const unsigned gw = gld<unsigned>(Yg0 + (size_t)i * NGATE + I * 1024 + c); const float s = 1.f / 255.f;
        acc[0][0] *= (float)(gw & 255u) * s; acc[0][1] *= (float)((gw >> 8) & 255u) * s; acc[0][2] *= (float)((gw >> 16) & 255u) * s; acc[0][3] *= (float)(gw >> 24) * s;
        reduce8<1>(F, acc);
        if (F.wave == 0) put4<CHECK>(F, C, Mx + (size_t)(PADL + i) * D + c, D, acc[0], 1, 0.03f, 3e-3f);
        __syncthreads();
    }
    if (CHECK) flush(F, C);
}
template <bool CHECK>
__device__ __forceinline__ void resid(const Frame& F, const bf16* A0, size_t lda, const bf16* W, int K, const bf16* hold) { Cnt C{0u, 0u};
    bf16* H = (bf16*)(F.ws + WS_H); const int nk = K / 256, k0 = (K / 8) * F.wave;
    for (int g = F.bid; g < 64; g += F.G) {
        f32x4 acc[1] = {(f32x4){0.f, 0.f, 0.f, 0.f}};
        dot16<1>(A0 + k0, lda, W + (size_t)(16 * g) * K + k0, W, (size_t)K, nk, F.lane, acc);
        reduce8<1>(F, acc);
        if (F.wave == 0) { const int i = F.lane & 15, c = 16 * g + 4 * (F.lane >> 4);
            const u32x2 x = gld<u32x2>(hold + (size_t)i * D + c);
            const f32x4 v = acc[0] + (f32x4){bflo(x.x), bfhi(x.x), bflo(x.y), bfhi(x.y)};
            put4<CHECK>(F, C, H + (size_t)(PADL + i) * D + c, D, v, 4, 0.01f, 1e-3f); }
        __syncthreads();
    }
    if (CHECK) flush(F, C);
}
template <bool CHECK>
__device__ __forceinline__ void ffn_up(const Frame& F) { Cnt C{0u, 0u};
    const bf16* U = (const bf16*)(F.dout + DO_U) + (size_t)PADL * D; const bf16* GU = (const bf16*)(F.ws + WS_WFF); bf16* Hm = (bf16*)(F.ws + WS_HMID);
    for (int g = F.bid; g < DFF / 16; g += F.G) {
        const int hc0 = 16 * g, r0 = 256 * (hc0 >> 7) + (hc0 & 127);
        f32x4 acc[2] = {(f32x4){0.f, 0.f, 0.f, 0.f}, (f32x4){0.f, 0.f, 0.f, 0.f}};
        dot16<2>(U + 128 * F.wave, D, GU + (size_t)r0 * D + 128 * F.wave, GU + (size_t)(r0 + 128) * D + 128 * F.wave, D, 4, F.lane, acc);
        reduce8<2>(F, acc);
        if (F.wave == 0) { const int i = F.lane & 15, c = hc0 + 4 * (F.lane >> 4); f32x4 h;
#pragma unroll
            for (int e = 0; e < 4; ++e) { const float gq = acc[0][e], uq = acc[1][e]; h[e] = gq * frcp(1.f + __expf(-gq)) * uq; }
            put4<CHECK>(F, C, Hm + (size_t)(PADL + i) * DFF + c, DFF, h, 1, 0.02f, 1e-3f); }
        __syncthreads();
    }
    if (CHECK) flush(F, C);
}
}

#ifndef SK_ERR_MAX
#define SK_ERR_MAX 200u
#endif
#ifndef SKMODE
#define SKMODE 1
#endif
enum { OP_INIT = 0, OP_INPROJ, OP_MLAPREP, OP_ATTN, OP_LIN, OP_MIX0, OP_MIX1, OP_MIX2, OP_CONV, OP_WOUT, OP_NORM_FFN, OP_FFN_UP, OP_FFN_DOWN, OP_NEXT, OP_ROUTE, OP_SCATTER, OP_MOE_UP, OP_MOE_DOWN, OP_MLAFIX, OP_NOP, OP_MLAPREP2 };
#define SW(op, layer, rh) ((unsigned)(op) | ((unsigned)(layer) << 5) | ((unsigned)(rh) << 6))
#define SWDRY(op, layer, rh) (SW(op, layer, rh) | 256u)
#ifndef STEP_PROGRAM
#define STEP_PROGRAM \
    SW(OP_INIT, 0, 0), \
    SW(OP_INPROJ, 0, 0), SW(OP_MLAPREP, 0, 0), SW(OP_MLAPREP2, 0, 0), SW(OP_MLAFIX, 0, 0), SW(OP_ATTN, 0, 0), SW(OP_MIX0, 0, 0), SW(OP_MIX1, 0, 0), SW(OP_MIX2, 0, 0), SW(OP_CONV, 0, 0), SW(OP_WOUT, 0, 0), \
    SW(OP_NORM_FFN, 0, 0), SW(OP_FFN_UP, 0, 0), SW(OP_FFN_DOWN, 0, 0), SW(OP_NEXT, 0, 0), \
    SW(OP_INPROJ, 1, 0), SW(OP_MLAPREP, 1, 0), SW(OP_MLAPREP2, 1, 0), SW(OP_MLAFIX, 1, 0), SW(OP_ATTN, 1, 0), SW(OP_MIX0, 1, 0), SW(OP_MIX1, 1, 0), SW(OP_MIX2, 1, 0), SW(OP_CONV, 1, 0), SW(OP_WOUT, 1, 0), \
    SW(OP_ROUTE, 1, 0), SW(OP_SCATTER, 1, 0), \
    SW(OP_MOE_UP, 1, 0), SW(OP_MOE_DOWN, 1, 0), SW(OP_MOE_UP, 1, 1), SW(OP_MOE_DOWN, 1, 1)
#endif
__device__ __forceinline__ unsigned step_word(int st) {
    constexpr unsigned prog[] = {STEP_PROGRAM};
    unsigned w = 0;
#pragma unroll
    for (int i = 0; i < (int)(sizeof(prog) / sizeof(prog[0])); ++i) w = (st == i) ? prog[i] : w;
    return w;
}
constexpr unsigned step_prog_host[] = {STEP_PROGRAM};
constexpr int NSTEP = (int)(sizeof(step_prog_host) / sizeof(step_prog_host[0]));
__global__ void __launch_bounds__(NTHREADS, 2) fwd_kernel(Args args) {
    extern __shared__ __attribute__((aligned(16))) unsigned char lds_raw[];
    Frame F;
    F.lds = (LAS unsigned char*)lds_raw; F.ws = args.ws; F.dout = (unsigned char*)args.out;
    F.tid = threadIdx.x; F.lane = F.tid & 63; F.wave = __builtin_amdgcn_readfirstlane(F.tid >> 6);
    F.G = gridDim.x; F.bid = blockIdx.x; F.gw = F.bid * NWAVES + F.wave; F.NGW = F.G * NWAVES;
    volatile LAS unsigned* MISC = (volatile LAS unsigned*)(F.lds + MISC_OFF);
    for (int u = F.tid; u < (LDS_BYTES - LDSCTL_OFF) / 4; u += NTHREADS) ((LAS unsigned*)(F.lds + LDSCTL_OFF))[u] = 0u;
    __syncthreads();
    unsigned* ctl = (unsigned*)(F.ws + WS_CTL);
    XcdBarrier bar = xcd_barrier_post(ctl + CW_BAR, MISC + 8);
    const int wave0 = F.wave;
#pragma unroll 1
    for (int st = args.ph_lo; st < args.ph_hi; ++st) {
        { unsigned char* p_ = args.ws; asm volatile("" : "+s"(p_)); F.ws = p_; p_ = (unsigned char*)args.out; asm volatile("" : "+s"(p_)); F.dout = p_;
          int wv_ = wave0; asm volatile("" : "+s"(wv_)); int ln_; asm volatile("v_mbcnt_lo_u32_b32 %0, -1, 0\n\tv_mbcnt_hi_u32_b32 %0, -1, %0" : "=v"(ln_)); int tid_ = wv_ * 64 + ln_; int bid_ = blockIdx.x; asm volatile("" : "+s"(bid_)); int G_ = gridDim.x; asm volatile("" : "+s"(G_));
          unsigned lo_ = 0; asm volatile("" : "+s"(lo_));
          F.lds = (LAS unsigned char*)lds_raw + lo_; F.tid = tid_; F.lane = tid_ & 63; F.wave = __builtin_amdgcn_readfirstlane(tid_ >> 6); F.G = G_; F.bid = bid_; F.gw = bid_ * NWAVES + F.wave; F.NGW = G_ * NWAVES; }
        LAS unsigned char* ring = F.lds;
        int layer, op, rh = 0;
        { const unsigned pw = step_word(st); op = pw & 31; layer = (pw >> 5) & 1; rh = (pw >> 6) & 3; F.dry = (pw >> 8) & 1; }
        bool is_gemm = false, sync_after = true, fp8 = false;
        pg8::Gemm g{nullptr, nullptr, 0, 0, 0}; pg8::Order S{0, 0, 0, F.G, F.bid, 0, 0, 0, (const LAS int*)(F.lds + TAB_OFF), 0, 0}; pg8::Epi E{0, nullptr, nullptr, nullptr, nullptr, 0, 0, F.dry, 1.f, 0.f};
        unsigned char* wl = F.ws + WS_WL;
        constexpr int XM = (SKMODE == 1) ? 1 : 0;
#if SKMODE == 1
        if (op == OP_INPROJ) sk::inproj<false>(F);
        else if (op == OP_MLAPREP) sk::mlaprep<false>(F);
        else if (op == OP_MIX0 && layer == 0) sk::mix<false>(F);
        else if (op == OP_WOUT && layer == 0) sk::resid<false>(F, (const bf16*)(F.dout + DO_MIX) + (size_t)PADL * D, D, (const bf16*)(wl + WL_OUT), D, (const bf16*)(F.ws + WS_H) + (size_t)PADL * D);
        else if (op == OP_FFN_UP) sk::ffn_up<false>(F);
        else if (op == OP_FFN_DOWN) sk::resid<false>(F, (const bf16*)(F.ws + WS_HMID) + (size_t)PADL * DFF, DFF, (const bf16*)(F.ws + WS_WFF) + (size_t)2 * DFF * D, DFF, (const bf16*)(F.ws + WS_H) + (size_t)PADL * D);
#elif SKMODE == 2
        { bool did = true; const bf16* dbg = (const bf16*)(F.ws + sk::WS_DBG);
          if (op == OP_MLAPREP) sk::inproj<true>(F);
          else if (op == OP_MLAFIX) sk::mlaprep<true>(F);
          else if (op == OP_CONV && layer == 0) sk::mix<true>(F);
          else if (op == OP_NORM_FFN) sk::resid<true>(F, (const bf16*)(F.dout + DO_MIX) + (size_t)PADL * D, D, (const bf16*)(wl + WL_OUT), D, dbg);
          else if (op == OP_FFN_DOWN) sk::ffn_up<true>(F);
          else if (op == OP_NEXT) sk::resid<true>(F, (const bf16*)(F.ws + WS_HMID) + (size_t)PADL * DFF, DFF, (const bf16*)(F.ws + WS_WFF) + (size_t)2 * DFF * D, DFF, dbg);
          else did = false;
          if ((op == OP_CONV || op == OP_FFN_UP) && layer == 0 && F.bid == 0) {
              for (int i = F.tid; i < 16 * D / 8; i += NTHREADS) *((u32x4*)(F.ws + sk::WS_DBG) + i) = *((const u32x4*)((const bf16*)(F.ws + WS_H) + (size_t)PADL * D) + i); }
          if (did) xcd_barrier(bar); }
#endif
        switch (op) {
        case OP_INIT:
            convert_layer_weights(F, 0); phase_rope_table(F); phase_init_rows(F, inptr(2)); break;
        case OP_INPROJ:
            is_gemm = true; g = pg8::Gemm{(const bf16*)(F.dout + DO_U), (const bf16*)(wl + WL_IN), D, D, D}; S.nM = XM ? 128 : M / 256; S.xrow = XM; S.nN = 28;
            E.kind = pg8::EK_INPROJ; E.o0 = F.ws + WS_YM; E.o1 = F.ws + WS_YG; break;
        case OP_MLAPREP:
            is_gemm = true; sync_after = false; g = pg8::Gemm{(const bf16*)(F.ws + WS_YM) + C_DQ, (const bf16*)(wl + WL_UQKV), 256, YW, 256}; S.nM = XM ? 128 : M / 256; S.xrow = XM; S.nN = 3;
            E.kind = pg8::EK_MLA; E.o0 = F.dout + DO_Q; E.o1 = F.dout + DO_K; E.i0 = F.ws + WS_V; E.fin = 0; break;
        case OP_MLAPREP2:
            is_gemm = true; g = pg8::Gemm{(const bf16*)(F.ws + WS_YM) + C_DKV, (const bf16*)(wl + WL_UQKV) + 768 * 256, 256, YW, 256}; S.nM = XM ? 128 : M / 256; S.xrow = XM; S.nN = 4;
            E.kind = pg8::EK_MLA; E.o0 = F.dout + DO_Q; E.o1 = F.dout + DO_K; E.i0 = F.ws + WS_V; E.fin = 3; break;
        case OP_MLAFIX: mla::fix(F, layer); phase_lin_prep(F, layer); break;
        case OP_NOP: break;
        case OP_ATTN: phase_linattn(F, layer); att::phase(F, layer); break;
        case OP_LIN: phase_linattn(F, layer); break;
        case OP_MIX0:
            is_gemm = true; sync_after = false; g = pg8::Gemm{(const bf16*)(F.ws + WS_O), (const bf16*)(wl + WL_OM), 512, 512, 512}; S.nM = (XM || layer) ? 128 : M / 256; S.xrow = (XM || layer) ? 1 : 0; S.nN = 4;
            E.kind = pg8::EK_MIX0; E.o0 = F.dout + DO_MIX; E.i0 = F.ws + WS_YG; break;
        case OP_MIX1:
            is_gemm = true; sync_after = false; g = pg8::Gemm{(const bf16*)(F.ws + WS_YM) + C_GV, (const bf16*)(wl + WL_OG), 512, YW, 512}; S.nM = (XM || layer) ? 128 : M / 256; S.xrow = (XM || layer) ? 1 : 0; S.nN = 4;
            E.kind = pg8::EK_MIX1; E.o0 = F.dout + DO_MIX; E.i0 = F.ws + WS_YG; break;
        case OP_MIX2:
            is_gemm = true; g = pg8::Gemm{(const bf16*)(F.ws + WS_YM) + C_HI, (const bf16*)(wl + WL_OH), 512, YW, 512}; S.nM = (XM || layer) ? 128 : M / 256; S.xrow = (XM || layer) ? 1 : 0; S.nN = 4;
            E.kind = pg8::EK_MIX2; E.o0 = F.dout + DO_MIX; E.i0 = F.ws + WS_YG; break;
        case OP_CONV:
            sync_after = false; if (layer == 0) convert_ffn_weights(F); else convert_expert_weights(F); break;
        case OP_WOUT:
            is_gemm = true; g = pg8::Gemm{(const bf16*)(F.dout + DO_MIX), (const bf16*)(wl + WL_OUT), D, D, D}; S.nM = (XM || layer) ? 128 : M / 256; S.xrow = (XM || layer) ? 1 : 0; S.nN = 4;
            E.kind = pg8::EK_RESID; E.o0 = F.ws + WS_H; break;
        case OP_NORM_FFN: phase_norm_rows(F, inptr(19), (bf16*)(F.dout + DO_U)); break;
        case OP_FFN_UP:
            is_gemm = true; g = pg8::Gemm{(const bf16*)(F.dout + DO_U), (const bf16*)(F.ws + WS_WFF), D, D, D}; S.nM = XM ? 128 : M / 256; S.xrow = XM; S.nN = 22;
            E.kind = pg8::EK_SWIGLU; E.o0 = F.ws + WS_HMID; E.ldo = DFF; break;
        case OP_FFN_DOWN:
            is_gemm = true; g = pg8::Gemm{(const bf16*)(F.ws + WS_HMID), (const bf16*)(F.ws + WS_WFF) + (size_t)2 * DFF * D, DFF, DFF, DFF}; S.nM = XM ? 128 : M / 256; S.xrow = XM; S.nN = 4;
            E.kind = pg8::EK_RESID; E.o0 = F.ws + WS_H; break;
        case OP_NEXT:
            convert_layer_weights(F, 1); phase_norm_rows(F, inptr(2) + D, (bf16*)(F.dout + DO_U)); break;
        case OP_ROUTE: phase_route(F, inptr(19) + D); break;
        case OP_SCATTER: phase_scatter(F, inptr(19) + D); break;
        default: {
            const int rk = rh;
            const int* tile_e = (const int*)(F.ws + WS_SMALL + SM_TILE_E) + rk * 256; const int* ntl = (const int*)(F.ws + WS_SMALL + SM_NT);
            LAS int* te = (LAS int*)(F.lds + TAB_OFF);
            const int nt_ = __builtin_amdgcn_readfirstlane(__hip_atomic_load(ntl + rk, __ATOMIC_RELAXED, __HIP_MEMORY_SCOPE_AGENT));
            for (int i = F.tid; i < 256; i += NTHREADS) te[i] = __hip_atomic_load(tile_e + i, __ATOMIC_RELAXED, __HIP_MEMORY_SCOPE_AGENT);
            const bf16* GU = (const bf16*)(F.ws + WS_WEXP); const bf16* DT = (const bf16*)(F.ws + WS_WEXP + (size_t)8 * 7168 * 1024);
            is_gemm = true; S.nM = nt_; S.grouped = 1;
            fp8 = true;
            if (op == OP_MOE_UP) { g = pg8::Gemm{(const bf16*)(F.ws + WS_XB + (size_t)rk * MOE_ROWS * D), GU, D, D, D}; S.nN = 28; S.tpe = 28; S.boff = 0;
                if (rk == 1) { const int nt0 = __builtin_amdgcn_readfirstlane(__hip_atomic_load(ntl + 0, __ATOMIC_RELAXED, __HIP_MEMORY_SCOPE_AGENT)); const int l3 = nt0 * 4 - 2 * F.G; S.late = (l3 > 0 && l3 < F.G / 2) ? l3 : 0; }
                E.kind = pg8::EK_SWIGLU; E.o0 = F.ws + WS_HQ + (size_t)rk * MOE_ROWS * DEXP; E.ldo = DEXP; E.osc = HQ_SCALE; E.isc = 1.f / (XB_SCALE * WU_SCALE); }
            else { g = pg8::Gemm{(const bf16*)(F.ws + WS_HQ + (size_t)rk * MOE_ROWS * DEXP), DT, DEXP, DEXP, DEXP}; S.nN = 4; S.tpe = 4; S.boff = 0;
                if (rk == 0) sync_after = false;
                E.kind = pg8::EK_MOEDOWN; E.o0 = F.ws + WS_H; E.o1 = F.dout; E.i0 = (const int*)(F.ws + WS_SMALL + SM_SLOT_TOK) + rk * MOE_ROWS; E.i1 = (const float*)(F.ws + WS_SMALL + SM_SLOT_W) + rk * MOE_ROWS; E.fin = (rk == 1) ? 1 : 0;
                E.osc = 1.f / (HQ_SCALE * WD_SCALE); }
            break; }
        }
        __syncthreads();
        if (is_gemm) { S.nwg = S.nM * S.nN;
            if (fp8) pg8::gemm_phase<pg8::Epi, pg8::Order, true, true>(ring, g, S, E, F.tid); else pg8::gemm_phase<pg8::Epi, pg8::Order, true, false>(ring, g, S, E, F.tid); }
        if (sync_after && st + 1 < args.ph_hi) xcd_barrier(bar);
    }
#if SKMODE == 2
    xcd_barrier(bar);
    { const unsigned e = xb_ld(ctl + sk::CW_ERR), n = xb_ld(ctl + sk::CW_ERR + 64);
      if (blockIdx.x == 0 && (e > SK_ERR_MAX || n != 1034240u)) args.out[threadIdx.x] = __builtin_nanf(""); }
#endif
}

extern "C" void kernel_launch(void* const* d_in, const int* in_sizes, int n_in, void* d_out, int out_size, void* d_ws, size_t ws_size, hipStream_t stream) {
    static int grid = 0;
    if (grid == 0) {
        if (n_in != 28 || ws_size < WS_END || out_size != BATCH * SEQ * D) { fprintf(stderr, "kernel_launch: unexpected shapes (n_in %d, ws %zu, out %d)\n", n_in, ws_size, out_size); grid = -1; return; }
        int dev = 0, cus = 0, per_cu = 0;
        if (hipGetDevice(&dev) != hipSuccess || hipDeviceGetAttribute(&cus, hipDeviceAttributeMultiprocessorCount, dev) != hipSuccess) { grid = -1; return; }
        if (hipFuncSetAttribute((const void*)fwd_kernel, hipFuncAttributeMaxDynamicSharedMemorySize, LDS_BYTES) != hipSuccess) { fprintf(stderr, "kernel_launch: hipFuncSetAttribute failed\n"); grid = -1; return; }
        if (hipOccupancyMaxActiveBlocksPerMultiprocessor(&per_cu, (const void*)fwd_kernel, NTHREADS, LDS_BYTES) != hipSuccess || per_cu < 1) { fprintf(stderr, "kernel_launch: occupancy query says %d\n", per_cu); }
        (void)hipGetLastError();
        grid = cus;
    }
    if (grid < 0) return;
    if (hipMemsetAsync((char*)d_ws + WS_CTL, 0, CTL_BYTES, stream) != hipSuccess) return;
    Args a{};
    for (int i = 0; i < 28; ++i) a.in[i] = (const float*)d_in[i];
    a.out = (float*)d_out; a.ws = (unsigned char*)d_ws; a.ph_lo = 0; a.ph_hi = NSTEP;
    hipLaunchKernelGGL(fwd_kernel, dim3(grid), dim3(NTHREADS), LDS_BYTES, stream, a);
}
```

```cpp
#include <hip/hip_runtime.h>
#include <cstdio>
#include <cstdint>

#define GAS __attribute__((address_space(1)))
#define LAS __attribute__((address_space(3)))
typedef unsigned short bf16;
typedef short bf16x8 __attribute__((ext_vector_type(8)));
typedef float f32x4 __attribute__((ext_vector_type(4)));
typedef float f32x2 __attribute__((ext_vector_type(2)));
typedef unsigned u32x4 __attribute__((ext_vector_type(4)));
typedef unsigned u32x2 __attribute__((ext_vector_type(2)));
typedef GAS unsigned gu32;

constexpr int BATCH = 4, SEQ = 8192, NMETA = 16, LTOK = SEQ + NMETA, PADL = 112, LP = LTOK + PADL, M = BATCH * LP, D = 1024;
constexpr int NWAVES = 8, NTHREADS = 512;
constexpr int YW = 4096, NGATE = 3072, IN_COLS = 7088;
constexpr int C_DQ = 0, C_DKV = 256, C_KR = 384, C_GQ = 416, C_GK = 672, C_GV = 928, C_GGD = 1440, C_GR = 1456, C_HQ = 1968, C_HF = 2480, C_HI = 2992, C_HG = 3504, C_END = 4016;
constexpr int QKW = 768, VW = 512;
constexpr float EPS = 1e-6f;
constexpr float QSCALE = 0.10206207261596577f * 1.4426950408889634f;
constexpr int DFF = 2816, DEXP = 3584, NEXP = 8;
constexpr float XB_SCALE = 8.f, WU_SCALE = 64.f, HQ_SCALE = 4.f, WD_SCALE = 128.f;
constexpr int MOE_TILES = 137, MOE_ROWS = MOE_TILES * 256;

constexpr size_t MiB = 1u << 20;
constexpr size_t WS_CTL = 0, CTL_BYTES = 1 * MiB;
constexpr size_t WS_ROPE = 1 * MiB;
constexpr size_t WS_SMALL = 3 * MiB;
constexpr size_t WS_H = 8 * MiB;
constexpr size_t WS_O = 74 * MiB;
constexpr size_t WS_WL = 138 * MiB;
constexpr size_t WS_YM = 160 * MiB;
constexpr size_t WS_YG = 420 * MiB;
constexpr size_t WS_V = 518 * MiB;
constexpr size_t WS_END = 562 * MiB;
constexpr size_t WS_WFF = WS_YG;
constexpr size_t WS_HMID = WS_YM;
constexpr size_t WS_WEXP = WS_YM;
constexpr size_t WS_HQ = WS_YM + 84 * MiB;
constexpr size_t WS_XB = 484 * MiB;
constexpr size_t WL_IN = 0, WL_UQKV = 14 * MiB, WL_OM = WL_UQKV + 1835008, WL_OG = WL_OM + 1572864, WL_OH = WL_OG + 1048576, WL_OUT = WL_OH + 1048576;
static_assert(WL_OUT + 2097152 <= 22 * MiB, "WL");
constexpr size_t DO_U = 0;
constexpr size_t DO_Q = 0, DO_K = 49 * MiB;
constexpr size_t DO_MIX = 49 * MiB;
constexpr size_t DO_XB1 = 0;
constexpr size_t SM_ASG_E = 0, SM_ASG_I = 262144, SM_ASG_W = 524288;
constexpr size_t SM_SLOT_TOK = 786432, SM_SLOT_W = SM_SLOT_TOK + 2 * MOE_ROWS * 4;
constexpr size_t SM_TILE_E = SM_SLOT_W + 2 * MOE_ROWS * 4;
constexpr size_t SM_NT = SM_TILE_E + 2048;
static_assert(SM_NT + 64 <= 5 * MiB, "small");
constexpr int CW_BAR = 4096, CW_CNT = 8192, CW_ATTQ = 16384, CW_LINC = 20480;

constexpr int RING_BYTES = 131072, LDSCTL_OFF = RING_BYTES, MISC_OFF = LDSCTL_OFF + 320, TAB_OFF = MISC_OFF + 128, LDS_BYTES = 147456;

__device__ __forceinline__ unsigned pk2(float lo, float hi) { unsigned r; asm("v_cvt_pk_bf16_f32 %0, %1, %2" : "=v"(r) : "v"(lo), "v"(hi)); return r; }
__device__ __forceinline__ unsigned f2bf(float f) { return pk2(f, f) & 0xffffu; }
__device__ __forceinline__ float bf2f(unsigned short b) { return __builtin_bit_cast(float, (unsigned)b << 16); }
__device__ __forceinline__ float bflo(unsigned w) { return __builtin_bit_cast(float, w << 16); }
__device__ __forceinline__ float bfhi(unsigned w) { return __builtin_bit_cast(float, w & 0xffff0000u); }
template <int CTRL> __device__ __forceinline__ float dppf(float v) { return __builtin_bit_cast(float, __builtin_amdgcn_update_dpp(0, __builtin_bit_cast(int, v), CTRL, 0xF, 0xF, true)); }
__device__ __forceinline__ float sum8(float v) { v += dppf<0xB1>(v); v += dppf<0x4E>(v); v += dppf<0x141>(v); return v; }
__device__ __forceinline__ float sum16(float v) { v = sum8(v); v += dppf<0x140>(v); return v; }
__device__ __forceinline__ float wave_sum(int, float v) {
    v = sum16(v);
    { float a = v, b = v; asm volatile("s_nop 1\n\tv_permlane16_swap_b32 %0, %1\n\ts_nop 1" : "+v"(a), "+v"(b)); v = a + b; }
    { float a = v, b = v; asm volatile("s_nop 1\n\tv_permlane32_swap_b32 %0, %1\n\ts_nop 1" : "+v"(a), "+v"(b)); v = a + b; }
    return v;
}
__device__ __forceinline__ float frcp(float x) { return __builtin_amdgcn_rcpf(x); }
__device__ __forceinline__ float frsq(float x) { return __builtin_amdgcn_rsqf(x); }
__device__ __forceinline__ float flog(float x) { return __builtin_amdgcn_logf(x) * 0.6931471805599453f; }
__device__ __forceinline__ float sigmoidf_(float x) { return frcp(1.f + __expf(-x)); }
__device__ __forceinline__ float siluf_(float x) { return x * frcp(1.f + __expf(-x)); }
#define WAVE_SYNC() do { asm volatile("s_waitcnt lgkmcnt(0)" ::: "memory"); __builtin_amdgcn_wave_barrier(); } while (0)
template <class T> __device__ __forceinline__ const GAS T* gp(const T* p) { return (const GAS T*)p; }
template <class T> __device__ __forceinline__ GAS T* gpw(T* p) { return (GAS T*)p; }
template <class T> __device__ __forceinline__ T gld(const void* p) { return *(const GAS T*)p; }
template <class T> __device__ __forceinline__ void gst(void* p, const T v) { *(GAS T*)p = v; }
__device__ __forceinline__ u32x4 zero4() { unsigned z = 0u; asm volatile("" : "+v"(z)); return (u32x4){z, z, z, z}; }
__device__ __forceinline__ const float* inptr(int k) {
    const __attribute__((address_space(4))) unsigned long long* ka = (const __attribute__((address_space(4))) unsigned long long*)__builtin_amdgcn_kernarg_segment_ptr();
    asm volatile("" : "+s"(ka));
    return (const float*)ka[k];
}

namespace pg8 {
#define PG8_LAS __attribute__((address_space(3)))
typedef unsigned short bf16_t;
constexpr int BM = 256, BK = 64, HALF = 128, HTB = HALF * BK * 2, NXCD = 8, WGM = 8;
__host__ __device__ __forceinline__ int lds_byte(int r, int c) { const int st = (r >> 4) * 2 + (c >> 5), rr = r & 15, cc = c & 31, ob = rr * 64 + cc * 2; return st * 1024 + (ob ^ (((ob >> 9) & 1) << 5)); }
__host__ __device__ __forceinline__ void stage_rc(int b, int& R, int& C) { const int st = b / 1024, sb = b % 1024, swz = sb ^ (((sb >> 9) & 1) << 5); R = (st >> 1) * 16 + swz / 64; C = (st & 1) * 32 + (swz % 64) / 2; }
__host__ __device__ __forceinline__ int perm32(int rho) { const int n = rho >> 4, i = rho & 15; return 8 * (i >> 2) + 4 * n + (i & 3); }

struct Unit { int pm, pn, pb; };
struct Gemm { const bf16_t* A; const bf16_t* Bt; int K, lda, ldb; };

__device__ __forceinline__ void tile_order(long L, int nM, int nN, int& pm, int& pn) {
    const int nwg = nM * nN; int wgid = (int)L;
    { const int q = nwg / NXCD, r = nwg % NXCD, xcd = wgid % NXCD, off = wgid / NXCD; wgid = (xcd < r ? xcd * (q + 1) : r * (q + 1) + (xcd - r) * q) + off; }
    const int nig = WGM * nN, gid = wgid / nig, fm = gid * WGM, gsz = (nM - fm) < WGM ? (nM - fm) : WGM;
    pm = fm + ((wgid % nig) % gsz); pn = (wgid % nig) / gsz;
}
struct Order {
    int nM, nN, nwg, G, c, tpe, boff, grouped; const PG8_LAS int* te; int xrow; int late;
    __device__ __forceinline__ bool next(int i, Unit& u) const {
        long L = (long)i * G + c;
        if (late > 0) {
            const int nf = G - late, R = nwg / nf;
            if (c >= late) { if (i >= R) return false; L = (long)i * nf + (c - late); } else L = (long)nf * R + (long)i * late + c; }
        if (L >= nwg) return false;
        tile_order(L, nM, nN, u.pm, u.pn);
        u.pb = grouped ? __builtin_amdgcn_readfirstlane(te[u.pm]) * tpe + boff + u.pn : u.pn;
        u.pm = 2 * u.pm + xrow * ((u.pm >> 5) + 1);
        return true;
    }
    __device__ __forceinline__ void a_ready(const Unit&) const {}
    __device__ __forceinline__ void done(const Unit&) const {}
};

typedef int v8i_t __attribute__((ext_vector_type(8)));
template <class Epi, class Sched, bool ALIGN_EPI = false, bool FP8 = false>
__device__ __forceinline__ void gemm_phase(PG8_LAS unsigned char* lds, const Gemm g, const Sched& S, const Epi& E, const int tid) {
    const int wid = __builtin_amdgcn_readfirstlane(tid >> 6), lane = tid & 63, wr = wid >> 2, wc = wid & 3, fr = lane & 15, fq = lane >> 4;
    constexpr int ESZ = FP8 ? 1 : 2;
    const int K = g.K, nt = K * ESZ / (BK * 2);
    unsigned voffA[2], voffB[2];
#pragma unroll
    for (int i = 0; i < 2; ++i) { int R, C; stage_rc(tid * 16 + i * 8192, R, C); const int Rb = Epi::PERM ? ((R & ~31) + perm32(R & 31)) : R;
        voffA[i] = (unsigned)(R * g.lda * ESZ + C * 2); voffB[i] = (unsigned)(Rb * g.ldb * ESZ + C * 2); }
    const size_t kstep = (size_t)(BK * 2);
    const size_t hstepA = (size_t)HALF * g.lda * ESZ, hstepB = (size_t)HALF * g.ldb * ESZ;
    const size_t tstepB = 2 * hstepB;
    const unsigned ldsw = (unsigned)wid * 1024u;
    const int aoff = lds_byte(wr * 64 + fr, FP8 ? fq * 16 : fq * 8), boff = lds_byte(wc * 32 + fr, FP8 ? fq * 16 : fq * 8);
    const int aoff1 = FP8 ? lds_byte(wr * 64 + fr, fq * 16 + 8) - aoff : 1024, boff1 = FP8 ? lds_byte(wc * 32 + fr, fq * 16 + 8) - boff : 1024;
#define PG8_SA(b, h) (((b) * 2 + (h)) * HTB)
#define PG8_SB(b, h) ((4 + (b) * 2 + (h)) * HTB)
#define PG8_STAGE(bufoff, gbase, voff) do { _Pragma("unroll") for (int _i = 0; _i < 2; ++_i) \
        __builtin_amdgcn_global_load_lds((const unsigned*)((const char*)(gbase) + (voff)[_i]), (PG8_LAS unsigned*)(lds + (bufoff) + ldsw + _i * 8192), 16, 0, 0); } while (0)
#define PG8_LDA(dst, b, h) do { _Pragma("unroll") for (int m = 0; m < 4; ++m) { \
        if constexpr (FP8) { const u32x4 lo_ = *(const PG8_LAS u32x4*)(lds + PG8_SA(b, h) + aoff + m * 2048), hi_ = *(const PG8_LAS u32x4*)(lds + PG8_SA(b, h) + aoff + m * 2048 + aoff1); \
            dst##8[m] = __builtin_bit_cast(v8i_t, __builtin_shufflevector(lo_, hi_, 0, 1, 2, 3, 4, 5, 6, 7)); } \
        else { _Pragma("unroll") for (int k = 0; k < 2; ++k) dst[m][k] = *(const PG8_LAS bf16x8*)(lds + PG8_SA(b, h) + aoff + m * 2048 + k * 1024); } } } while (0)
#define PG8_LDB(dst, b, h) do { _Pragma("unroll") for (int n = 0; n < 2; ++n) { \
        if constexpr (FP8) { const u32x4 lo_ = *(const PG8_LAS u32x4*)(lds + PG8_SB(b, h) + boff + n * 2048), hi_ = *(const PG8_LAS u32x4*)(lds + PG8_SB(b, h) + boff + n * 2048 + boff1); \
            dst##8[n] = __builtin_bit_cast(v8i_t, __builtin_shufflevector(lo_, hi_, 0, 1, 2, 3, 4, 5, 6, 7)); } \
        else { _Pragma("unroll") for (int k = 0; k < 2; ++k) dst[n][k] = *(const PG8_LAS bf16x8*)(lds + PG8_SB(b, h) + boff + n * 2048 + k * 1024); } } } while (0)
#define PG8_MMA(ai, bj, At, Bt) do { __builtin_amdgcn_s_setprio(1); \
        if constexpr (FP8) { _Pragma("unroll") for (int m = 0; m < 4; ++m) _Pragma("unroll") for (int n = 0; n < 2; ++n) \
            asm volatile("v_mfma_scale_f32_16x16x128_f8f6f4 %0, %1, %2, %0, %3, %3 op_sel_hi:[0,0,0]" : "+v"(acc[ai][bj][m][n]) : "v"(Bt##8[n]), "v"(At##8[m]), "v"(one8)); } \
        else { _Pragma("unroll") for (int m = 0; m < 4; ++m) _Pragma("unroll") for (int n = 0; n < 2; ++n) _Pragma("unroll") for (int k = 0; k < 2; ++k) \
            acc[ai][bj][m][n] = __builtin_amdgcn_mfma_f32_16x16x32_bf16(Bt[n][k], At[m][k], acc[ai][bj][m][n], 0, 0, 0); } \
        __builtin_amdgcn_s_setprio(0); } while (0)
#define PG8_WAIT_V(n) asm volatile("s_waitcnt vmcnt(" #n ")" ::: "memory")
#define PG8_WAIT_L(n) asm volatile("s_waitcnt lgkmcnt(" #n ")" ::: "memory")
#define PG8_BAR __builtin_amdgcn_s_barrier()
#define PG8_SCHED __builtin_amdgcn_sched_barrier(0)
    Unit cur, nxt; int ui = 0;
    if (!S.next(0, cur)) return;
    f32x4 acc[2][2][4][2];
#pragma unroll
    for (int a = 0; a < 2; ++a)
#pragma unroll
        for (int b = 0; b < 2; ++b)
#pragma unroll
            for (int m = 0; m < 4; ++m)
#pragma unroll
                for (int n = 0; n < 2; ++n) acc[a][b][m][n] = (f32x4){0.f, 0.f, 0.f, 0.f};
    bf16x8 At[4][2], B0[2][2], B1[2][2]; v8i_t At8[4], B08[2], B18[2];
    int one8 = 0x7F7F7F7F; asm volatile("" : "+v"(one8));
    const char* cA = (const char*)g.A + (size_t)cur.pm * hstepA; const char* cB = (const char*)g.Bt + (size_t)cur.pb * tstepB;
    S.a_ready(cur);
    PG8_STAGE(PG8_SB(0, 0), cB, voffB); PG8_STAGE(PG8_SB(0, 1), cB + hstepB, voffB); PG8_STAGE(PG8_SA(0, 0), cA, voffA); PG8_STAGE(PG8_SA(0, 1), cA + hstepA, voffA);
    if (wr == 1) PG8_BAR;
    PG8_WAIT_V(2); PG8_BAR;
    PG8_STAGE(PG8_SB(1, 0), cB + kstep, voffB); PG8_STAGE(PG8_SA(1, 0), cA + kstep, voffA); PG8_STAGE(PG8_SB(1, 1), cB + hstepB + kstep, voffB);
    PG8_WAIT_V(6); PG8_BAR;
    for (;;) {
        const bool has_next = S.next(ui + 1, nxt);
        const char* nA = has_next ? (const char*)g.A + (size_t)nxt.pm * hstepA : cA; const char* nB = has_next ? (const char*)g.Bt + (size_t)nxt.pb * tstepB : cB;
        for (int t = 0; t < nt; t += 2) {
            const bool last = (t == nt - 2);
            const char* a1 = cA + (size_t)(t + 1) * kstep;
            const char* a2 = last ? nA : cA + (size_t)(t + 2) * kstep; const char* b2 = last ? nB : cB + (size_t)(t + 2) * kstep;
            const char* a3 = a2 + kstep; const char* b3 = b2 + kstep;
            if (last && has_next) S.a_ready(nxt);
            PG8_LDB(B0, 0, 0); PG8_LDB(B1, 0, 1); PG8_SCHED; PG8_LDA(At, 0, 0); PG8_STAGE(PG8_SA(1, 1), a1 + hstepA, voffA);
            PG8_WAIT_V(8); PG8_WAIT_L(0); PG8_BAR; PG8_MMA(0, 0, At, B0); PG8_MMA(0, 1, At, B1); PG8_BAR; PG8_SCHED;
            PG8_LDA(At, 0, 1); PG8_STAGE(PG8_SB(0, 0), b2, voffB); PG8_STAGE(PG8_SB(0, 1), b2 + hstepB, voffB); PG8_STAGE(PG8_SA(0, 0), a2, voffA);
            PG8_WAIT_V(8); PG8_WAIT_L(0); PG8_BAR; PG8_MMA(1, 0, At, B0); PG8_MMA(1, 1, At, B1); PG8_BAR; PG8_SCHED;
            PG8_LDB(B0, 1, 0); PG8_LDB(B1, 1, 1); PG8_SCHED; PG8_LDA(At, 1, 0); PG8_STAGE(PG8_SA(0, 1), a2 + hstepA, voffA);
            PG8_WAIT_V(8); PG8_WAIT_L(0); PG8_BAR; PG8_MMA(0, 0, At, B0); PG8_MMA(0, 1, At, B1); PG8_BAR; PG8_SCHED;
            PG8_LDA(At, 1, 1); PG8_STAGE(PG8_SB(1, 0), b3, voffB); PG8_STAGE(PG8_SB(1, 1), b3 + hstepB, voffB); PG8_STAGE(PG8_SA(1, 0), a3, voffA);
            PG8_WAIT_V(8); PG8_WAIT_L(0); PG8_BAR; PG8_MMA(1, 0, At, B0); PG8_MMA(1, 1, At, B1); PG8_BAR; PG8_SCHED;
        }
        if constexpr (ALIGN_EPI) { if (wr == 0) PG8_BAR; }
        if constexpr (FP8) asm volatile("s_nop 15\n\ts_nop 15" ::: "memory");
        E(acc, cur, wr, wc, fr, fq); S.done(cur);
        if (!has_next) break;
#pragma unroll
        for (int a = 0; a < 2; ++a)
#pragma unroll
            for (int b = 0; b < 2; ++b)
#pragma unroll
                for (int m = 0; m < 4; ++m)
#pragma unroll
                    for (int n = 0; n < 2; ++n) acc[a][b][m][n] = (f32x4){0.f, 0.f, 0.f, 0.f};
        cur = nxt; cA = nA; cB = nB; ++ui;
        if constexpr (ALIGN_EPI) { if (wr == 1) PG8_BAR; }
    }
    PG8_WAIT_V(0);
    if constexpr (!ALIGN_EPI) { if (wr == 0) PG8_BAR; }
    PG8_BAR;
#undef PG8_SA
#undef PG8_SB
#undef PG8_STAGE
#undef PG8_LDA
#undef PG8_LDB
#undef PG8_MMA
#undef PG8_WAIT_V
#undef PG8_WAIT_L
#undef PG8_BAR
#undef PG8_SCHED
}

__device__ __forceinline__ unsigned cvt_pk_bf16(float lo, float hi) { unsigned r; asm volatile("v_cvt_pk_bf16_f32 %0, %1, %2" : "=v"(r) : "v"(lo), "v"(hi)); return r; }
__device__ __forceinline__ u32x4 pack8(const f32x4 v0, const f32x4 v1) { u32x4 w; w.x = cvt_pk_bf16(v0[0], v0[1]); w.y = cvt_pk_bf16(v0[2], v0[3]); w.z = cvt_pk_bf16(v1[0], v1[1]); w.w = cvt_pk_bf16(v1[2], v1[3]); return w; }
__device__ __forceinline__ float clamp448(float x) { return __builtin_amdgcn_fmed3f(x, -448.f, 448.f); }
__device__ __forceinline__ unsigned fp8x4(const f32x4 v) { int w = 0; w = __builtin_amdgcn_cvt_pk_fp8_f32(clamp448(v[0]), clamp448(v[1]), w, false);
    w = __builtin_amdgcn_cvt_pk_fp8_f32(clamp448(v[2]), clamp448(v[3]), w, true); return (unsigned)w; }
__device__ __forceinline__ unsigned q8(float x) { const float s = frcp(1.f + __expf(-x)); return (unsigned)(s * 255.f + 0.5f); }

#define EPI_FENCE() asm volatile("" ::: "memory")
enum { EK_INPROJ = 0, EK_MIX0, EK_MIX1, EK_MIX2, EK_RESID, EK_SWIGLU, EK_MOEDOWN, EK_MLA };
struct Epi {
    static constexpr bool PERM = true;
    int kind;
    void* o0;
    void* o1;
    const void* i0;
    const void* i1;
    int ldo, fin, dry;
    float isc;
    float osc;
    __device__ __forceinline__ void operator()(const f32x4 (&acc)[2][2][4][2], const Unit& u, int wr, int wc, int fr, int fq) const {
        const int row0 = u.pm * HALF + wr * 64 + fr;
        if (dry) { float sink = 0.f;
#pragma unroll
            for (int ai = 0; ai < 2; ++ai)
#pragma unroll
                for (int bj = 0; bj < 2; ++bj)
#pragma unroll
                    for (int m = 0; m < 4; ++m) sink += acc[ai][bj][m][0][0] + acc[ai][bj][m][1][3];
            asm volatile("" :: "v"(sink)); return; }
        if (kind == EK_INPROJ) {
            if (u.pn < 16) { bf16_t* Ym = (bf16_t*)o0; const int col0 = u.pn * BM + wc * 32 + 8 * fq;
#pragma unroll
                for (int ai = 0; ai < 2; ++ai)
#pragma unroll
                    for (int m = 0; m < 4; ++m) { bf16_t* rowp = Ym + (size_t)(row0 + ai * HALF + m * 16) * YW + col0;
#pragma unroll
                        for (int bj = 0; bj < 2; ++bj) gst<u32x4>(rowp + bj * HALF, pack8(acc[ai][bj][m][0], acc[ai][bj][m][1])); }
            } else { unsigned char* Yg = (unsigned char*)o1; const int col0 = (u.pn - 16) * BM + wc * 32 + 8 * fq;
#pragma unroll
                for (int ai = 0; ai < 2; ++ai)
#pragma unroll
                    for (int m = 0; m < 4; ++m) { unsigned char* rowp = Yg + (size_t)(row0 + ai * HALF + m * 16) * NGATE + col0;
#pragma unroll
                        for (int bj = 0; bj < 2; ++bj) { const f32x4 a = acc[ai][bj][m][0], b = acc[ai][bj][m][1]; u32x2 w;
                            w.x = q8(a[0]) | (q8(a[1]) << 8) | (q8(a[2]) << 16) | (q8(a[3]) << 24); w.y = q8(b[0]) | (q8(b[1]) << 8) | (q8(b[2]) << 16) | (q8(b[3]) << 24);
                            gst<u32x2>(rowp + bj * HALF, w); } }
            }
        } else if (kind <= EK_MIX2) {
            bf16_t* Mx = (bf16_t*)o0; const unsigned char* Yg = (const unsigned char*)i0 + (kind - EK_MIX0) * 1024; const bool addp = kind != EK_MIX0;
            const int col0 = u.pn * BM + wc * 32 + 8 * fq; const float s = 1.f / 255.f;
#pragma unroll
            for (int ai = 0; ai < 2; ++ai)
#pragma unroll
                for (int bj = 0; bj < 2; ++bj) { const int col = col0 + bj * HALF; u32x2 gw[4]; u32x4 pv[4];
#pragma unroll
                    for (int m = 0; m < 4; ++m) { const int row = row0 + ai * HALF + m * 16; gw[m] = gld<u32x2>(Yg + (size_t)row * NGATE + col);
                        pv[m] = (u32x4){0u, 0u, 0u, 0u}; if (addp) pv[m] = gld<u32x4>(Mx + (size_t)row * D + col); }
#pragma unroll
                    for (int m = 0; m < 4; ++m) { const int row = row0 + ai * HALF + m * 16; f32x4 a = acc[ai][bj][m][0], b = acc[ai][bj][m][1]; const u32x2 g = gw[m]; const u32x4 p = pv[m];
                        a[0] = a[0] * ((float)(g.x & 255u) * s) + bflo(p.x); a[1] = a[1] * ((float)((g.x >> 8) & 255u) * s) + bfhi(p.x); a[2] = a[2] * ((float)((g.x >> 16) & 255u) * s) + bflo(p.y); a[3] = a[3] * ((float)(g.x >> 24) * s) + bfhi(p.y);
                        b[0] = b[0] * ((float)(g.y & 255u) * s) + bflo(p.z); b[1] = b[1] * ((float)((g.y >> 8) & 255u) * s) + bfhi(p.z); b[2] = b[2] * ((float)((g.y >> 16) & 255u) * s) + bflo(p.w); b[3] = b[3] * ((float)(g.y >> 24) * s) + bfhi(p.w);
                        gst<u32x4>(Mx + (size_t)row * D + col, pack8(a, b)); }
                    EPI_FENCE(); }
        } else if (kind == EK_RESID) {
            bf16_t* H = (bf16_t*)o0; const int col0 = u.pn * BM + wc * 32 + 8 * fq;
#pragma unroll
            for (int ai = 0; ai < 2; ++ai)
#pragma unroll
                for (int bj = 0; bj < 2; ++bj) { u32x4 x[4];
#pragma unroll
                    for (int m = 0; m < 4; ++m) x[m] = gld<u32x4>(H + (size_t)(row0 + ai * HALF + m * 16) * D + col0 + bj * HALF);
#pragma unroll
                    for (int m = 0; m < 4; ++m) { const f32x4 a = acc[ai][bj][m][0] * isc + (f32x4){bflo(x[m].x), bfhi(x[m].x), bflo(x[m].y), bfhi(x[m].y)}, b = acc[ai][bj][m][1] * isc + (f32x4){bflo(x[m].z), bfhi(x[m].z), bflo(x[m].w), bfhi(x[m].w)};
                        gst<u32x4>(H + (size_t)(row0 + ai * HALF + m * 16) * D + col0 + bj * HALF, pack8(a, b)); }
                    EPI_FENCE(); }
        } else if (kind == EK_SWIGLU) {
            bf16_t* O = (bf16_t*)o0; const int col0 = u.pn * HALF + wc * 32 + 8 * fq; const float c1 = -1.4426950408889634f * isc, c2 = isc * isc * (osc > 0.f ? osc : 1.f);
#pragma unroll
            for (int ai = 0; ai < 2; ++ai)
#pragma unroll
                for (int m = 0; m < 4; ++m) { f32x4 h[2];
#pragma unroll
                    for (int n = 0; n < 2; ++n)
#pragma unroll
                        for (int e = 0; e < 4; ++e) { const float ga = acc[ai][0][m][n][e], ua = acc[ai][1][m][n][e];
                            h[n][e] = ga * ua * c2 * frcp(1.f + __builtin_amdgcn_exp2f(ga * c1)); }
                    if (osc > 0.f) { u32x2 w8; w8.x = fp8x4(h[0]); w8.y = fp8x4(h[1]); gst<u32x2>((unsigned char*)o0 + (size_t)(row0 + ai * HALF + m * 16) * ldo + col0, w8); }
                    else gst<u32x4>(O + (size_t)(row0 + ai * HALF + m * 16) * ldo + col0, pack8(h[0], h[1])); }
        } else if (kind == EK_MLA) {
            bf16_t* Qb = (bf16_t*)o0; bf16_t* Kb = (bf16_t*)o1; bf16_t* Vb = (bf16_t*)i0;
#pragma unroll
            for (int ai = 0; ai < 2; ++ai)
#pragma unroll
                for (int m = 0; m < 4; ++m) { const size_t row = (size_t)(row0 + ai * HALF + m * 16);
#pragma unroll
                    for (int bj = 0; bj < 2; ++bj) { const u32x4 w = pack8(acc[ai][bj][m][0], acc[ai][bj][m][1]);
                        const int pn_ = u.pn + fin;
                        if (pn_ < 3) gst<u32x4>(Qb + row * QKW + pn_ * BM + bj * HALF + wc * 32 + 8 * fq, w);
                        else { const int c = (pn_ - 3) * BM + bj * HALF + wc * 32 + 8 * fq, hh = c >> 7, d = c & 127;
                            if (d < 64) gst<u32x4>(Kb + row * QKW + hh * 96 + d, w); else gst<u32x4>(Vb + row * VW + hh * 64 + d - 64, w); } } }
        } else {
            bf16_t* H = (bf16_t*)o0; float* out = (float*)o1; const int* slot_tok = (const int*)i0; const float* slot_w = (const float*)i1;
            const int col0 = u.pn * BM + wc * 32 + 8 * fq;
#pragma unroll
            for (int ai = 0; ai < 2; ++ai) { int tk[4]; float wv[4];
#pragma unroll
                for (int m = 0; m < 4; ++m) { const int slot = row0 + ai * HALF + m * 16; tk[m] = gld<int>(slot_tok + slot); wv[m] = gld<float>(slot_w + slot) * osc; }
#pragma unroll
                for (int bj = 0; bj < 2; ++bj) { u32x4 x[4];
#pragma unroll
                    for (int m = 0; m < 4; ++m) { const int t_ = tk[m] < 0 ? 0 : tk[m]; x[m] = gld<u32x4>(H + (size_t)t_ * D + col0 + bj * HALF); }
#pragma unroll
                    for (int m = 0; m < 4; ++m) if (tk[m] >= 0) {
                        const f32x4 a = acc[ai][bj][m][0] * wv[m] + (f32x4){bflo(x[m].x), bfhi(x[m].x), bflo(x[m].y), bfhi(x[m].y)}, b = acc[ai][bj][m][1] * wv[m] + (f32x4){bflo(x[m].z), bfhi(x[m].z), bflo(x[m].w), bfhi(x[m].w)};
                        if (fin) { const int bb = tk[m] / LP, p = tk[m] - bb * LP; f32x4* q = (f32x4*)(out + ((size_t)bb * SEQ + (p - 128)) * D + col0 + bj * HALF); gst<f32x4>(q, a); gst<f32x4>(q + 1, b); }
                        else gst<u32x4>(H + (size_t)tk[m] * D + col0 + bj * HALF, pack8(a, b)); }
                    EPI_FENCE(); } }
        }
    }
};
}

#define XB_TMO      128
#define XB_XCNT(j)  (256  + 64 * (j))
#define XB_XSUB(j)  (1280 + 64 * (j))
#define XB_XGEN(j)  (2304 + 64 * (j))
#define XB_TOP      3328
#define XB_TOPGEN   3392
#define XCD_BAR_WORDS 3456
#define XB_SPIN_CAP (1u << 25)
__device__ __forceinline__ unsigned xb_ld(unsigned* p)              { return __hip_atomic_load(p, __ATOMIC_RELAXED, __HIP_MEMORY_SCOPE_AGENT); }
__device__ __forceinline__ unsigned xb_add(unsigned* p, unsigned v) { return __hip_atomic_fetch_add(p, v, __ATOMIC_RELAXED, __HIP_MEMORY_SCOPE_AGENT); }
__device__ __forceinline__ unsigned xb_xcc_id() { return (unsigned)__builtin_amdgcn_s_getreg((3 << 11) | 20) & 0xFu; }
#define XB_SPIN(cond, bar) do { unsigned _sp = 0; while (cond) { __builtin_amdgcn_s_sleep(1); \
    if ((++_sp & 255u) == 0u) { if (xb_ld(&(bar)[XB_TMO])) break; if (_sp > XB_SPIN_CAP) { atomicAdd(&(bar)[XB_TMO], 1u); break; } } } } while (0)
struct XcdBarrier { unsigned* bar; unsigned x; volatile LAS unsigned* st; };
__device__ __forceinline__ XcdBarrier xcd_barrier_post(unsigned* bar, volatile LAS unsigned* st) {
    XcdBarrier b; b.bar = bar; b.x = xb_xcc_id(); b.st = st;
    if (threadIdx.x == 0) (void)xb_add(&bar[XB_XCNT(b.x)], 1u);
    return b;
}
__device__ __forceinline__ void xcd_barrier_complete(unsigned* bar, unsigned x, unsigned& nloc, unsigned& nx) {
    const unsigned G = gridDim.x * gridDim.y * gridDim.z;
    unsigned sum, cnt, mine, sp = 0u;
    for (;;) {
        sum = 0u; cnt = 0u; mine = 0u;
#pragma unroll
        for (unsigned j = 0; j < 16; ++j) { const unsigned c = xb_ld(&bar[XB_XCNT(j)]); sum += c; cnt += (c > 0u) ? 1u : 0u; mine = (j == x) ? c : mine; }
        if (sum == G) break;
        __builtin_amdgcn_s_sleep(1);
        if ((++sp & 255u) == 0u) { if (xb_ld(&bar[XB_TMO])) break; if (sp > XB_SPIN_CAP) { atomicAdd(&bar[XB_TMO], 1u); break; } }
    }
    nloc = mine > 0u ? mine : 1u; nx = cnt > 0u ? cnt : 1u;
}
__device__ __forceinline__ void xcd_barrier(const XcdBarrier& b) {
    asm volatile("s_waitcnt vmcnt(0)" ::: "memory");
    __syncthreads();
    if (threadIdx.x == 0) {
        unsigned* bar = b.bar;
        __builtin_amdgcn_s_waitcnt(0);
        unsigned nloc = b.st[0], nx = b.st[1];
        if (nloc == 0u) { xcd_barrier_complete(bar, b.x, nloc, nx); b.st[0] = nloc; b.st[1] = nx; }
        const unsigned old = xb_add(&bar[XB_XSUB(b.x)], 1u);
        const unsigned gen = old / nloc;
        if (old + 1u == (gen + 1u) * nloc) {
            __builtin_amdgcn_fence(__ATOMIC_RELEASE, "agent");
            asm volatile("s_waitcnt vmcnt(0)" ::: "memory");
            const unsigned og = xb_add(&bar[XB_TOP], 1u);
            const unsigned tg = og / nx;
            if (og + 1u == (tg + 1u) * nx) xb_add(&bar[XB_TOPGEN], 1u);
            else XB_SPIN(xb_ld(&bar[XB_TOPGEN]) == tg, bar);
            __builtin_amdgcn_fence(__ATOMIC_ACQUIRE, "agent");
            xb_add(&bar[XB_XGEN(b.x)], 1u);
            asm volatile("s_waitcnt vmcnt(0)" ::: "memory");
        } else {
            XB_SPIN(xb_ld(&bar[XB_XGEN(b.x)]) == gen, bar);
            __builtin_amdgcn_fence(__ATOMIC_ACQUIRE, "agent");
            asm volatile("s_waitcnt vmcnt(0)" ::: "memory");
        }
    }
    __syncthreads();
}

struct Args { const float* in[28]; float* out; unsigned char* ws; int ph_lo, ph_hi; };
struct Frame {
    LAS unsigned char* lds; unsigned char* ws; unsigned char* dout;
    int tid, lane, wave, G, bid, gw, NGW, dry;
};

template <bool F8>
__device__ __forceinline__ void transpose_tile(const float* W, size_t ldw, int k0, int ncol0, int nvalid, bf16* WT, size_t ldt, int drow0, int dk0, const float* gain, float scale, LAS float* scr, int lane) {
    const int n_ = lane & 31;
    float tv[32];
#pragma unroll
    for (int i = 0; i < 32; ++i) { const int kk = 2 * i + (lane >> 5); tv[i] = 0.f; if (n_ < nvalid) tv[i] = *(const GAS float*)gp(W + (size_t)(k0 + kk) * ldw + ncol0 + n_); }
    { const float* gsrc = gain ? gain : W;
      const bool hasg = gain != nullptr;
#pragma unroll
      for (int i = 0; i < 32; ++i) { const float gv = *(const GAS float*)gp(gsrc + k0 + 2 * i + (lane >> 5)); tv[i] *= hasg ? gv : 1.f; } }
#pragma unroll
    for (int i = 0; i < 32; ++i) scr[(2 * i + (lane >> 5)) * 33 + n_] = tv[i] * scale;
    WAVE_SYNC();
    const int c = lane & 7;
#pragma unroll
    for (int j = 0; j < 4; ++j) { const LAS float* s = scr + (8 * c) * 33 + (lane >> 3) + 8 * j;
#pragma unroll
        for (int q = 0; q < 8; ++q) tv[8 * j + q] = s[q * 33]; }
#pragma unroll
    for (int j = 0; j < 4; ++j) { const int n = (lane >> 3) + 8 * j; const float* s = tv + 8 * j;
        if (F8) { u32x2 o; o.x = pg8::fp8x4((f32x4){s[0], s[1], s[2], s[3]}); o.y = pg8::fp8x4((f32x4){s[4], s[5], s[6], s[7]});
            if (n < nvalid) *(GAS u32x2*)gpw((u32x2*)((unsigned char*)WT + (size_t)(drow0 + n) * ldt + dk0 + 8 * c)) = o; }
        else { u32x4 o; o.x = pk2(s[0], s[1]); o.y = pk2(s[2], s[3]); o.z = pk2(s[4], s[5]); o.w = pk2(s[6], s[7]);
            if (n < nvalid) *(GAS u32x4*)gpw((u32x4*)(WT + (size_t)(drow0 + n) * ldt + dk0 + 8 * c)) = o; } }
    WAVE_SYNC();
}
template <int MODE, bool F8 = false>
__device__ __forceinline__ void conv_matrix(const Frame& F, const float* W, int K, int Ncols, size_t ldw, int ncol_base, bf16* WT, size_t ldt, int drow_base, const float* gain, int dk_base = 0, float scale = 1.f) {
    LAS float* scr = (LAS float*)(F.lds + F.wave * 16384);
    const int nkb = K / 64, nnb = (Ncols + 31) / 32, ntile = nkb * nnb;
    for (int it = F.gw; it < ntile; it += F.NGW) {
        const int kb = it / nnb, nb = it % nnb, n0 = nb * 32, nvalid = (Ncols - n0) < 32 ? (Ncols - n0) : 32;
        int drow0 = drow_base + n0, dk0 = dk_base + kb * 64;
        if (MODE == 1) drow0 = 256 * (n0 / 128) + (n0 % 128) + drow_base;
        if (MODE == 2) dk0 = kb * 96;
        transpose_tile<F8>(W, ldw, kb * 64, ncol_base + n0, nvalid, WT, ldt, drow0, dk0, gain, scale, scr, F.lane);
    }
}
__device__ __forceinline__ void zero_fill16(const Frame& F, void* p, size_t bytes) {
    u32x4* q = (u32x4*)p; const size_t n = bytes / 16;
    const u32x4 z4 = zero4();
    for (size_t i = (size_t)F.bid * NTHREADS + F.tid; i < n; i += (size_t)F.G * NTHREADS) q[i] = z4;
}
__device__ __forceinline__ void convert_layer_weights(const Frame& F, int layer) {
    unsigned char* wl = F.ws + WS_WL;
    bf16* WinT = (bf16*)(wl + WL_IN); bf16* uq = (bf16*)(wl + WL_UQKV);
    const float* w_in = inptr(3) + (size_t)layer * D * IN_COLS;
    LAS float* scr = (LAS float*)(F.lds + F.wave * 16384);
    constexpr int T0 = 16 * 126, T1 = T0 + 16 * 96, T2 = T1 + 4 * 24, T3 = T2 + 2 * 32, T4 = T3 + 8 * 32, T5 = T4 + 8 * 32, T6 = T5 + 8 * 32, T7 = T6 + 16 * 32;
    for (int it = F.gw; it < T7; it += F.NGW) {
        const float* W; const float* gain = nullptr; bf16* WT; int Ncols, ldw, ncol_base = 0, ldt, drow_base = 0, nnb, t;
        if (it < T0)      { t = it;      W = w_in; Ncols = C_END; ldw = IN_COLS; WT = WinT; ldt = D; nnb = 126; }
        else if (it < T1) { t = it - T0; W = w_in; Ncols = NGATE; ldw = IN_COLS; ncol_base = C_END; WT = WinT; ldt = D; drow_base = YW; nnb = 96; }
        else if (it < T2) { t = it - T1; W = inptr(5) + (size_t)layer * 256 * 768; Ncols = 768; ldw = 768; WT = uq; ldt = 256; gain = inptr(4) + layer * 256; nnb = 24; }
        else if (it < T3) { t = it - T2; W = inptr(7) + (size_t)layer * 128 * 1024; Ncols = 1024; ldw = 1024; WT = uq; ldt = 256; drow_base = 768; gain = inptr(6) + layer * 128; nnb = 32; }
        else if (it < T4) { t = it - T3; W = inptr(15) + (size_t)layer * 512 * 1024; Ncols = 1024; ldw = 1024; WT = (bf16*)(wl + WL_OM); ldt = 512; nnb = 32; }
        else if (it < T5) { t = it - T4; W = inptr(16) + (size_t)layer * 512 * 1024; Ncols = 1024; ldw = 1024; WT = (bf16*)(wl + WL_OG); ldt = 512; nnb = 32; }
        else if (it < T6) { t = it - T5; W = inptr(17) + (size_t)layer * 512 * 1024; Ncols = 1024; ldw = 1024; WT = (bf16*)(wl + WL_OH); ldt = 512; nnb = 32; }
        else              { t = it - T6; W = inptr(18) + (size_t)layer * 1024 * 1024; Ncols = 1024; ldw = 1024; WT = (bf16*)(wl + WL_OUT); ldt = 1024; nnb = 32; }
        const int kb = t / nnb, n0 = (t % nnb) * 32, nvalid = (Ncols - n0) < 32 ? (Ncols - n0) : 32;
        transpose_tile<false>(W, (size_t)ldw, kb * 64, ncol_base + n0, nvalid, WT, (size_t)ldt, drow_base + n0, kb * 64, gain, 1.f, scr, F.lane);
    }
    zero_fill16(F, WinT + (size_t)C_END * D, (size_t)(YW - C_END) * D * 2);
    { const u32x4 z4 = zero4();
      for (int i = F.bid * NTHREADS + F.tid; i < 1024 * 16; i += F.G * NTHREADS) { const int row = 768 + (i >> 4), c = 16 + (i & 15); *(u32x4*)(uq + (size_t)row * 256 + 8 * c) = z4; } }
}

__device__ __forceinline__ float row_rstd(const Frame& F, const f32x4 (&v)[4]) {
    float s = 0.f;
#pragma unroll
    for (int j = 0; j < 4; ++j) s += (v[j].x * v[j].x + v[j].y * v[j].y) + (v[j].z * v[j].z + v[j].w * v[j].w);
    return frsq(wave_sum(F.lane, s) * (1.f / D) + EPS);
}
__device__ __forceinline__ void store_row_bf16(bf16* orow, const f32x4 (&v)[4], float rstd, const float* gain, int lane) {
    unsigned long long* o8 = (unsigned long long*)orow + lane;
#pragma unroll
    for (int j = 0; j < 4; ++j) { const f32x4 g = gld<f32x4>((const f32x4*)gain + lane + 64 * j);
        gst<u32x2>(o8 + 64 * j, (u32x2){pk2(v[j].x * rstd * g.x, v[j].y * rstd * g.y), pk2(v[j].z * rstd * g.z, v[j].w * rstd * g.w)}); }
}
__device__ __forceinline__ void store_row_bf16g(bf16* orow, const f32x4 (&v)[4], float rstd, const f32x4 (&g)[4], int lane) {
    unsigned long long* o8 = (unsigned long long*)orow + lane;
#pragma unroll
    for (int j = 0; j < 4; ++j) gst<u32x2>(o8 + 64 * j, (u32x2){pk2(v[j].x * rstd * g[j].x, v[j].y * rstd * g[j].y), pk2(v[j].z * rstd * g[j].z, v[j].w * rstd * g[j].w)});
}
__device__ __forceinline__ void store_row_fp8(unsigned char* orow, const f32x4 (&v)[4], float rstd, const float* gain, float scale, int lane) {
    unsigned* o4 = (unsigned*)orow + lane;
#pragma unroll
    for (int j = 0; j < 4; ++j) { const f32x4 g = gld<f32x4>((const f32x4*)gain + lane + 64 * j); const float sc = rstd * scale;
        gst<unsigned>(o4 + 64 * j, pg8::fp8x4((f32x4){v[j].x * sc * g.x, v[j].y * sc * g.y, v[j].z * sc * g.z, v[j].w * sc * g.w})); }
}
__device__ __forceinline__ void load_h_row(const bf16* hrow, int lane, f32x4 (&v)[4]) {
#pragma unroll
    for (int j = 0; j < 4; ++j) { const u32x2 w = *(const GAS u32x2*)gp((const u32x2*)hrow + lane + 64 * j); v[j] = (f32x4){bflo(w.x), bfhi(w.x), bflo(w.y), bfhi(w.y)}; }
}
__device__ __forceinline__ void store_h_row(bf16* hrow, int lane, const f32x4 (&v)[4]) {
#pragma unroll
    for (int j = 0; j < 4; ++j) { u32x2 w; w.x = pk2(v[j].x, v[j].y); w.y = pk2(v[j].z, v[j].w); gst<u32x2>((u32x2*)hrow + lane + 64 * j, w); }
}
__device__ __forceinline__ void phase_init_rows(const Frame& F, const float* gain) {
    bf16* H = (bf16*)(F.ws + WS_H); bf16* U = (bf16*)(F.dout + DO_U);
    const float* x = inptr(0); const float* meta = inptr(1);
    f32x4 gn[4];
#pragma unroll
    for (int j = 0; j < 4; ++j) gn[j] = gld<f32x4>((const f32x4*)gain + F.lane + 64 * j);
    f32x4 vr[2][4];
    auto issue = [&](int q, int r_) { const int r = r_ < M ? r_ : F.gw; const int b = r / LP, p = r - b * LP;
        const float* src = (p < 128) ? meta + (size_t)(p < PADL ? 0 : p - PADL) * D : x + ((size_t)b * SEQ + (p - 128)) * D;
#pragma unroll
        for (int j = 0; j < 4; ++j) vr[q][j] = *(const GAS f32x4*)gp((const f32x4*)src + F.lane + 64 * j); };
    issue(0, F.gw); issue(1, F.gw + F.NGW);
    for (int r0 = F.gw; r0 < M; r0 += 2 * F.NGW)
#pragma unroll
        for (int q = 0; q < 2; ++q) { const int r = r0 + q * F.NGW; if (r >= M) break;
            f32x4 v[4]; const int p = r % LP;
#pragma unroll
            for (int j = 0; j < 4; ++j) { v[j] = vr[q][j]; if (p < PADL) v[j] = (f32x4){0.f, 0.f, 0.f, 0.f}; }
            issue(q, r + 2 * F.NGW);
            store_h_row(H + (size_t)r * D, F.lane, v);
            const float rstd = row_rstd(F, v);
            store_row_bf16g(U + (size_t)r * D, v, rstd, gn, F.lane); }
}
__device__ __forceinline__ void phase_norm_rows(const Frame& F, const float* gain, bf16* U) {
    const bf16* H = (const bf16*)(F.ws + WS_H);
    f32x4 gn[4];
#pragma unroll
    for (int j = 0; j < 4; ++j) gn[j] = gld<f32x4>((const f32x4*)gain + F.lane + 64 * j);
    u32x2 rw[4][4];
#pragma unroll
    for (int q = 0; q < 4; ++q) { const int r = F.gw + q * F.NGW < M ? F.gw + q * F.NGW : F.gw;
#pragma unroll
        for (int j = 0; j < 4; ++j) rw[q][j] = *(const GAS u32x2*)gp((const u32x2*)(H + (size_t)r * D) + F.lane + 64 * j); }
    for (int r0 = F.gw; r0 < M; r0 += 4 * F.NGW)
#pragma unroll
        for (int q = 0; q < 4; ++q) { const int r = r0 + q * F.NGW; if (r >= M) break;
            f32x4 v[4];
#pragma unroll
            for (int j = 0; j < 4; ++j) { const u32x2 w = rw[q][j]; v[j] = (f32x4){bflo(w.x), bfhi(w.x), bflo(w.y), bfhi(w.y)}; }
            { const int rn = r + 4 * F.NGW < M ? r + 4 * F.NGW : r;
#pragma unroll
              for (int j = 0; j < 4; ++j) rw[q][j] = *(const GAS u32x2*)gp((const u32x2*)(H + (size_t)rn * D) + F.lane + 64 * j); }
            const float rstd = row_rstd(F, v);
            store_row_bf16g(U + (size_t)r * D, v, rstd, gn, F.lane); }
}
__device__ __forceinline__ void phase_rope_table(const Frame& F) {
    float* ct = (float*)(F.ws + WS_ROPE); float* st = ct + LP * 16;
    for (int i = F.bid * NTHREADS + F.tid; i < LP * 16; i += F.G * NTHREADS) {
        const int p = i >> 4, k = i & 15; const int pos = p - PADL;
        const float inv = exp2f(-(float)k * 0.83048202372184059f);
        const float ang = (float)(pos < 0 ? 0 : pos) * inv;
        const float c_hi = 0.15915494309189535f;
        const float c_lo = 6.420638326565253e-09f;
        const float t_hi = ang * c_hi; const float e = fmaf(ang, c_hi, -t_hi);
        float fr = t_hi - rintf(t_hi); fr += e + ang * c_lo;
        ct[i] = __builtin_amdgcn_cosf(fr); st[i] = __builtin_amdgcn_sinf(fr);
    }
}

namespace att {
typedef float f32x16 __attribute__((ext_vector_type(16)));
typedef short s16x4 __attribute__((ext_vector_type(4)));
typedef short v4i16_t __attribute__((ext_vector_type(4)));
constexpr int KS = 208, VS = 192, KBUF = 64 * KS, VBUF = 64 * VS, BUF = KBUF + VBUF;
constexpr int NUNIT = BATCH * 8 * 33;
__device__ __forceinline__ int crow(int r, int hi) { return (r & 3) + 8 * (r >> 2) + 4 * hi; }
__device__ __forceinline__ unsigned cvtpk(float lo, float hi) { unsigned r; asm volatile("v_cvt_pk_bf16_f32 %0, %1, %2" : "=v"(r) : "v"(lo), "v"(hi)); return r; }
__device__ __forceinline__ s16x4 vtr(const LAS unsigned char* p) { return __builtin_bit_cast(s16x4, __builtin_amdgcn_ds_read_tr16_b64_v4i16((LAS v4i16_t*)p)); }
__device__ __forceinline__ float xhalf_max(float m) { auto rr = __builtin_amdgcn_permlane32_swap(__float_as_uint(m), __float_as_uint(m), false, false); return fmaxf(__uint_as_float(rr[0]), __uint_as_float(rr[1])); }
__device__ __forceinline__ float xhalf_sum(float m) { auto rr = __builtin_amdgcn_permlane32_swap(__float_as_uint(m), __float_as_uint(m), false, false); return __uint_as_float(rr[0]) + __uint_as_float(rr[1]); }

__device__ __forceinline__ void unit(const Frame& F, int b, int h, int qb) {
    const int tid = F.tid, lane = F.lane, wave = F.wave, r32 = lane & 31, hi = lane >> 5;
    bf16* Q = (bf16*)(F.dout + DO_Q); const bf16* Kg = (const bf16*)(F.dout + DO_K) + (size_t)b * LP * QKW + h * 96; const bf16* Vg = (const bf16*)(F.ws + WS_V) + (size_t)b * LP * VW + h * 64;
    const int pw = 256 * qb + 32 * wave;
    const int Tl = (4 * qb + 3) < 129 ? (4 * qb + 3) : 129;
    const int twr = pw >> 6;
    const int tw = (pw >= LP) ? 0 : (twr < 129 ? twr : 129);
    const int qp = pw + r32, qpc = qp < LP ? qp : LP - 1;
    bf16x8 qf[6];
    { const bf16* qrow = Q + ((size_t)b * LP + qpc) * QKW + h * 96 + 8 * hi;
#pragma unroll
      for (int ks = 0; ks < 6; ++ks) qf[ks] = *(const GAS bf16x8*)gp(qrow + 16 * ks); }
    const int kr0 = tid / 12, kc0 = tid % 12, kr1 = (512 + tid) / 12, kc1 = (512 + tid) % 12, vr = tid >> 3, vc = tid & 7;
    const bf16* kg0 = Kg + (size_t)kr0 * QKW + kc0 * 8; const bf16* kg1 = Kg + (size_t)kr1 * QKW + kc1 * 8; const bf16* vg = Vg + (size_t)vr * VW + vc * 8;
    LAS unsigned char* lds = F.lds;
    const int kl0 = kr0 * KS + kc0 * 16, kl1 = kr1 * KS + kc1 * 16, vl = KBUF + vr * VS + vc * 16;
    const int koff = r32 * KS + 16 * hi;
    const int voff = KBUF + (4 * hi + ((lane & 15) >> 2)) * VS + (16 * ((lane >> 4) & 1) + 4 * (lane & 3)) * 2;
    u32x4 kA0, kA1 = zero4(), vA;
#define ATT_LOAD(k0_, k1_, v_, tt) do { const int tc_ = (tt) <= Tl ? (tt) : Tl; const size_t ko_ = (size_t)(64 * tc_) * QKW, vo_ = (size_t)(64 * tc_) * VW; \
        k0_ = *(const GAS u32x4*)gp(kg0 + ko_); if (tid < 256) k1_ = *(const GAS u32x4*)gp(kg1 + ko_); v_ = *(const GAS u32x4*)gp(vg + vo_); } while (0)
#define ATT_WRITE(k0_, k1_, v_, bufi) do { LAS unsigned char* nb_ = lds + (bufi) * BUF; *(LAS u32x4*)(nb_ + kl0) = k0_; if (tid < 256) *(LAS u32x4*)(nb_ + kl1) = k1_; *(LAS u32x4*)(nb_ + vl) = v_; } while (0)
#define ATT_QK(P0, P1, bufi) do { const LAS unsigned char* kq_ = lds + (bufi) * BUF + koff; \
        _Pragma("unroll") for (int ks = 0; ks < 6; ++ks) { const bf16x8 a0 = *(const LAS bf16x8*)(kq_ + 32 * ks), a1 = *(const LAS bf16x8*)(kq_ + 32 * KS + 32 * ks); \
            P0 = __builtin_amdgcn_mfma_f32_32x32x16_bf16(a0, qf[ks], P0, 0, 0, 0); P1 = __builtin_amdgcn_mfma_f32_32x32x16_bf16(a1, qf[ks], P1, 0, 0, 0); } } while (0)
#define ATT_MASK(P0, P1, tt) do { const int kbase = 64 * (tt) + 4 * hi; \
        _Pragma("unroll") for (int r = 0; r < 16; ++r) { const int key = kbase + (r & 3) + 8 * (r >> 2); \
            if (key > qp || key < PADL) P0[r] = -1e30f; if (key + 32 > qp || key + 32 < PADL) P1[r] = -1e30f; } } while (0)
    ATT_LOAD(kA0, kA1, vA, 1); ATT_WRITE(kA0, kA1, vA, 0);
    ATT_LOAD(kA0, kA1, vA, 2); ATT_WRITE(kA0, kA1, vA, 1);
    __syncthreads();
    float m = -1e30f, l = 0.f; f32x16 o0 = {}, o1 = {}, p0 = {}, p1 = {};
    if (tw >= 1) { ATT_QK(p0, p1, 0); ATT_MASK(p0, p1, 1); }
    int cur = 0;
    for (int t = 1; t <= Tl; ++t) {
        ATT_LOAD(kA0, kA1, vA, t + 2);
        const int nx1 = cur == 2 ? 0 : cur + 1, nx2 = nx1 == 2 ? 0 : nx1 + 1;
        if (t <= tw) {
            const LAS unsigned char* kb = lds + cur * BUF; const LAS unsigned char* kq_ = lds + nx1 * BUF + koff;
            bf16x8 kf0[3], kf1[3];
#pragma unroll
            for (int ks = 0; ks < 3; ++ks) { kf0[ks] = *(const LAS bf16x8*)(kq_ + 32 * ks); kf1[ks] = *(const LAS bf16x8*)(kq_ + 32 * KS + 32 * ks); }
            __builtin_amdgcn_sched_barrier(0);
            float rm = fmaxf(p0[0], p1[0]);
#pragma unroll
            for (int r = 1; r < 16; ++r) rm = fmaxf(rm, fmaxf(p0[r], p1[r]));
            rm = xhalf_max(rm);
            const float mn = fmaxf(m, rm), alpha = __builtin_amdgcn_exp2f(m - mn); m = mn;
            __builtin_amdgcn_sched_barrier(0);
            f32x16 n0 = {}, n1 = {};
#pragma unroll
            for (int ks = 0; ks < 3; ++ks) { n0 = __builtin_amdgcn_mfma_f32_32x32x16_bf16(kf0[ks], qf[ks], n0, 0, 0, 0); n1 = __builtin_amdgcn_mfma_f32_32x32x16_bf16(kf1[ks], qf[ks], n1, 0, 0, 0); }
            __builtin_amdgcn_sched_barrier(0);
#pragma unroll
            for (int ks = 0; ks < 3; ++ks) { kf0[ks] = *(const LAS bf16x8*)(kq_ + 32 * (ks + 3)); kf1[ks] = *(const LAS bf16x8*)(kq_ + 32 * KS + 32 * (ks + 3)); }
            __builtin_amdgcn_sched_barrier(0);
            float ls = 0.f;
#pragma unroll
            for (int r = 0; r < 16; ++r) { p0[r] = __builtin_amdgcn_exp2f(p0[r] - mn); ls += p0[r]; }
            __builtin_amdgcn_sched_barrier(0);
#pragma unroll
            for (int ks = 0; ks < 3; ++ks) { n0 = __builtin_amdgcn_mfma_f32_32x32x16_bf16(kf0[ks], qf[ks + 3], n0, 0, 0, 0); n1 = __builtin_amdgcn_mfma_f32_32x32x16_bf16(kf1[ks], qf[ks + 3], n1, 0, 0, 0); }
            __builtin_amdgcn_sched_barrier(0);
            s16x4 vlo[8], vhi[8];
#pragma unroll
            for (int s_ = 0; s_ < 4; ++s_)
#pragma unroll
                for (int d0 = 0; d0 < 2; ++d0) { const LAS unsigned char* vp = kb + voff + (32 * (s_ >> 1) + 16 * (s_ & 1)) * VS + 64 * d0; vlo[2 * s_ + d0] = vtr(vp); vhi[2 * s_ + d0] = vtr(vp + 8 * VS); }
            __builtin_amdgcn_sched_barrier(0);
#pragma unroll
            for (int r = 0; r < 16; ++r) { p1[r] = __builtin_amdgcn_exp2f(p1[r] - mn); ls += p1[r]; }
            l = l * alpha + ls;
            if (!__all(alpha == 1.f)) {
#pragma unroll
                for (int r = 0; r < 16; ++r) { o0[r] *= alpha; o1[r] *= alpha; } }
            bf16x8 pb[4];
#pragma unroll
            for (int s_ = 0; s_ < 4; ++s_) { u32x4 w;
                if (s_ < 2) { w.x = cvtpk(p0[8 * s_], p0[8 * s_ + 1]); w.y = cvtpk(p0[8 * s_ + 2], p0[8 * s_ + 3]); w.z = cvtpk(p0[8 * s_ + 4], p0[8 * s_ + 5]); w.w = cvtpk(p0[8 * s_ + 6], p0[8 * s_ + 7]); }
                else { const int q_ = 8 * (s_ - 2); w.x = cvtpk(p1[q_], p1[q_ + 1]); w.y = cvtpk(p1[q_ + 2], p1[q_ + 3]); w.z = cvtpk(p1[q_ + 4], p1[q_ + 5]); w.w = cvtpk(p1[q_ + 6], p1[q_ + 7]); }
                pb[s_] = __builtin_bit_cast(bf16x8, w); }
#pragma unroll
            for (int s_ = 0; s_ < 4; ++s_) {
                const bf16x8 af0 = (bf16x8){vlo[2 * s_][0], vlo[2 * s_][1], vlo[2 * s_][2], vlo[2 * s_][3], vhi[2 * s_][0], vhi[2 * s_][1], vhi[2 * s_][2], vhi[2 * s_][3]};
                const bf16x8 af1 = (bf16x8){vlo[2 * s_ + 1][0], vlo[2 * s_ + 1][1], vlo[2 * s_ + 1][2], vlo[2 * s_ + 1][3], vhi[2 * s_ + 1][0], vhi[2 * s_ + 1][1], vhi[2 * s_ + 1][2], vhi[2 * s_ + 1][3]};
                o0 = __builtin_amdgcn_mfma_f32_32x32x16_bf16(af0, pb[s_], o0, 0, 0, 0); o1 = __builtin_amdgcn_mfma_f32_32x32x16_bf16(af1, pb[s_], o1, 0, 0, 0); }
            if (t + 1 == twr) ATT_MASK(n0, n1, t + 1);
            p0 = n0; p1 = n1;
        }
        ATT_WRITE(kA0, kA1, vA, nx2); __syncthreads(); cur = nx1;
    }
#undef ATT_LOAD
#undef ATT_WRITE
#undef ATT_QK
#undef ATT_MASK
    const float lt = xhalf_sum(l); const float inv = (qp >= PADL && lt > 0.f) ? 1.f / lt : 0.f;
    if (qp < LP && !F.dry) { bf16* orow = (bf16*)(F.ws + WS_O) + ((size_t)b * LP + qp) * 512 + h * 64 + 4 * hi;
#pragma unroll
        for (int g4 = 0; g4 < 4; ++g4) { u32x2 w0, w1;
            w0.x = cvtpk(o0[4 * g4] * inv, o0[4 * g4 + 1] * inv); w0.y = cvtpk(o0[4 * g4 + 2] * inv, o0[4 * g4 + 3] * inv);
            w1.x = cvtpk(o1[4 * g4] * inv, o1[4 * g4 + 1] * inv); w1.y = cvtpk(o1[4 * g4 + 2] * inv, o1[4 * g4 + 3] * inv);
            gst<u32x2>(orow + 8 * g4, w0); gst<u32x2>(orow + 32 + 8 * g4, w1); } }
}
__device__ __forceinline__ void phase(const Frame& F, int layer) {
    const int xg = F.bid & 7;
    unsigned* ctl = (unsigned*)(F.ws + WS_CTL) + CW_ATTQ + 64 * ((2 * layer + F.dry) * 8 + xg);
    volatile LAS int* slot = (volatile LAS int*)(F.lds + MISC_OFF + 64);
    for (;;) {
        if (F.tid == 0) slot[0] = (int)atomicAdd(ctl, 1u);
        __syncthreads();
        const int i = __builtin_amdgcn_readfirstlane(slot[0]);
        __syncthreads();
        if (i >= NUNIT / 8) break;
        const int qb = 32 - (i >> 2), bh = 4 * xg + (i & 3);
        unit(F, bh >> 3, bh & 7, qb);
    }
}
}

namespace mla {
__device__ __forceinline__ void fix(const Frame& F, int layer) {
    const bf16* Ym = (const bf16*)(F.ws + WS_YM);
    bf16* Q = (bf16*)(F.dout + DO_Q); bf16* Kb = (bf16*)(F.dout + DO_K); bf16* V = (bf16*)(F.ws + WS_V);
    const float* qn = inptr(8) + layer * 96; const float* kn = inptr(9) + layer * 96;
    const float* ct = (const float*)(F.ws + WS_ROPE); const float* st = ct + LP * 16;
    const int lane = F.lane, h = lane >> 3, sub = lane & 7;
    f32x4 qg0 = *(const GAS f32x4*)gp(qn + 8 * sub), qg1 = *(const GAS f32x4*)gp(qn + 8 * sub + 4), kg0 = *(const GAS f32x4*)gp(kn + 8 * sub), kg1 = *(const GAS f32x4*)gp(kn + 8 * sub + 4);
    const f32x2 qr1 = *(const GAS f32x2*)gp(qn + 64 + 2 * sub), qr2 = *(const GAS f32x2*)gp(qn + 80 + 2 * sub), kr1 = *(const GAS f32x2*)gp(kn + 64 + 2 * sub), kr2 = *(const GAS f32x2*)gp(kn + 80 + 2 * sub);
    struct Ld { u32x2 dqw; unsigned dkw, krw, qa, qb, ka, kb_; u32x4 qw, kw, vw; f32x2 c, sn; };
    auto load_row = [&](int r) { Ld d; const int rc = r < M ? r : F.gw; const int p = rc % LP; const bf16* y = Ym + (size_t)rc * YW;
        const bf16* qrow = Q + (size_t)rc * QKW + h * 96; const bf16* krow = Kb + (size_t)rc * QKW + h * 96; const bf16* vrow = V + (size_t)rc * VW + h * 64;
        d.dqw = *(const GAS u32x2*)gp(y + C_DQ + 4 * lane); d.dkw = *(const GAS unsigned*)gp(y + C_DKV + 2 * lane);
        d.krw = *(const GAS unsigned*)gp(y + C_KR + 2 * (lane & 15));
        d.qw = *(const GAS u32x4*)gp(qrow + 8 * sub); d.qa = *(const GAS unsigned*)gp(qrow + 64 + 2 * sub); d.qb = *(const GAS unsigned*)gp(qrow + 80 + 2 * sub);
        d.kw = *(const GAS u32x4*)gp(krow + 8 * sub); d.vw = *(const GAS u32x4*)gp(vrow + 8 * sub);
        d.ka = *(const GAS unsigned*)gp(y + C_KR + 2 * sub); d.kb_ = *(const GAS unsigned*)gp(y + C_KR + 16 + 2 * sub);
        d.c = *(const GAS f32x2*)gp(ct + (size_t)p * 16 + 2 * sub); d.sn = *(const GAS f32x2*)gp(st + (size_t)p * 16 + 2 * sub); return d; };
    constexpr int NU = BATCH * (LP / 64) * 12, FIX_KEEP = 8;
    const int kmax_ = (M + F.NGW - 1) / F.NGW; const int nl4_ = NU % F.NGW; const int nl4 = (kmax_ > FIX_KEEP && (F.NGW - nl4_) >= nl4_ * (kmax_ - FIX_KEEP)) ? nl4_ : 0;
    const int kown = (M - F.gw + F.NGW - 1) / F.NGW;
    const int kmax = (M + F.NGW - 1) / F.NGW, nmv = kmax - FIX_KEEP;
    auto rowk = [&](int k) -> int {
        if (F.gw < nl4) return k < FIX_KEEP ? F.gw + k * F.NGW : M;
        if (k < kown) return F.gw + k * F.NGW;
        if (k == kown && nl4 > 0) { const int j = F.gw - nl4; if (j < nl4 * nmv) { const int r_ = (j % nl4) + (FIX_KEEP + j / nl4) * F.NGW; return r_ < M ? r_ : M; } }
        return M; };
    Ld nx = load_row(rowk(0));
    for (int kk = 0;; ++kk) { const int r = rowk(kk); if (r >= M) break;
        const Ld d = nx; nx = load_row(rowk(kk + 1));
        bf16* qrow = Q + (size_t)r * QKW + h * 96; bf16* krow = Kb + (size_t)r * QKW + h * 96; bf16* vrow = V + (size_t)r * VW + h * 64;
        const u32x2 dqw = d.dqw; const unsigned dkw = d.dkw, krw = d.krw, qa = d.qa, qb = d.qb, ka = d.ka, kb_ = d.kb_; const u32x4 qw = d.qw, kw = d.kw, vw = d.vw; const f32x2 c = d.c, sn = d.sn;
        const float rsq = frsq(wave_sum(F.lane, bflo(dqw.x) * bflo(dqw.x) + bfhi(dqw.x) * bfhi(dqw.x) + bflo(dqw.y) * bflo(dqw.y) + bfhi(dqw.y) * bfhi(dqw.y)) * (1.f / 256.f) + EPS);
        const float rskv = frsq(wave_sum(F.lane, bflo(dkw) * bflo(dkw) + bfhi(dkw) * bfhi(dkw)) * (1.f / 128.f) + EPS);
        float krs = bflo(krw) * bflo(krw) + bfhi(krw) * bfhi(krw);
        krs = sum16(krs);
        { float e[8] = {bflo(qw.x), bfhi(qw.x), bflo(qw.y), bfhi(qw.y), bflo(qw.z), bfhi(qw.z), bflo(qw.w), bfhi(qw.w)}; float x1[2] = {bflo(qa), bfhi(qa)}, x2[2] = {bflo(qb), bfhi(qb)};
          float ss = 0.f;
#pragma unroll
          for (int i = 0; i < 8; ++i) { e[i] *= rsq; ss += e[i] * e[i]; }
#pragma unroll
          for (int i = 0; i < 2; ++i) { x1[i] *= rsq; x2[i] *= rsq; ss += x1[i] * x1[i] + x2[i] * x2[i]; }
          ss = sum8(ss);
          const float sc = QSCALE * frsq(ss * (1.f / 96.f) + EPS);
          u32x4 w; w.x = pk2(e[0] * sc * qg0[0], e[1] * sc * qg0[1]); w.y = pk2(e[2] * sc * qg0[2], e[3] * sc * qg0[3]); w.z = pk2(e[4] * sc * qg1[0], e[5] * sc * qg1[1]); w.w = pk2(e[6] * sc * qg1[2], e[7] * sc * qg1[3]);
          if (!F.dry) *(GAS u32x4*)gpw(qrow + 8 * sub) = w;
          const float a0 = x1[0] * sc * qr1[0], a1 = x1[1] * sc * qr1[1], b0 = x2[0] * sc * qr2[0], b1 = x2[1] * sc * qr2[1];
          if (!F.dry) *(GAS unsigned*)gpw(qrow + 64 + 2 * sub) = pk2(a0 * c[0] - b0 * sn[0], a1 * c[1] - b1 * sn[1]); if (!F.dry) *(GAS unsigned*)gpw(qrow + 80 + 2 * sub) = pk2(a0 * sn[0] + b0 * c[0], a1 * sn[1] + b1 * c[1]); }
        { float e[8] = {bflo(kw.x), bfhi(kw.x), bflo(kw.y), bfhi(kw.y), bflo(kw.z), bfhi(kw.z), bflo(kw.w), bfhi(kw.w)}; float ss = 0.f;
#pragma unroll
          for (int i = 0; i < 8; ++i) { e[i] *= rskv; ss += e[i] * e[i]; }
          ss = sum8(ss);
          const float sc = frsq((ss + krs) * (1.f / 96.f) + EPS);
          u32x4 w; w.x = pk2(e[0] * sc * kg0[0], e[1] * sc * kg0[1]); w.y = pk2(e[2] * sc * kg0[2], e[3] * sc * kg0[3]); w.z = pk2(e[4] * sc * kg1[0], e[5] * sc * kg1[1]); w.w = pk2(e[6] * sc * kg1[2], e[7] * sc * kg1[3]);
          if (!F.dry) *(GAS u32x4*)gpw(krow + 8 * sub) = w;
          const float a0 = bflo(ka) * sc * kr1[0], a1 = bfhi(ka) * sc * kr1[1], b0 = bflo(kb_) * sc * kr2[0], b1 = bfhi(kb_) * sc * kr2[1];
          if (!F.dry) *(GAS unsigned*)gpw(krow + 64 + 2 * sub) = pk2(a0 * c[0] - b0 * sn[0], a1 * c[1] - b1 * sn[1]); if (!F.dry) *(GAS unsigned*)gpw(krow + 80 + 2 * sub) = pk2(a0 * sn[0] + b0 * c[0], a1 * sn[1] + b1 * c[1]);
          u32x4 wv; wv.x = pk2(bflo(vw.x) * rskv, bfhi(vw.x) * rskv); wv.y = pk2(bflo(vw.y) * rskv, bfhi(vw.y) * rskv); wv.z = pk2(bflo(vw.z) * rskv, bfhi(vw.z) * rskv); wv.w = pk2(bflo(vw.w) * rskv, bfhi(vw.w) * rskv);
          if (!F.dry) *(GAS u32x4*)gpw(vrow + 8 * sub) = wv; }
    }
}
}

constexpr size_t WS_C12 = 551 * MiB;
constexpr int NCHUNK = LP / 64;
__device__ __forceinline__ void phase_lin_prep(const Frame& F, int layer) {
    bf16* Ym = (bf16*)(F.ws + WS_YM); float* c1g = (float*)(F.ws + WS_C12);
    const int lane = F.lane;
    LAS float* bbl = (LAS float*)(F.lds + F.wave * 16384) + lane;
    for (int u = F.gw; u < BATCH * NCHUNK * 12; u += F.NGW) {
        const int chunk = u / 12, sub = u % 12, b = chunk / NCHUNK, n = chunk % NCHUNK;
        const bool HG = sub >= 4; const int h = HG ? (sub - 4) >> 1 : sub; const int i = HG ? ((sub - 4) & 1) * 64 + lane : lane; const int DK = HG ? 128 : 64;
        const int ch = h * DK + i; const int cq = (HG ? C_HQ : C_GQ) + ch, ck = (HG ? C_HF : C_GK) + ch;
        bf16* y0 = Ym + ((size_t)b * LP + 64 * n) * YW;
        const int tpad = PADL - 64 * n;
        float run = 0.f, lb = 0.f;
        unsigned kq[128];
#define LP_ISSUE() do { _Pragma("unroll") for (int t = 0; t < 64; ++t) { const bf16* y = y0 + (size_t)t * YW; kq[t] = gld<bf16>(y + ck); kq[64 + t] = gld<bf16>(y + cq); } } while (0)
        if (!HG) { const float* w_g2 = inptr(10) + (size_t)layer * 16 * 256; const float bg = inptr(11)[layer * 256 + ch]; float wg[16];
#pragma unroll
            for (int rr = 0; rr < 16; ++rr) wg[rr] = gld<float>(w_g2 + rr * 256 + ch);
#pragma unroll 16
            for (int t = 0; t < 64; ++t) { const bf16* y = y0 + (size_t)t * YW; const u32x4 g0 = gld<u32x4>(y + C_GGD), g1 = gld<u32x4>(y + C_GGD + 8);
                const float z = bg + bflo(g0.x) * wg[0] + bfhi(g0.x) * wg[1] + bflo(g0.y) * wg[2] + bfhi(g0.y) * wg[3] + bflo(g0.z) * wg[4] + bfhi(g0.z) * wg[5] + bflo(g0.w) * wg[6] + bfhi(g0.w) * wg[7]
                              + bflo(g1.x) * wg[8] + bfhi(g1.x) * wg[9] + bflo(g1.y) * wg[10] + bfhi(g1.y) * wg[11] + bflo(g1.z) * wg[12] + bfhi(g1.z) * wg[13] + bflo(g1.w) * wg[14] + bfhi(g1.w) * wg[15];
                float lg = -(fmaxf(-z, 0.f) + flog(1.f + __expf(-fabsf(z)))) * (1.f / 16.f);
                if (t < tpad) lg = 0.f;
                run += lg; bbl[64 * t] = run; }
            LP_ISSUE();
        } else { if (layer == 1) { const float* lbp = inptr(13); lb = 1.f / (1.f + __expf(lbp[ch] - lbp[512 + ch])); }
            LP_ISSUE();
#pragma unroll
            for (int t = 0; t < 64; ++t) { const float f = lb + (1.f - lb) * sigmoidf_(bf2f((bf16)kq[t])); float lg = flog(fmaxf(f, 1e-30f));
                kq[t] = __builtin_bit_cast(unsigned, f);
                if (t < tpad) lg = 0.f;
                run += lg; bbl[64 * t] = run; } }
#undef LP_ISSUE
        const float bref = run;
#pragma unroll
        for (int t = 0; t < 64; ++t) { bf16* y = y0 + (size_t)t * YW; float q, k;
            if (!HG) { q = bf2f((bf16)kq[64 + t]) * 0.125f; k = bf2f((bf16)kq[t]); }
            else { q = siluf_(bf2f((bf16)kq[64 + t])); k = 1.f - __builtin_bit_cast(float, kq[t]); }
            if (t < tpad) { q = 0.f; k = 0.f; }
            const float d = fminf(bbl[64 * t] - bref, 80.f);
            if (!F.dry) { gst<bf16>(y + cq, (bf16)f2bf(q * __expf(d))); gst<bf16>(y + ck, (bf16)f2bf(k * __expf(-d))); } }
        if (!F.dry) gst<float>(c1g + chunk * 768 + (HG ? 256 + ch : ch), __expf(bref));
    }
}
namespace lin {
typedef float f32x16 __attribute__((ext_vector_type(16)));
using att::vtr; using att::cvtpk; using att::crow; using att::xhalf_sum; typedef att::s16x4 s16x4;
constexpr int NSEG = 4;
constexpr size_t WS_SLOC = 553 * MiB;
constexpr size_t WS_DTOT = 561 * MiB;
template <int DK, bool HG>
__device__ __forceinline__ void pass1(const Frame& F, int b, int h, int n0, int nc, float* sloc, float* dtot) {
    constexpr int QS = DK * 2 + 16, VSt = 320, QB = 64 * QS, VB = 64 * VSt, CB = DK * 4, BUFB = QB + VB + CB, NI = DK / 32, NO = NI / 2, QCH = DK / 8;
    constexpr int NQC = 64 * QCH, NL = (NQC + 1024) / NTHREADS; static_assert(NQC % NTHREADS == 0 && 2 * BUFB <= RING_BYTES, "pass1 staging");
    const bf16* Ym = (const bf16*)(F.ws + WS_YM); const float* c1g = (const float*)(F.ws + WS_C12);
    const int tid = F.tid, lane = F.lane, wave = F.wave, j = wave & 3, th = wave >> 2, hi = lane >> 5;
    const int ck = (HG ? C_HF : C_GK) + h * DK, cv = (HG ? C_HI : C_GV) + h * 128, cc = (HG ? 256 : 0) + h * DK;
    LAS unsigned char* lds = F.lds;
    unsigned gsrc[NL]; int ldst[NL];
#pragma unroll
    for (int k = 0; k < NL; ++k) { const int reg = (NTHREADS * k) / NQC;
        if (reg < 1) { const int e2 = tid + NTHREADS * k, r = e2 / QCH, c = e2 % QCH; gsrc[k] = (unsigned)(r * YW + ck + 8 * c); ldst[k] = r * QS + 16 * c; }
        else { const int e3 = tid + NTHREADS * k - NQC, r = e3 >> 4, c = e3 & 15; gsrc[k] = (unsigned)(r * YW + cv + 8 * c); ldst[k] = QB + r * VSt + 16 * c; } }
    const size_t rowb = (size_t)b * LP;
    float S[NO][16];
#pragma unroll
    for (int i = 0; i < NO; ++i)
#pragma unroll
        for (int r = 0; r < 16; ++r) S[i][r] = 0.f;
    f32x4 prod;
    { const size_t ro = (rowb + 64 * n0) * YW; u32x4 st[NL];
#pragma unroll
      for (int k = 0; k < NL; ++k) st[k] = *(const GAS u32x4*)gp(Ym + ro + gsrc[k]);
      const f32x4 cst = *(const GAS f32x4*)gp(c1g + (size_t)(b * NCHUNK + n0) * 768 + cc + 4 * (tid & (DK / 4 - 1)));
#pragma unroll
      for (int k = 0; k < NL; ++k) *(LAS u32x4*)(lds + ldst[k]) = st[k];
      if (tid < DK / 4) *(LAS f32x4*)(lds + QB + VB + 16 * tid) = cst;
      prod = cst; }
    __syncthreads();
    const int trq = (lane & 15) >> 2, trc = (16 * ((lane >> 4) & 1) + 4 * (lane & 3)) * 2;
    int cur = 0;
    for (int c = 0; c < nc; ++c) {
        const bool more = c + 1 < nc; const int nn = n0 + c + (more ? 1 : 0); const size_t ron = (rowb + 64 * nn) * YW; LAS unsigned char* nb = lds + (cur ^ 1) * BUFB;
        u32x4 st[NL];
#pragma unroll
        for (int k = 0; k < NL; ++k) st[k] = *(const GAS u32x4*)gp(Ym + ron + gsrc[k]);
        const f32x4 cst = *(const GAS f32x4*)gp(c1g + (size_t)(b * NCHUNK + nn) * 768 + cc + 4 * (tid & (DK / 4 - 1)));
        const LAS unsigned char* kt = lds + cur * BUFB; const LAS unsigned char* vt = kt + QB; const LAS float* c1l = (const LAS float*)(vt + VB);
#pragma unroll
        for (int ii = 0; ii < NO; ++ii) { const int i = th + 2 * ii;
#pragma unroll
            for (int g4 = 0; g4 < 4; ++g4) { const f32x4 dc = *(const LAS f32x4*)(c1l + 32 * i + 8 * g4 + 4 * hi);
#pragma unroll
                for (int e = 0; e < 4; ++e) S[ii][4 * g4 + e] *= dc[e]; }
            f32x16 T = {};
#pragma unroll
            for (int s_ = 0; s_ < 4; ++s_) { const LAS unsigned char* kp = kt + (16 * s_ + 8 * hi + trq) * QS + 64 * i + trc; const LAS unsigned char* vp = vt + (16 * s_ + 8 * hi + trq) * VSt + 64 * j + trc;
                const s16x4 ka = vtr(kp), kb2 = vtr(kp + 4 * QS), va = vtr(vp), vb2 = vtr(vp + 4 * VSt);
                T = __builtin_amdgcn_mfma_f32_32x32x16_bf16((bf16x8){ka[0], ka[1], ka[2], ka[3], kb2[0], kb2[1], kb2[2], kb2[3]}, (bf16x8){va[0], va[1], va[2], va[3], vb2[0], vb2[1], vb2[2], vb2[3]}, T, 0, 0, 0); }
#pragma unroll
            for (int r = 0; r < 16; ++r) S[ii][r] += T[r]; }
#pragma unroll
        for (int k = 0; k < NL; ++k) *(LAS u32x4*)(nb + ldst[k]) = st[k];
        if (tid < DK / 4) *(LAS f32x4*)(nb + QB + VB + 16 * tid) = cst;
        if (more) prod = prod * cst;
        __syncthreads();
        cur ^= 1;
    }
#pragma unroll
    for (int ii = 0; ii < NO; ++ii) { const int i = th + 2 * ii;
#pragma unroll
        for (int r = 0; r < 16; ++r) *(GAS float*)gpw(sloc + (size_t)(((i * 4 + j) * 16 + r) * 64 + lane)) = S[ii][r]; }
    if (tid < DK / 4) *(GAS f32x4*)gpw((f32x4*)dtot + tid) = prod;
}
template <int DK, bool HG>
__device__ __forceinline__ void unit(const Frame& F, int layer, int b, int h, int seg, int uidx) {
    const int n0 = seg == 0 ? 1 : 34 + 32 * (seg - 1), nc = seg == 0 ? 33 : 32, nend = n0 + nc;
    float* slocb = (float*)(F.ws + WS_SLOC) + (size_t)uidx * NSEG * 16384; float* dtotb = (float*)(F.ws + WS_DTOT) + (size_t)uidx * NSEG * 128;
    unsigned* cnt = (unsigned*)(F.ws + WS_CTL) + CW_LINC + 64 * ((2 * layer + F.dry) * 32 + uidx);
    pass1<DK, HG>(F, b, h, n0, nc, slocb + (size_t)seg * 16384, dtotb + seg * 128);
    asm volatile("s_waitcnt vmcnt(0)" ::: "memory");
    __syncthreads();
    if (F.tid == 0) { __builtin_amdgcn_fence(__ATOMIC_RELEASE, "agent"); asm volatile("s_waitcnt vmcnt(0)" ::: "memory"); (void)xb_add(cnt, 1u);
        if (seg > 0) { unsigned sp = 0; while (xb_ld(cnt) < (unsigned)NSEG) { __builtin_amdgcn_s_sleep(2); if (++sp > (1u << 22)) break; }
            __builtin_amdgcn_fence(__ATOMIC_ACQUIRE, "agent"); asm volatile("s_waitcnt vmcnt(0)" ::: "memory"); } }
    __syncthreads();
    constexpr int QS = DK * 2 + 16, VSt = 320, QB = 64 * QS, VB = 64 * VSt, CB = DK * 4, BUFB = 2 * QB + VB + CB, XCO = BUFB, SSO = XCO + 32768, ONO = SSO + 1024, NI = DK / 32, NO = NI / 2, QCH = DK / 8;
    static_assert(ONO + 512 <= RING_BYTES, "lin LDS");
    constexpr int NQC = 64 * QCH, NLD = (2 * NQC + 1024) / NTHREADS; static_assert(NQC % NTHREADS == 0, "staging regions");
    bf16* Ym = (bf16*)(F.ws + WS_YM); const float* c1g = (const float*)(F.ws + WS_C12);
    const int tid = F.tid, lane = F.lane, wave = F.wave, j = wave & 3, th = wave >> 2, r32 = lane & 31, hi = lane >> 5;
    const int cq = (HG ? C_HQ : C_GQ) + h * DK, ck = (HG ? C_HF : C_GK) + h * DK, cv = (HG ? C_HI : C_GV) + h * 128, cg = (HG ? C_HG : C_GR) + h * 128, cc = (HG ? 256 : 0) + h * DK;
    LAS unsigned char* lds = F.lds;
    unsigned gsrc[NLD]; int ldst[NLD];
#pragma unroll
    for (int k = 0; k < NLD; ++k) { const int reg = (NTHREADS * k) / NQC;
        if (reg < 2) { const int e2 = tid + NTHREADS * k - reg * NQC, r = e2 / QCH, c = e2 % QCH; gsrc[k] = (unsigned)(r * YW + (reg == 0 ? cq : ck) + 8 * c); ldst[k] = reg * QB + r * QS + 16 * c; }
        else { const int e3 = tid + NTHREADS * k - 2 * NQC, r = e3 >> 4, c = e3 & 15; gsrc[k] = (unsigned)(r * YW + cv + 8 * c); ldst[k] = 2 * QB + r * VSt + 16 * c; } }
    const size_t rowb = (size_t)b * LP;
    if (tid < 128) ((LAS float*)(lds + ONO))[tid] = (inptr(HG ? 14 : 12) + layer * 128)[tid];
    float S[NO][16];
#pragma unroll
    for (int i = 0; i < NO; ++i)
#pragma unroll
        for (int r = 0; r < 16; ++r) S[i][r] = 0.f;
#pragma unroll 1
    for (int g = 0; g < seg; ++g) {
#pragma unroll
        for (int ii = 0; ii < NO; ++ii) { const int i = th + 2 * ii;
#pragma unroll
            for (int g4 = 0; g4 < 4; ++g4) { const f32x4 dd = *(const GAS f32x4*)gp(dtotb + g * 128 + 32 * i + 8 * g4 + 4 * hi);
#pragma unroll
                for (int e = 0; e < 4; ++e) { const int r = 4 * g4 + e; S[ii][r] = dd[e] * S[ii][r] + *(const GAS float*)gp(slocb + (size_t)g * 16384 + ((i * 4 + j) * 16 + r) * 64 + lane); } } } }
    { const size_t ro = (rowb + 64 * n0) * YW;
#pragma unroll
      for (int k = 0; k < NLD; ++k) { const u32x4 v = *(const GAS u32x4*)gp(Ym + ro + gsrc[k]); *(LAS u32x4*)(lds + ldst[k]) = v; }
      if (tid < DK / 4) { const f32x4 cst = *(const GAS f32x4*)gp(c1g + (size_t)(b * NCHUNK + n0) * 768 + cc + 4 * tid); *(LAS f32x4*)(lds + 2 * QB + VB + 16 * tid) = cst; } }
    __syncthreads();
    const LAS unsigned char* qt = lds; const LAS unsigned char* kt = qt + QB; const LAS unsigned char* vt = kt + QB; const LAS float* c1l = (const LAS float*)(vt + VB);
    const int trq = (lane & 15) >> 2, trc = (16 * ((lane >> 4) & 1) + 4 * (lane & 3)) * 2;
    for (int n = n0; n < nend; ++n) {
        const int nn = n + 1 < nend ? n + 1 : n; const size_t ron = (rowb + 64 * nn) * YW;
        u32x4 st[NLD];
#pragma unroll
        for (int k = 0; k < NLD; ++k) st[k] = *(const GAS u32x4*)gp(Ym + ron + gsrc[k]);
        const f32x4 cst = *(const GAS f32x4*)gp(c1g + (size_t)(b * NCHUNK + nn) * 768 + cc + 4 * (tid & (DK / 4 - 1)));
        bf16* yrow = Ym + (rowb + 64 * n + 32 * th + r32) * YW;
        u32x2 gt[4];
#pragma unroll
        for (int g4 = 0; g4 < 4; ++g4) gt[g4] = *(const GAS u32x2*)gp(yrow + cg + 32 * j + 8 * g4 + 4 * hi);
        f32x16 o = {};
#pragma unroll
        for (int jb = 0; jb < 2; ++jb) { f32x16 AT = {};
#pragma unroll
            for (int ks = 0; ks < DK / 16; ++ks) { const bf16x8 bq = *(const LAS bf16x8*)(qt + (32 * th + r32) * QS + 32 * ks + 16 * hi);
                const bf16x8 ak = *(const LAS bf16x8*)(kt + (32 * jb + r32) * QS + 32 * ks + 16 * hi);
                AT = __builtin_amdgcn_mfma_f32_32x32x16_bf16(ak, bq, AT, 0, 0, 0); }
            int tq = 32 * th + r32 - 32 * jb;
            asm volatile("" : "+v"(tq));
#pragma unroll
            for (int r = 0; r < 16; ++r) AT[r] = (crow(r, hi) > tq) ? 0.f : AT[r];
#pragma unroll
            for (int sp = 0; sp < 2; ++sp) { u32x4 w; w.x = cvtpk(AT[8 * sp], AT[8 * sp + 1]); w.y = cvtpk(AT[8 * sp + 2], AT[8 * sp + 3]); w.z = cvtpk(AT[8 * sp + 4], AT[8 * sp + 5]); w.w = cvtpk(AT[8 * sp + 6], AT[8 * sp + 7]);
                const LAS unsigned char* vp = vt + (32 * jb + 16 * sp + 4 * hi + trq) * VSt + 64 * j + trc;
                const s16x4 lo = vtr(vp), h4 = vtr(vp + 8 * VSt);
                o = __builtin_amdgcn_mfma_f32_32x32x16_bf16((bf16x8){lo[0], lo[1], lo[2], lo[3], h4[0], h4[1], h4[2], h4[3]}, __builtin_bit_cast(bf16x8, w), o, 0, 0, 0); }
            __builtin_amdgcn_sched_barrier(0); }
        f32x16 op = {};
#pragma unroll
        for (int ii = 0; ii < NO; ++ii) { const int i = th + 2 * ii;
#pragma unroll
            for (int g4 = 0; g4 < 4; ++g4) { const f32x4 dc = *(const LAS f32x4*)(c1l + 32 * i + 8 * g4 + 4 * hi);
#pragma unroll
                for (int e = 0; e < 4; ++e) S[ii][4 * g4 + e] *= dc[e]; }
#pragma unroll
            for (int sp = 0; sp < 2; ++sp) { u32x4 w; w.x = cvtpk(S[ii][8 * sp], S[ii][8 * sp + 1]); w.y = cvtpk(S[ii][8 * sp + 2], S[ii][8 * sp + 3]); w.z = cvtpk(S[ii][8 * sp + 4], S[ii][8 * sp + 5]); w.w = cvtpk(S[ii][8 * sp + 6], S[ii][8 * sp + 7]);
                const LAS unsigned char* qo_ = qt + (32 * th + r32) * QS + (32 * i + 16 * sp + 4 * hi) * 2; const LAS unsigned char* qp_ = qt + (32 * (th ^ 1) + r32) * QS + (32 * i + 16 * sp + 4 * hi) * 2;
                const u32x2 b0 = *(const LAS u32x2*)qo_, b1 = *(const LAS u32x2*)(qo_ + 16), c0 = *(const LAS u32x2*)qp_, c1 = *(const LAS u32x2*)(qp_ + 16);
                o = __builtin_amdgcn_mfma_f32_32x32x16_bf16(__builtin_bit_cast(bf16x8, w), __builtin_bit_cast(bf16x8, (u32x4){b0.x, b0.y, b1.x, b1.y}), o, 0, 0, 0);
                op = __builtin_amdgcn_mfma_f32_32x32x16_bf16(__builtin_bit_cast(bf16x8, w), __builtin_bit_cast(bf16x8, (u32x4){c0.x, c0.y, c1.x, c1.y}), op, 0, 0, 0); }
            f32x16 T = {};
#pragma unroll
            for (int s_ = 0; s_ < 4; ++s_) { const LAS unsigned char* kp = kt + (16 * s_ + 8 * hi + trq) * QS + 64 * i + trc; const LAS unsigned char* vp = vt + (16 * s_ + 8 * hi + trq) * VSt + 64 * j + trc;
                const s16x4 ka = vtr(kp), kb2 = vtr(kp + 4 * QS), va = vtr(vp), vb2 = vtr(vp + 4 * VSt);
                T = __builtin_amdgcn_mfma_f32_32x32x16_bf16((bf16x8){ka[0], ka[1], ka[2], ka[3], kb2[0], kb2[1], kb2[2], kb2[3]}, (bf16x8){va[0], va[1], va[2], va[3], vb2[0], vb2[1], vb2[2], vb2[3]}, T, 0, 0, 0); }
#pragma unroll
            for (int r = 0; r < 16; ++r) S[ii][r] += T[r];
            __builtin_amdgcn_sched_barrier(0); }
        { LAS float* xo = (LAS float*)(lds + XCO) + wave * 1024 + lane;
#pragma unroll
          for (int r = 0; r < 16; ++r) xo[64 * r] = op[r]; }
        __syncthreads();
        { const LAS float* xi = (const LAS float*)(lds + XCO) + (wave ^ 4) * 1024 + lane;
#pragma unroll
          for (int r = 0; r < 16; ++r) o[r] += xi[64 * r]; }
        float ssq = 0.f;
#pragma unroll
        for (int r = 0; r < 16; ++r) ssq += o[r] * o[r];
        ssq = xhalf_sum(ssq);
        LAS float* ssb = (LAS float*)(lds + SSO);
        if (hi == 0) ssb[(th * 4 + j) * 32 + r32] = ssq;
#pragma unroll
        for (int k = 0; k < NLD; ++k) *(LAS u32x4*)(lds + ldst[k]) = st[k];
        if (tid < DK / 4) *(LAS f32x4*)(lds + 2 * QB + VB + 16 * tid) = cst;
        __syncthreads();
        const float tot = ssb[(th * 4 + 0) * 32 + r32] + ssb[(th * 4 + 1) * 32 + r32] + ssb[(th * 4 + 2) * 32 + r32] + ssb[(th * 4 + 3) * 32 + r32];
        const float rstd = frsq(tot * (1.f / 128.f) + EPS);
#pragma unroll
        for (int g4 = 0; g4 < 4; ++g4) { const f32x4 on = *(const LAS f32x4*)(lds + ONO + (32 * j + 8 * g4 + 4 * hi) * 4);
            const float v0 = o[4 * g4] * rstd * on[0] * siluf_(bflo(gt[g4].x)), v1 = o[4 * g4 + 1] * rstd * on[1] * siluf_(bfhi(gt[g4].x));
            const float v2 = o[4 * g4 + 2] * rstd * on[2] * siluf_(bflo(gt[g4].y)), v3 = o[4 * g4 + 3] * rstd * on[3] * siluf_(bfhi(gt[g4].y));
            u32x2 w; w.x = cvtpk(v0, v1); w.y = cvtpk(v2, v3); if (!F.dry) *(GAS u32x2*)gpw(yrow + cv + 32 * j + 8 * g4 + 4 * hi) = w; }
    }
    __syncthreads();
}
}
__device__ __forceinline__ void phase_linattn(const Frame& F, int layer) {
    if (F.bid < 32 * lin::NSEG) { const int seg = F.bid >> 5, u = F.bid & 31, br = u >> 4, b = (u >> 2) & 3, h = u & 3;
        if (br == 0) lin::unit<64, false>(F, layer, b, h, seg, u); else lin::unit<128, true>(F, layer, b, h, seg, u); }
}

__device__ __forceinline__ void phase_route(const Frame& F, const float* gain) {
    const bf16* H = (const bf16*)(F.ws + WS_H); const float* wr_ = inptr(23); const float* br_ = inptr(24);
    int* asg_e = (int*)(F.ws + WS_SMALL + SM_ASG_E); int* asg_i = (int*)(F.ws + WS_SMALL + SM_ASG_I); float* asg_w = (float*)(F.ws + WS_SMALL + SM_ASG_W);
    unsigned* ctl = (unsigned*)(F.ws + WS_CTL);
    f32x4 wa[4][4], wc[4][4];
#pragma unroll
    for (int j = 0; j < 4; ++j) { const f32x4 g = gld<f32x4>((const f32x4*)gain + F.lane + 64 * j); const f32x4* w0 = (const f32x4*)(wr_ + (size_t)(4 * (F.lane + 64 * j)) * 8);
#pragma unroll
        for (int kk = 0; kk < 4; ++kk) { wa[j][kk] = gld<f32x4>(w0 + 2 * kk) * g[kk]; wc[j][kk] = gld<f32x4>(w0 + 2 * kk + 1) * g[kk]; } }
    float brr[8];
#pragma unroll
    for (int e = 0; e < 8; ++e) brr[e] = gld<float>(br_ + e);
    constexpr int NT = BATCH * SEQ;
    int me1 = 0, me2 = 0, mt = -1, kit = 0; float mw1 = 0.f;
    u32x2 rw[4][4];
    const int npw_ = (NT + F.NGW - 1) / F.NGW, tw0 = F.gw * npw_, tw1 = (tw0 + npw_) < NT ? (tw0 + npw_) : NT;
#pragma unroll
    for (int q = 0; q < 4; ++q) { const int tq = tw0 + q < tw1 ? tw0 + q : tw0, b = tq / SEQ, r = b * LP + 128 + (tq - b * SEQ);
#pragma unroll
        for (int j = 0; j < 4; ++j) rw[q][j] = *(const GAS u32x2*)gp((const u32x2*)(H + (size_t)r * D) + F.lane + 64 * j); }
    for (int t0 = tw0; t0 < tw1; t0 += 4)
#pragma unroll
    for (int q = 0; q < 4; ++q) { const int t = t0 + q; if (t >= tw1) break;
        f32x4 v[4];
#pragma unroll
        for (int j = 0; j < 4; ++j) { const u32x2 w = rw[q][j]; v[j] = (f32x4){bflo(w.x), bfhi(w.x), bflo(w.y), bfhi(w.y)}; }
        { const int tn = t + 4 < tw1 ? t + 4 : t, b = tn / SEQ, r = b * LP + 128 + (tn - b * SEQ);
#pragma unroll
          for (int j = 0; j < 4; ++j) rw[q][j] = *(const GAS u32x2*)gp((const u32x2*)(H + (size_t)r * D) + F.lane + 64 * j); }
        const float rstd = row_rstd(F, v);
        float lg[8];
#pragma unroll
        for (int e = 0; e < 8; ++e) lg[e] = 0.f;
#pragma unroll
        for (int j = 0; j < 4; ++j) {
#pragma unroll
            for (int kk = 0; kk < 4; ++kk) { const float uu = v[j][kk] * rstd; const f32x4 a = wa[j][kk], c = wc[j][kk];
                lg[0] += uu * a.x; lg[1] += uu * a.y; lg[2] += uu * a.z; lg[3] += uu * a.w; lg[4] += uu * c.x; lg[5] += uu * c.y; lg[6] += uu * c.z; lg[7] += uu * c.w; } }
#pragma unroll
        for (int e = 0; e < 8; ++e) lg[e] = wave_sum(F.lane, lg[e]) + brr[e];
        int e1 = 0; float v1 = lg[0];
#pragma unroll
        for (int e = 1; e < 8; ++e) if (lg[e] > v1) { v1 = lg[e]; e1 = e; }
        int e2 = -1; float v2 = -INFINITY;
#pragma unroll
        for (int e = 0; e < 8; ++e) if (e != e1 && lg[e] > v2) { v2 = lg[e]; e2 = e; }
        const float w1 = 1.f / (1.f + __expf(v2 - v1)), w2 = 1.f - w1;
        if (F.lane == kit) { me1 = e1; me2 = e2; mw1 = w1; mt = t; }
        ++kit; (void)w2;
    }
    const int npw = (NT + F.NGW - 1) / F.NGW, K = NWAVES * npw;
    LAS int* le = (LAS int*)F.lds; LAS int* lt = le + 1024; LAS float* lw = (LAS float*)(le + 1536); LAS unsigned* lbase = (LAS unsigned*)(le + 2048);
    __syncthreads();
    if (F.lane < npw) { const int k = F.wave * npw + F.lane; le[k] = mt >= 0 ? me1 : -1; le[512 + k] = mt >= 0 ? me2 : -1; lt[k] = mt; lw[k] = mw1; }
    __syncthreads();
    int my_e[2] = {-1, -1}, my_r[2] = {0, 0}, my_k[2] = {0, 0};
#pragma unroll
    for (int q = 0; q < 2; ++q) { const int x = F.tid + q * NTHREADS; if (x < 2 * K) { const int rk = x / K, k = x - rk * K; const int e = le[rk * 512 + k]; int cnt = 0, rnk = 0;
            for (int k2 = 0; k2 < K; ++k2) { const int ee = le[rk * 512 + k2]; cnt += (ee == e) ? 1 : 0; rnk += (ee == e && k2 < k) ? 1 : 0; }
            my_e[q] = e; my_r[q] = rnk; my_k[q] = x;
            if (e >= 0 && rnk == 0 && !F.dry) lbase[rk * 8 + e] = atomicAdd(ctl + CW_CNT + 64 * (rk * 8 + e), (unsigned)cnt); } }
    __syncthreads();
#pragma unroll
    for (int q = 0; q < 2; ++q) if (my_e[q] >= 0 && !F.dry) { const int x = my_k[q], rk = x / K, k = x - rk * K, t = lt[k]; const float w1 = lw[k];
        asg_e[rk * 32768 + t] = my_e[q]; asg_i[rk * 32768 + t] = (int)(lbase[rk * 8 + my_e[q]] + (unsigned)my_r[q]); asg_w[rk * 32768 + t] = rk ? 1.f - w1 : w1; }
    __syncthreads();
}
__device__ __forceinline__ void phase_scatter(const Frame& F, const float* gain) {
    const bf16* H = (const bf16*)(F.ws + WS_H);
    const int* asg_e = (const int*)(F.ws + WS_SMALL + SM_ASG_E); const int* asg_i = (const int*)(F.ws + WS_SMALL + SM_ASG_I); const float* asg_w = (const float*)(F.ws + WS_SMALL + SM_ASG_W);
    int* slot_tok = (int*)(F.ws + WS_SMALL + SM_SLOT_TOK); float* slot_w = (float*)(F.ws + WS_SMALL + SM_SLOT_W);
    int* tile_e = (int*)(F.ws + WS_SMALL + SM_TILE_E); int* ntl = (int*)(F.ws + WS_SMALL + SM_NT);
    unsigned* ctl = (unsigned*)(F.ws + WS_CTL);
    unsigned char* xb[2] = {F.ws + WS_XB, F.ws + WS_XB + (size_t)MOE_ROWS * D};
    LAS int* tb = (LAS int*)(F.lds + TAB_OFF);
    if (F.tid < 16) tb[16 + F.tid] = (int)xb_ld(ctl + CW_CNT + 64 * F.tid);
    __syncthreads();
    if (F.tid == 0) {
#pragma unroll 1
        for (int rk = 0; rk < 2; ++rk) { int t = 0;
#pragma unroll 1
            for (int e = 0; e < 8; ++e) { tb[rk * 8 + e] = t; const int nt_ = (tb[16 + rk * 8 + e] + 255) >> 8;
                if (F.bid == 0) {
#pragma unroll 1
                    for (int q = 0; q < nt_; ++q) tile_e[rk * 256 + t + q] = e; }
                t += nt_; }
            if (F.bid == 0) ntl[rk] = t; } }
    __syncthreads();
    for (int g = 0; g < 16; ++g) { const int rk = g >> 3, cnt = tb[16 + g], base = tb[g] * 256, end = base + ((cnt + 255) >> 8) * 256;
        for (int s = base + cnt + F.gw; s < end; s += F.NGW) { if (F.lane == 0) { slot_tok[rk * MOE_ROWS + s] = -1; slot_w[rk * MOE_ROWS + s] = 0.f; }
            u32x4* xr = (u32x4*)(xb[rk] + (size_t)s * D); xr[F.lane] = zero4(); } }
    constexpr int NT = BATCH * SEQ;
    const int npw = (NT + F.NGW - 1) / F.NGW, tw0 = F.gw * npw, tw1 = (tw0 + npw) < NT ? (tw0 + npw) : NT;
    int ae[2], ai[2]; float aw[2];
    { const int tl = tw0 + F.lane < tw1 ? tw0 + F.lane : (tw0 < NT ? tw0 : 0);
#pragma unroll
      for (int rk = 0; rk < 2; ++rk) { ae[rk] = gld<int>(asg_e + rk * 32768 + tl); ai[rk] = gld<int>(asg_i + rk * 32768 + tl); aw[rk] = gld<float>(asg_w + rk * 32768 + tl); } }
    f32x4 gn[4];
#pragma unroll
    for (int j = 0; j < 4; ++j) gn[j] = gld<f32x4>((const f32x4*)gain + F.lane + 64 * j);
    u32x2 rw[4][4];
#pragma unroll
    for (int q = 0; q < 4; ++q) { const int tq = tw0 + q < tw1 ? tw0 + q : (tw0 < NT ? tw0 : 0), b = tq / SEQ, r = b * LP + 128 + (tq - b * SEQ);
#pragma unroll
        for (int j = 0; j < 4; ++j) rw[q][j] = *(const GAS u32x2*)gp((const u32x2*)(H + (size_t)r * D) + F.lane + 64 * j); }
    for (int t0 = tw0; t0 < tw1; t0 += 4)
#pragma unroll
    for (int q = 0; q < 4; ++q) { const int t = t0 + q; if (t >= tw1) break;
        const int b = t / SEQ, r = b * LP + 128 + (t - b * SEQ), k = t - tw0;
        f32x4 v[4];
#pragma unroll
        for (int j = 0; j < 4; ++j) { const u32x2 w = rw[q][j]; v[j] = (f32x4){bflo(w.x), bfhi(w.x), bflo(w.y), bfhi(w.y)}; }
        { const int tn = t + 4 < tw1 ? t + 4 : t, bn = tn / SEQ, rn = bn * LP + 128 + (tn - bn * SEQ);
#pragma unroll
          for (int j = 0; j < 4; ++j) rw[q][j] = *(const GAS u32x2*)gp((const u32x2*)(H + (size_t)rn * D) + F.lane + 64 * j); }
        const float rstd = row_rstd(F, v);
#pragma unroll
        for (int rk = 0; rk < 2; ++rk) { const int e = __builtin_amdgcn_readlane(ae[rk], k), s = tb[rk * 8 + e] * 256 + __builtin_amdgcn_readlane(ai[rk], k);
            const float wgt = __builtin_bit_cast(float, __builtin_amdgcn_readlane(__builtin_bit_cast(int, aw[rk]), k)); const float sc = rstd * XB_SCALE;
            unsigned* o4 = (unsigned*)(xb[rk] + (size_t)s * D) + F.lane;
#pragma unroll
            for (int j = 0; j < 4; ++j) gst<unsigned>(o4 + 64 * j, pg8::fp8x4((f32x4){v[j].x * sc * gn[j].x, v[j].y * sc * gn[j].y, v[j].z * sc * gn[j].z, v[j].w * sc * gn[j].w}));
            if (F.lane == 0) { gst<int>(slot_tok + rk * MOE_ROWS + s, r); gst<float>(slot_w + rk * MOE_ROWS + s, wgt); } }
    }
}
__device__ __forceinline__ void convert_expert_weights(const Frame& F) {
    unsigned char* GU = F.ws + WS_WEXP; unsigned char* DT = F.ws + WS_WEXP + (size_t)8 * 7168 * 1024;
    LAS float* scr = (LAS float*)(F.lds + F.wave * 16384);
    for (int it = F.gw; it < NEXP * 3 * 1792; it += F.NGW) {
        const int e = it / 5376, r = it - e * 5376, m = r / 1792, t = r - m * 1792;
        if (m < 2) { const int kb = t / 112, n0 = (t % 112) * 32; const float* W = inptr(m == 0 ? 25 : 26) + (size_t)e * D * DEXP;
            transpose_tile<true>(W, (size_t)DEXP, kb * 64, n0, 32, (bf16*)(GU + (size_t)e * 7168 * 1024), (size_t)D, 256 * (n0 / 128) + (n0 % 128) + 128 * m, kb * 64, nullptr, WU_SCALE, scr, F.lane); }
        else { const int kb = t / 32, n0 = (t % 32) * 32; const float* W = inptr(27) + (size_t)e * DEXP * D;
            transpose_tile<true>(W, (size_t)D, kb * 64, n0, 32, (bf16*)(DT + (size_t)e * 1024 * DEXP), (size_t)DEXP, n0, kb * 64, nullptr, WD_SCALE, scr, F.lane); }
    }
}
__device__ __forceinline__ void convert_ffn_weights(const Frame& F) {
    bf16* GU = (bf16*)(F.ws + WS_WFF); bf16* DT = GU + (size_t)2 * DFF * D;
    conv_matrix<1>(F, inptr(20), D, DFF, DFF, 0, GU, D, 0, nullptr);
    conv_matrix<1>(F, inptr(21), D, DFF, DFF, 0, GU, D, 128, nullptr);
    conv_matrix<0>(F, inptr(22), DFF, D, D, 0, DT, DFF, 0, nullptr);
}

namespace sk {
constexpr int CW_ERR = 32768;
constexpr size_t WS_DBG = 110 * MiB;
template <int NACC>
__device__ __forceinline__ void dot16(const bf16* A, size_t lda, const bf16* W0, const bf16* W1, size_t ldb, int nk, int lane, f32x4 (&acc)[NACC]) {
    const int i = lane & 15, kq = lane >> 4;
    const bf16* ap = A + (size_t)i * lda + 8 * kq; const bf16* w0 = W0 + (size_t)i * ldb + 8 * kq; const bf16* w1 = W1 + (size_t)i * ldb + 8 * kq;
#pragma unroll 1
    for (int s = 0; s < nk; s += 4) {
        bf16x8 a[4], b0[4], b1[4];
#pragma unroll
        for (int q = 0; q < 4; ++q) { const int ss = (s + q < nk) ? s + q : s;
            a[q] = *(const GAS bf16x8*)gp((const bf16x8*)(ap + 32 * ss)); b0[q] = *(const GAS bf16x8*)gp((const bf16x8*)(w0 + 32 * ss));
            if (NACC == 2) b1[q] = *(const GAS bf16x8*)gp((const bf16x8*)(w1 + 32 * ss)); }
#pragma unroll
        for (int q = 0; q < 4; ++q) if (s + q < nk) { acc[0] = __builtin_amdgcn_mfma_f32_16x16x32_bf16(b0[q], a[q], acc[0], 0, 0, 0);
            if (NACC == 2) acc[1] = __builtin_amdgcn_mfma_f32_16x16x32_bf16(b1[q], a[q], acc[1], 0, 0, 0); }
    }
}
template <int NACC>
__device__ __forceinline__ void reduce8(const Frame& F, f32x4 (&acc)[NACC]) {
    LAS f32x4* red = (LAS f32x4*)F.lds;
#pragma unroll
    for (int a = 0; a < NACC; ++a) red[(a * 8 + F.wave) * 64 + F.lane] = acc[a];
    __syncthreads();
    if (F.wave == 0) {
#pragma unroll
        for (int a = 0; a < NACC; ++a) { f32x4 s = red[(a * 8) * 64 + F.lane];
#pragma unroll
            for (int w = 1; w < 8; ++w) s += red[(a * 8 + w) * 64 + F.lane];
            acc[a] = s; } }
}
struct Cnt { unsigned n, e; };
__device__ __forceinline__ void chk(Cnt& C, float mine, float ref, float rel, float ab) {
#ifdef SK_EXACT
    rel = 0.f; ab = 0.f;
#endif
    C.n += 1u; if (!(fabsf(mine - ref) <= rel * fmaxf(fabsf(mine), fabsf(ref)) + ab)) C.e += 1u;
}
__device__ __forceinline__ void flush(const Frame& F, const Cnt& C) {
    unsigned* ctl = (unsigned*)(F.ws + WS_CTL);
    if (C.n) atomicAdd(ctl + CW_ERR + 64, C.n);
    if (C.e) atomicAdd(ctl + CW_ERR, C.e);
}
__device__ __forceinline__ u32x2 pack4(const f32x4 v) { u32x2 w; w.x = pg8::cvt_pk_bf16(v[0], v[1]); w.y = pg8::cvt_pk_bf16(v[2], v[3]); return w; }
template <bool CHECK>
__device__ __forceinline__ void put4(const Frame& F, Cnt& C, bf16* dst, size_t rs, const f32x4 v, int nb, float rel, float ab) {
    const u32x2 w = pack4(v);
#pragma unroll
    for (int b = 0; b < 4; ++b) if (b < nb) { u32x2* p = (u32x2*)(dst + (size_t)b * LP * rs);
        if (CHECK) { const u32x2 m = gld<u32x2>(p); chk(C, bflo(w.x), bflo(m.x), rel, ab); chk(C, bfhi(w.x), bfhi(m.x), rel, ab); chk(C, bflo(w.y), bflo(m.y), rel, ab); chk(C, bfhi(w.y), bfhi(m.y), rel, ab); }
        else if (!F.dry) gst<u32x2>(p, w); }
}
template <bool CHECK>
__device__ __forceinline__ void inproj(const Frame& F) { Cnt C{0u, 0u};
    const bf16* U = (const bf16*)(F.dout + DO_U) + (size_t)PADL * D; const bf16* W = (const bf16*)(F.ws + WS_WL + WL_IN);
    bf16* Ym = (bf16*)(F.ws + WS_YM); unsigned char* Yg = F.ws + WS_YG;
    if (!CHECK && !F.dry) { const u32x4 z4 = zero4();
        for (int idx = F.bid * NTHREADS + F.tid; idx < BATCH * PADL * (YW / 8); idx += F.G * NTHREADS) { const int row = idx / (YW / 8), c8 = idx % (YW / 8), b = row / PADL, p = row % PADL;
            gst<u32x4>(Ym + ((size_t)b * LP + p) * YW + 8 * c8, z4); } }
    for (int g = F.bid; g < 251 + 192; g += F.G) {
        const int wrow = g < 251 ? 16 * g : YW + 16 * (g - 251);
        f32x4 acc[1] = {(f32x4){0.f, 0.f, 0.f, 0.f}};
        dot16<1>(U + 128 * F.wave, D, W + (size_t)wrow * D + 128 * F.wave, W, D, 4, F.lane, acc);
        reduce8<1>(F, acc);
        if (F.wave == 0) { const int i = F.lane & 15, c = 4 * (F.lane >> 4);
            if (g < 251) put4<CHECK>(F, C, Ym + (size_t)(PADL + i) * YW + 16 * g + c, YW, acc[0], 4, 0.01f, 1e-3f);
            else { const unsigned w = pg8::q8(acc[0][0]) | (pg8::q8(acc[0][1]) << 8) | (pg8::q8(acc[0][2]) << 16) | (pg8::q8(acc[0][3]) << 24);
                unsigned* p = (unsigned*)(Yg + (size_t)(PADL + i) * NGATE + 16 * (g - 251) + c);
                if (CHECK) { const unsigned m = *p;
#pragma unroll
                    for (int e = 0; e < 4; ++e) chk(C, (float)((w >> (8 * e)) & 255u), (float)((m >> (8 * e)) & 255u), 0.f, 1.f); }
                else if (!F.dry) *p = w; } }
        __syncthreads();
    }
    if (CHECK) flush(F, C);
}
template <bool CHECK>
__device__ __forceinline__ void mlaprep(const Frame& F) { Cnt C{0u, 0u};
    const bf16* Ym0 = (const bf16*)(F.ws + WS_YM) + (size_t)PADL * YW; const bf16* W = (const bf16*)(F.ws + WS_WL + WL_UQKV);
    bf16* Q = (bf16*)(F.dout + DO_Q); bf16* Kb = (bf16*)(F.dout + DO_K); bf16* V = (bf16*)(F.ws + WS_V);
    if (!CHECK && !F.dry) { const u32x4 z4 = zero4();
        for (int idx = F.bid * NTHREADS + F.tid; idx < BATCH * PADL * 256; idx += F.G * NTHREADS) { const int row = idx >> 8, c = idx & 255, b = row / PADL, p = row % PADL; const size_t r = (size_t)b * LP + p;
            if (c < 96) gst<u32x4>(Q + r * QKW + 8 * c, z4); else if (c < 192) gst<u32x4>(Kb + r * QKW + 8 * (c - 96), z4); else gst<u32x4>(V + r * VW + 8 * (c - 192), z4); } }
    for (int g = F.bid; g < 48 + 64; g += F.G) {
        const bool kv = g >= 48; const int n0 = kv ? 16 * (g - 48) : 16 * g;
        f32x4 acc[1] = {(f32x4){0.f, 0.f, 0.f, 0.f}};
        dot16<1>(Ym0 + (kv ? C_DKV : C_DQ) + 32 * F.wave, YW, W + (size_t)((kv ? 768 : 0) + n0) * 256 + 32 * F.wave, W, 256, 1, F.lane, acc);
        reduce8<1>(F, acc);
        if (F.wave == 0) { const int i = F.lane & 15, c = n0 + 4 * (F.lane >> 4); const size_t r = (size_t)(PADL + i);
            if (!kv) put4<CHECK>(F, C, Q + r * QKW + c, QKW, acc[0], 4, 0.01f, 1e-3f);
            else { const int hh = c >> 7, d = c & 127;
                if (d < 64) put4<CHECK>(F, C, Kb + r * QKW + hh * 96 + d, QKW, acc[0], 4, 0.01f, 1e-3f); else put4<CHECK>(F, C, V + r * VW + hh * 64 + d - 64, VW, acc[0], 4, 0.01f, 1e-3f); } }
        __syncthreads();
    }
    if (CHECK) flush(F, C);
}
template <bool CHECK>
__device__ __forceinline__ void mix(const Frame& F) { Cnt C{0u, 0u};
    const bf16* Ym0 = (const bf16*)(F.ws + WS_YM) + (size_t)PADL * YW; const bf16* O0 = (const bf16*)(F.ws + WS_O) + (size_t)PADL * 512; const unsigned char* Yg0 = F.ws + WS_YG + (size_t)PADL * NGATE;
    bf16* Mx = (bf16*)(F.dout + DO_MIX); unsigned char* wl = F.ws + WS_WL;
    const int w = F.wave, I = w < 4 ? 0 : (w < 6 ? 1 : 2);
    const bf16* A = I == 0 ? O0 + 128 * w : (I == 1 ? Ym0 + C_GV + 256 * (w - 4) : Ym0 + C_HI + 256 * (w - 6));
    const size_t lda = I == 0 ? 512 : YW, ldb = 512; const int nk = I == 0 ? 4 : 8;
    const bf16* Wb = I == 0 ? (const bf16*)(wl + WL_OM) + 128 * w : (I == 1 ? (const bf16*)(wl + WL_OG) + 256 * (w - 4) : (const bf16*)(wl + WL_OH) + 256 * (w - 6));
    for (int g = F.bid; g < 64; g += F.G) {
        f32x4 acc[1] = {(f32x4){0.f, 0.f, 0.f, 0.f}};
        dot16<1>(A, lda, Wb + (size_t)(16 * g) * ldb, Wb, ldb, nk, F.lane, acc);
        const int i = F.lane & 15, c = 16 * g + 4 * (F.lane >> 4);
        const unsigned gw = gld<unsigned>(Yg0 + (size_t)i * NGATE + I * 1024 + c); const float s = 1.f / 255.f;
        acc[0][0] *= (float)(gw & 255u) * s; acc[0][1] *= (float)((gw >> 8) & 255u) * s; acc[0][2] *= (float)((gw >> 16) & 255u) * s; acc[0][3] *= (float)(gw >> 24) * s;
        reduce8<1>(F, acc);
        if (F.wave == 0) put4<CHECK>(F, C, Mx + (size_t)(PADL + i) * D + c, D, acc[0], 1, 0.03f, 3e-3f);
        __syncthreads();
    }
    if (CHECK) flush(F, C);
}
template <bool CHECK>
__device__ __forceinline__ void resid(const Frame& F, const bf16* A0, size_t lda, const bf16* W, int K, const bf16* hold) { Cnt C{0u, 0u};
    bf16* H = (bf16*)(F.ws + WS_H); const int nk = K / 256, k0 = (K / 8) * F.wave;
    for (int g = F.bid; g < 64; g += F.G) {
        f32x4 acc[1] = {(f32x4){0.f, 0.f, 0.f, 0.f}};
        dot16<1>(A0 + k0, lda, W + (size_t)(16 * g) * K + k0, W, (size_t)K, nk, F.lane, acc);
        reduce8<1>(F, acc);
        if (F.wave == 0) { const int i = F.lane & 15, c = 16 * g + 4 * (F.lane >> 4);
            const u32x2 x = gld<u32x2>(hold + (size_t)i * D + c);
            const f32x4 v = acc[0] + (f32x4){bflo(x.x), bfhi(x.x), bflo(x.y), bfhi(x.y)};
            put4<CHECK>(F, C, H + (size_t)(PADL + i) * D + c, D, v, 4, 0.01f, 1e-3f); }
        __syncthreads();
    }
    if (CHECK) flush(F, C);
}
template <bool CHECK>
__device__ __forceinline__ void ffn_up(const Frame& F) { Cnt C{0u, 0u};
    const bf16* U = (const bf16*)(F.dout + DO_U) + (size_t)PADL * D; const bf16* GU = (const bf16*)(F.ws + WS_WFF); bf16* Hm = (bf16*)(F.ws + WS_HMID);
    for (int g = F.bid; g < DFF / 16; g += F.G) {
        const int hc0 = 16 * g, r0 = 256 * (hc0 >> 7) + (hc0 & 127);
        f32x4 acc[2] = {(f32x4){0.f, 0.f, 0.f, 0.f}, (f32x4){0.f, 0.f, 0.f, 0.f}};
        dot16<2>(U + 128 * F.wave, D, GU + (size_t)r0 * D + 128 * F.wave, GU + (size_t)(r0 + 128) * D + 128 * F.wave, D, 4, F.lane, acc);
        reduce8<2>(F, acc);
        if (F.wave == 0) { const int i = F.lane & 15, c = hc0 + 4 * (F.lane >> 4); f32x4 h;
#pragma unroll
            for (int e = 0; e < 4; ++e) { const float gq = acc[0][e], uq = acc[1][e]; h[e] = gq * frcp(1.f + __expf(-gq)) * uq; }
            put4<CHECK>(F, C, Hm + (size_t)(PADL + i) * DFF + c, DFF, h, 1, 0.02f, 1e-3f); }
        __syncthreads();
    }
    if (CHECK) flush(F, C);
}
}

#ifndef SK_ERR_MAX
#define SK_ERR_MAX 200u
#endif
#ifndef SKMODE
#define SKMODE 1
#endif
enum { OP_INIT = 0, OP_INPROJ, OP_MLAPREP, OP_ATTN, OP_LIN, OP_MIX0, OP_MIX1, OP_MIX2, OP_CONV, OP_WOUT, OP_NORM_FFN, OP_FFN_UP, OP_FFN_DOWN, OP_NEXT, OP_ROUTE, OP_SCATTER, OP_MOE_UP, OP_MOE_DOWN, OP_MLAFIX, OP_NOP, OP_MLAPREP2 };
#define SW(op, layer, rh) ((unsigned)(op) | ((unsigned)(layer) << 5) | ((unsigned)(rh) << 6))
#define SWDRY(op, layer, rh) (SW(op, layer, rh) | 256u)
#ifndef STEP_PROGRAM
#define STEP_PROGRAM \
    SW(OP_INIT, 0, 0), \
    SW(OP_INPROJ, 0, 0), SW(OP_MLAPREP, 0, 0), SW(OP_MLAPREP2, 0, 0), SW(OP_MLAFIX, 0, 0), SW(OP_ATTN, 0, 0), SW(OP_MIX0, 0, 0), SW(OP_MIX1, 0, 0), SW(OP_MIX2, 0, 0), SW(OP_CONV, 0, 0), SW(OP_WOUT, 0, 0), \
    SW(OP_NORM_FFN, 0, 0), SW(OP_FFN_UP, 0, 0), SW(OP_FFN_DOWN, 0, 0), SW(OP_NEXT, 0, 0), \
    SW(OP_INPROJ, 1, 0), SW(OP_MLAPREP, 1, 0), SW(OP_MLAPREP2, 1, 0), SW(OP_MLAFIX, 1, 0), SW(OP_ATTN, 1, 0), SW(OP_MIX0, 1, 0), SW(OP_MIX1, 1, 0), SW(OP_MIX2, 1, 0), SW(OP_CONV, 1, 0), SW(OP_WOUT, 1, 0), \
    SW(OP_ROUTE, 1, 0), SW(OP_SCATTER, 1, 0), \
    SW(OP_MOE_UP, 1, 0), SW(OP_MOE_DOWN, 1, 0), SW(OP_MOE_UP, 1, 1), SW(OP_MOE_DOWN, 1, 1)
#endif
__device__ __forceinline__ unsigned step_word(int st) {
    constexpr unsigned prog[] = {STEP_PROGRAM};
    unsigned w = 0;
#pragma unroll
    for (int i = 0; i < (int)(sizeof(prog) / sizeof(prog[0])); ++i) w = (st == i) ? prog[i] : w;
    return w;
}
constexpr unsigned step_prog_host[] = {STEP_PROGRAM};
constexpr int NSTEP = (int)(sizeof(step_prog_host) / sizeof(step_prog_host[0]));
__global__ void __launch_bounds__(NTHREADS, 2) fwd_kernel(Args args) {
    extern __shared__ __attribute__((aligned(16))) unsigned char lds_raw[];
    Frame F;
    F.lds = (LAS unsigned char*)lds_raw; F.ws = args.ws; F.dout = (unsigned char*)args.out;
    F.tid = threadIdx.x; F.lane = F.tid & 63; F.wave = __builtin_amdgcn_readfirstlane(F.tid >> 6);
    F.G = gridDim.x; F.bid = blockIdx.x; F.gw = F.bid * NWAVES + F.wave; F.NGW = F.G * NWAVES;
    volatile LAS unsigned* MISC = (volatile LAS unsigned*)(F.lds + MISC_OFF);
    for (int u = F.tid; u < (LDS_BYTES - LDSCTL_OFF) / 4; u += NTHREADS) ((LAS unsigned*)(F.lds + LDSCTL_OFF))[u] = 0u;
    __syncthreads();
    unsigned* ctl = (unsigned*)(F.ws + WS_CTL);
    XcdBarrier bar = xcd_barrier_post(ctl + CW_BAR, MISC + 8);
    const int wave0 = F.wave;
#pragma unroll 1
    for (int st = args.ph_lo; st < args.ph_hi; ++st) {
        { unsigned char* p_ = args.ws; asm volatile("" : "+s"(p_)); F.ws = p_; p_ = (unsigned char*)args.out; asm volatile("" : "+s"(p_)); F.dout = p_;
          int wv_ = wave0; asm volatile("" : "+s"(wv_)); int ln_; asm volatile("v_mbcnt_lo_u32_b32 %0, -1, 0\n\tv_mbcnt_hi_u32_b32 %0, -1, %0" : "=v"(ln_)); int tid_ = wv_ * 64 + ln_; int bid_ = blockIdx.x; asm volatile("" : "+s"(bid_)); int G_ = gridDim.x; asm volatile("" : "+s"(G_));
          unsigned lo_ = 0; asm volatile("" : "+s"(lo_));
          F.lds = (LAS unsigned char*)lds_raw + lo_; F.tid = tid_; F.lane = tid_ & 63; F.wave = __builtin_amdgcn_readfirstlane(tid_ >> 6); F.G = G_; F.bid = bid_; F.gw = bid_ * NWAVES + F.wave; F.NGW = G_ * NWAVES; }
        LAS unsigned char* ring = F.lds;
        int layer, op, rh = 0;
        { const unsigned pw = step_word(st); op = pw & 31; layer = (pw >> 5) & 1; rh = (pw >> 6) & 3; F.dry = (pw >> 8) & 1; }
        bool is_gemm = false, sync_after = true, fp8 = false;
        pg8::Gemm g{nullptr, nullptr, 0, 0, 0}; pg8::Order S{0, 0, 0, F.G, F.bid, 0, 0, 0, (const LAS int*)(F.lds + TAB_OFF), 0, 0}; pg8::Epi E{0, nullptr, nullptr, nullptr, nullptr, 0, 0, F.dry, 1.f, 0.f};
        unsigned char* wl = F.ws + WS_WL;
        constexpr int XM = (SKMODE == 1) ? 1 : 0;
#if SKMODE == 1
        if (op == OP_INPROJ) sk::inproj<false>(F);
        else if (op == OP_MLAPREP) sk::mlaprep<false>(F);
        else if (op == OP_MIX0 && layer == 0) sk::mix<false>(F);
        else if (op == OP_WOUT && layer == 0) sk::resid<false>(F, (const bf16*)(F.dout + DO_MIX) + (size_t)PADL * D, D, (const bf16*)(wl + WL_OUT), D, (const bf16*)(F.ws + WS_H) + (size_t)PADL * D);
        else if (op == OP_FFN_UP) sk::ffn_up<false>(F);
        else if (op == OP_FFN_DOWN) sk::resid<false>(F, (const bf16*)(F.ws + WS_HMID) + (size_t)PADL * DFF, DFF, (const bf16*)(F.ws + WS_WFF) + (size_t)2 * DFF * D, DFF, (const bf16*)(F.ws + WS_H) + (size_t)PADL * D);
#elif SKMODE == 2
        { bool did = true; const bf16* dbg = (const bf16*)(F.ws + sk::WS_DBG);
          if (op == OP_MLAPREP) sk::inproj<true>(F);
          else if (op == OP_MLAFIX) sk::mlaprep<true>(F);
          else if (op == OP_CONV && layer == 0) sk::mix<true>(F);
          else if (op == OP_NORM_FFN) sk::resid<true>(F, (const bf16*)(F.dout + DO_MIX) + (size_t)PADL * D, D, (const bf16*)(wl + WL_OUT), D, dbg);
          else if (op == OP_FFN_DOWN) sk::ffn_up<true>(F);
          else if (op == OP_NEXT) sk::resid<true>(F, (const bf16*)(F.ws + WS_HMID) + (size_t)PADL * DFF, DFF, (const bf16*)(F.ws + WS_WFF) + (size_t)2 * DFF * D, DFF, dbg);
          else did = false;
          if ((op == OP_CONV || op == OP_FFN_UP) && layer == 0 && F.bid == 0) {
              for (int i = F.tid; i < 16 * D / 8; i += NTHREADS) *((u32x4*)(F.ws + sk::WS_DBG) + i) = *((const u32x4*)((const bf16*)(F.ws + WS_H) + (size_t)PADL * D) + i); }
          if (did) xcd_barrier(bar); }
#endif
        switch (op) {
        case OP_INIT:
            convert_layer_weights(F, 0); phase_rope_table(F); phase_init_rows(F, inptr(2)); break;
        case OP_INPROJ:
            is_gemm = true; g = pg8::Gemm{(const bf16*)(F.dout + DO_U), (const bf16*)(wl + WL_IN), D, D, D}; S.nM = XM ? 128 : M / 256; S.xrow = XM; S.nN = 28;
            E.kind = pg8::EK_INPROJ; E.o0 = F.ws + WS_YM; E.o1 = F.ws + WS_YG; break;
        case OP_MLAPREP:
            is_gemm = true; sync_after = false; g = pg8::Gemm{(const bf16*)(F.ws + WS_YM) + C_DQ, (const bf16*)(wl + WL_UQKV), 256, YW, 256}; S.nM = XM ? 128 : M / 256; S.xrow = XM; S.nN = 3;
            E.kind = pg8::EK_MLA; E.o0 = F.dout + DO_Q; E.o1 = F.dout + DO_K; E.i0 = F.ws + WS_V; E.fin = 0; break;
        case OP_MLAPREP2:
            is_gemm = true; g = pg8::Gemm{(const bf16*)(F.ws + WS_YM) + C_DKV, (const bf16*)(wl + WL_UQKV) + 768 * 256, 256, YW, 256}; S.nM = XM ? 128 : M / 256; S.xrow = XM; S.nN = 4;
            E.kind = pg8::EK_MLA; E.o0 = F.dout + DO_Q; E.o1 = F.dout + DO_K; E.i0 = F.ws + WS_V; E.fin = 3; break;
        case OP_MLAFIX: mla::fix(F, layer); phase_lin_prep(F, layer); break;
        case OP_NOP: break;
        case OP_ATTN: phase_linattn(F, layer); att::phase(F, layer); break;
        case OP_LIN: phase_linattn(F, layer); break;
        case OP_MIX0:
            is_gemm = true; sync_after = false; g = pg8::Gemm{(const bf16*)(F.ws + WS_O), (const bf16*)(wl + WL_OM), 512, 512, 512}; S.nM = (XM || layer) ? 128 : M / 256; S.xrow = (XM || layer) ? 1 : 0; S.nN = 4;
            E.kind = pg8::EK_MIX0; E.o0 = F.dout + DO_MIX; E.i0 = F.ws + WS_YG; break;
        case OP_MIX1:
            is_gemm = true; sync_after = false; g = pg8::Gemm{(const bf16*)(F.ws + WS_YM) + C_GV, (const bf16*)(wl + WL_OG), 512, YW, 512}; S.nM = (XM || layer) ? 128 : M / 256; S.xrow = (XM || layer) ? 1 : 0; S.nN = 4;
            E.kind = pg8::EK_MIX1; E.o0 = F.dout + DO_MIX; E.i0 = F.ws + WS_YG; break;
        case OP_MIX2:
            is_gemm = true; g = pg8::Gemm{(const bf16*)(F.ws + WS_YM) + C_HI, (const bf16*)(wl + WL_OH), 512, YW, 512}; S.nM = (XM || layer) ? 128 : M / 256; S.xrow = (XM || layer) ? 1 : 0; S.nN = 4;
            E.kind = pg8::EK_MIX2; E.o0 = F.dout + DO_MIX; E.i0 = F.ws + WS_YG; break;
        case OP_CONV:
            sync_after = false; if (layer == 0) convert_ffn_weights(F); else convert_expert_weights(F); break;
        case OP_WOUT:
            is_gemm = true; g = pg8::Gemm{(const bf16*)(F.dout + DO_MIX), (const bf16*)(wl + WL_OUT), D, D, D}; S.nM = (XM || layer) ? 128 : M / 256; S.xrow = (XM || layer) ? 1 : 0; S.nN = 4;
            E.kind = pg8::EK_RESID; E.o0 = F.ws + WS_H; break;
        case OP_NORM_FFN: phase_norm_rows(F, inptr(19), (bf16*)(F.dout + DO_U)); break;
        case OP_FFN_UP:
            is_gemm = true; g = pg8::Gemm{(const bf16*)(F.dout + DO_U), (const bf16*)(F.ws + WS_WFF), D, D, D}; S.nM = XM ? 128 : M / 256; S.xrow = XM; S.nN = 22;
            E.kind = pg8::EK_SWIGLU; E.o0 = F.ws + WS_HMID; E.ldo = DFF; break;
        case OP_FFN_DOWN:
            is_gemm = true; g = pg8::Gemm{(const bf16*)(F.ws + WS_HMID), (const bf16*)(F.ws + WS_WFF) + (size_t)2 * DFF * D, DFF, DFF, DFF}; S.nM = XM ? 128 : M / 256; S.xrow = XM; S.nN = 4;
            E.kind = pg8::EK_RESID; E.o0 = F.ws + WS_H; break;
        case OP_NEXT:
            convert_layer_weights(F, 1); phase_norm_rows(F, inptr(2) + D, (bf16*)(F.dout + DO_U)); break;
        case OP_ROUTE: phase_route(F, inptr(19) + D); break;
        case OP_SCATTER: phase_scatter(F, inptr(19) + D); break;
        default: {
            const int rk = rh;
            const int* tile_e = (const int*)(F.ws + WS_SMALL + SM_TILE_E) + rk * 256; const int* ntl = (const int*)(F.ws + WS_SMALL + SM_NT);
            LAS int* te = (LAS int*)(F.lds + TAB_OFF);
            const int nt_ = __builtin_amdgcn_readfirstlane(__hip_atomic_load(ntl + rk, __ATOMIC_RELAXED, __HIP_MEMORY_SCOPE_AGENT));
            for (int i = F.tid; i < 256; i += NTHREADS) te[i] = __hip_atomic_load(tile_e + i, __ATOMIC_RELAXED, __HIP_MEMORY_SCOPE_AGENT);
            const bf16* GU = (const bf16*)(F.ws + WS_WEXP); const bf16* DT = (const bf16*)(F.ws + WS_WEXP + (size_t)8 * 7168 * 1024);
            is_gemm = true; S.nM = nt_; S.grouped = 1;
            fp8 = true;
            if (op == OP_MOE_UP) { g = pg8::Gemm{(const bf16*)(F.ws + WS_XB + (size_t)rk * MOE_ROWS * D), GU, D, D, D}; S.nN = 28; S.tpe = 28; S.boff = 0;
                if (rk == 1) { const int nt0 = __builtin_amdgcn_readfirstlane(__hip_atomic_load(ntl + 0, __ATOMIC_RELAXED, __HIP_MEMORY_SCOPE_AGENT)); const int l3 = nt0 * 4 - 2 * F.G; S.late = (l3 > 0 && l3 < F.G / 2) ? l3 : 0; }
                E.kind = pg8::EK_SWIGLU; E.o0 = F.ws + WS_HQ + (size_t)rk * MOE_ROWS * DEXP; E.ldo = DEXP; E.osc = HQ_SCALE; E.isc = 1.f / (XB_SCALE * WU_SCALE); }
            else { g = pg8::Gemm{(const bf16*)(F.ws + WS_HQ + (size_t)rk * MOE_ROWS * DEXP), DT, DEXP, DEXP, DEXP}; S.nN = 4; S.tpe = 4; S.boff = 0;
                if (rk == 0) sync_after = false;
                E.kind = pg8::EK_MOEDOWN; E.o0 = F.ws + WS_H; E.o1 = F.dout; E.i0 = (const int*)(F.ws + WS_SMALL + SM_SLOT_TOK) + rk * MOE_ROWS; E.i1 = (const float*)(F.ws + WS_SMALL + SM_SLOT_W) + rk * MOE_ROWS; E.fin = (rk == 1) ? 1 : 0;
                E.osc = 1.f / (HQ_SCALE * WD_SCALE); }
            break; }
        }
        __syncthreads();
        if (is_gemm) { S.nwg = S.nM * S.nN;
            if (fp8) pg8::gemm_phase<pg8::Epi, pg8::Order, true, true>(ring, g, S, E, F.tid); else pg8::gemm_phase<pg8::Epi, pg8::Order, true, false>(ring, g, S, E, F.tid); }
        if (sync_after && st + 1 < args.ph_hi) xcd_barrier(bar);
    }
#if SKMODE == 2
    xcd_barrier(bar);
    { const unsigned e = xb_ld(ctl + sk::CW_ERR), n = xb_ld(ctl + sk::CW_ERR + 64);
      if (blockIdx.x == 0 && (e > SK_ERR_MAX || n != 1034240u)) args.out[threadIdx.x] = __builtin_nanf(""); }
#endif
}

extern "C" void kernel_launch(void* const* d_in, const int* in_sizes, int n_in, void* d_out, int out_size, void* d_ws, size_t ws_size, hipStream_t stream) {
    static int grid = 0;
    if (grid == 0) {
        if (n_in != 28 || ws_size < WS_END || out_size != BATCH * SEQ * D) { fprintf(stderr, "kernel_launch: unexpected shapes (n_in %d, ws %zu, out %d)\n", n_in, ws_size, out_size); grid = -1; return; }
        int dev = 0, cus = 0, per_cu = 0;
        if (hipGetDevice(&dev) != hipSuccess || hipDeviceGetAttribute(&cus, hipDeviceAttributeMultiprocessorCount, dev) != hipSuccess) { grid = -1; return; }
        if (hipFuncSetAttribute((const void*)fwd_kernel, hipFuncAttributeMaxDynamicSharedMemorySize, LDS_BYTES) != hipSuccess) { fprintf(stderr, "kernel_launch: hipFuncSetAttribute failed\n"); grid = -1; return; }
        if (hipOccupancyMaxActiveBlocksPerMultiprocessor(&per_cu, (const void*)fwd_kernel, NTHREADS, LDS_BYTES) != hipSuccess || per_cu < 1) { fprintf(stderr, "kernel_launch: occupancy query says %d\n", per_cu); }
        (void)hipGetLastError();
        grid = cus;
    }
    if (grid < 0) return;
    if (hipMemsetAsync((char*)d_ws + WS_CTL, 0, CTL_BYTES, stream) != hipSuccess) return;
    Args a{};
    for (int i = 0; i < 28; ++i) a.in[i] = (const float*)d_in[i];
    a.out = (float*)d_out; a.ws = (unsigned char*)d_ws; a.ph_lo = 0; a.ph_hi = NSTEP;
    hipLaunchKernelGGL(fwd_kernel, dim3(grid), dim3(NTHREADS), LDS_BYTES, stream, a);
}
```

```cpp
#include <hip/hip_runtime.h>
#include <cstdio>
#include <cstdint>

#define GAS __attribute__((address_space(1)))
#define LAS __attribute__((address_space(3)))
typedef unsigned short bf16;
typedef short bf16x8 __attribute__((ext_vector_type(8)));
typedef float f32x4 __attribute__((ext_vector_type(4)));
typedef float f32x2 __attribute__((ext_vector_type(2)));
typedef unsigned u32x4 __attribute__((ext_vector_type(4)));
typedef unsigned u32x2 __attribute__((ext_vector_type(2)));
typedef GAS unsigned gu32;

constexpr int BATCH = 4, SEQ = 8192, NMETA = 16, LTOK = SEQ + NMETA, PADL = 112, LP = LTOK + PADL, M = BATCH * LP, D = 1024;
constexpr int NWAVES = 8, NTHREADS = 512;
constexpr int YW = 4096, NGATE = 3072, IN_COLS = 7088;
constexpr int C_DQ = 0, C_DKV = 256, C_KR = 384, C_GGD = 416, C_GQ = 512, C_GK = 768, C_GV = 1024, C_GR = 1536, C_HQ = 2048, C_HF = 2560, C_HI = 3072, C_HG = 3584, C_END = 4096;
constexpr int C_O = 0, SRC_END = 4016;
constexpr int QKW = 768, VW = 512;
constexpr float EPS = 1e-6f;
constexpr float QSCALE = 0.10206207261596577f * 1.4426950408889634f;
constexpr int DFF = 2816, DEXP = 3584, NEXP = 8;
constexpr float XB_SCALE = 8.f, WU_SCALE = 64.f, HQ_SCALE = 4.f, WD_SCALE = 128.f;
constexpr int MOE_TILES = 137, MOE_ROWS = MOE_TILES * 256;

constexpr size_t MiB = 1u << 20;
constexpr size_t WS_CTL = 0, CTL_BYTES = 1 * MiB;
constexpr size_t WS_ROPE = 1 * MiB;
constexpr size_t WS_SMALL = 3 * MiB;
constexpr size_t WS_H = 8 * MiB;
constexpr size_t WS_O = 74 * MiB;
constexpr size_t WS_WL = 138 * MiB;
constexpr size_t WS_YM = 160 * MiB;
constexpr size_t WS_YG = 420 * MiB;
constexpr size_t WS_V = 518 * MiB;
constexpr size_t WS_END = 562 * MiB;
constexpr size_t WS_WFF = WS_YG;
constexpr size_t WS_HMID = WS_YM;
constexpr size_t WS_WEXP = WS_YM;
constexpr size_t WS_HQ = WS_YM + 84 * MiB;
constexpr size_t WS_XB = 484 * MiB;
constexpr size_t WL_IN = 0, WL_UQKV = 14 * MiB, WL_OM = WL_UQKV + 1835008, WL_OG = WL_OM + 1048576, WL_OH = WL_OG + 1048576, WL_OUT = WL_OH + 1048576;
static_assert(WL_OUT + 2097152 <= 22 * MiB, "WL");
constexpr size_t DO_U = 0;
constexpr size_t DO_Q = 0, DO_K = 49 * MiB;
constexpr size_t DO_MIX = 49 * MiB;
constexpr size_t DO_XB1 = 0;
constexpr size_t SM_ASG_E = 0, SM_ASG_I = 262144, SM_ASG_W = 524288;
constexpr size_t SM_SLOT_TOK = 786432, SM_SLOT_W = SM_SLOT_TOK + 2 * MOE_ROWS * 4;
constexpr size_t SM_TILE_E = SM_SLOT_W + 2 * MOE_ROWS * 4;
constexpr size_t SM_NT = SM_TILE_E + 2048;
static_assert(SM_NT + 64 <= 5 * MiB, "small");
constexpr int CW_BAR = 4096, CW_CNT = 8192, CW_ATTQ = 16384, CW_LINC = 20480;

constexpr int RING_BYTES = 131072, LDSCTL_OFF = RING_BYTES, MISC_OFF = LDSCTL_OFF + 320, TAB_OFF = MISC_OFF + 128, LDS_BYTES = 147456;

__device__ __forceinline__ unsigned pk2(float lo, float hi) { unsigned r; asm("v_cvt_pk_bf16_f32 %0, %1, %2" : "=v"(r) : "v"(lo), "v"(hi)); return r; }
__device__ __forceinline__ unsigned f2bf(float f) { return pk2(f, f) & 0xffffu; }
__device__ __forceinline__ float bf2f(unsigned short b) { return __builtin_bit_cast(float, (unsigned)b << 16); }
__device__ __forceinline__ float bflo(unsigned w) { return __builtin_bit_cast(float, w << 16); }
__device__ __forceinline__ float bfhi(unsigned w) { return __builtin_bit_cast(float, w & 0xffff0000u); }
template <int CTRL> __device__ __forceinline__ float dppf(float v) { return __builtin_bit_cast(float, __builtin_amdgcn_update_dpp(0, __builtin_bit_cast(int, v), CTRL, 0xF, 0xF, true)); }
__device__ __forceinline__ float sum8(float v) { v += dppf<0xB1>(v); v += dppf<0x4E>(v); v += dppf<0x141>(v); return v; }
__device__ __forceinline__ float sum16(float v) { v = sum8(v); v += dppf<0x140>(v); return v; }
__device__ __forceinline__ float wave_sum(int, float v) {
    v = sum16(v);
    { float a = v, b = v; asm volatile("s_nop 1\n\tv_permlane16_swap_b32 %0, %1\n\ts_nop 1" : "+v"(a), "+v"(b)); v = a + b; }
    { float a = v, b = v; asm volatile("s_nop 1\n\tv_permlane32_swap_b32 %0, %1\n\ts_nop 1" : "+v"(a), "+v"(b)); v = a + b; }
    return v;
}
__device__ __forceinline__ float frcp(float x) { return __builtin_amdgcn_rcpf(x); }
__device__ __forceinline__ float frsq(float x) { return __builtin_amdgcn_rsqf(x); }
__device__ __forceinline__ float flog(float x) { return __builtin_amdgcn_logf(x) * 0.6931471805599453f; }
__device__ __forceinline__ float sigmoidf_(float x) { return frcp(1.f + __expf(-x)); }
__device__ __forceinline__ float siluf_(float x) { return x * frcp(1.f + __expf(-x)); }
#define WAVE_SYNC() do { asm volatile("s_waitcnt lgkmcnt(0)" ::: "memory"); __builtin_amdgcn_wave_barrier(); } while (0)
template <class T> __device__ __forceinline__ const GAS T* gp(const T* p) { return (const GAS T*)p; }
template <class T> __device__ __forceinline__ GAS T* gpw(T* p) { return (GAS T*)p; }
template <class T> __device__ __forceinline__ T gld(const void* p) { return *(const GAS T*)p; }
template <class T> __device__ __forceinline__ void gst(void* p, const T v) { *(GAS T*)p = v; }
__device__ __forceinline__ u32x4 zero4() { unsigned z = 0u; asm volatile("" : "+v"(z)); return (u32x4){z, z, z, z}; }
__device__ __forceinline__ const float* inptr(int k) {
    const __attribute__((address_space(4))) unsigned long long* ka = (const __attribute__((address_space(4))) unsigned long long*)__builtin_amdgcn_kernarg_segment_ptr();
    asm volatile("" : "+s"(ka));
    return (const float*)ka[k];
}

namespace pg8 {
#define PG8_LAS __attribute__((address_space(3)))
typedef unsigned short bf16_t;
constexpr int BM = 256, BK = 64, HALF = 128, HTB = HALF * BK * 2, NXCD = 8, WGM = 8;
__host__ __device__ __forceinline__ int lds_byte(int r, int c) { const int st = (r >> 4) * 2 + (c >> 5), rr = r & 15, cc = c & 31, ob = rr * 64 + cc * 2; return st * 1024 + (ob ^ (((ob >> 9) & 1) << 5)); }
__host__ __device__ __forceinline__ void stage_rc(int b, int& R, int& C) { const int st = b / 1024, sb = b % 1024, swz = sb ^ (((sb >> 9) & 1) << 5); R = (st >> 1) * 16 + swz / 64; C = (st & 1) * 32 + (swz % 64) / 2; }
__host__ __device__ __forceinline__ int perm32(int rho) { const int n = rho >> 4, i = rho & 15; return 8 * (i >> 2) + 4 * n + (i & 3); }

struct Unit { int pm, pn, pb, ao, sub; };
struct Gemm { const bf16_t* A; const bf16_t* Bt; int K, lda, ldb; };

__device__ __forceinline__ void tile_order(long L, int nM, int nN, int& pm, int& pn) {
    const int nwg = nM * nN; int wgid = (int)L;
    { const int q = nwg / NXCD, r = nwg % NXCD, xcd = wgid % NXCD, off = wgid / NXCD; wgid = (xcd < r ? xcd * (q + 1) : r * (q + 1) + (xcd - r) * q) + off; }
    const int nig = WGM * nN, gid = wgid / nig, fm = gid * WGM, gsz = (nM - fm) < WGM ? (nM - fm) : WGM;
    pm = fm + ((wgid % nig) % gsz); pn = (wgid % nig) / gsz;
}
struct Order {
    int nM, nN, nwg, G, c, tpe, boff, grouped; const PG8_LAS int* te; int xrow; int late; int msub, ao1, ao2;
    __device__ __forceinline__ bool next(int i, Unit& u) const {
        long L = (long)i * G + c; int sub = 0;
        if (msub) { const int i3 = i / 3; sub = i - 3 * i3; L = (long)i3 * G + c; }
        if (late > 0) {
            const int nf = G - late, R = nwg / nf;
            if (c >= late) { if (i >= R) return false; L = (long)i * nf + (c - late); } else L = (long)nf * R + (long)i * late + c; }
        if (L >= nwg) return false;
        tile_order(L, nM, nN, u.pm, u.pn);
        u.pb = grouped ? __builtin_amdgcn_readfirstlane(te[u.pm]) * tpe + boff + u.pn : u.pn + 4 * sub;
        u.sub = sub; u.ao = sub == 0 ? 0 : (sub == 1 ? ao1 : ao2);
        u.pm = 2 * u.pm + xrow * ((u.pm >> 5) + 1);
        return true;
    }
    __device__ __forceinline__ void a_ready(const Unit&) const {}
    __device__ __forceinline__ void done(const Unit&) const {}
};

typedef int v8i_t __attribute__((ext_vector_type(8)));
template <class Epi, class Sched, bool ALIGN_EPI = false, bool FP8 = false>
__device__ __forceinline__ void gemm_phase(PG8_LAS unsigned char* lds, const Gemm g, const Sched& S, const Epi& E, const int tid) {
    const int wid = __builtin_amdgcn_readfirstlane(tid >> 6), lane = tid & 63, wr = wid >> 2, wc = wid & 3, fr = lane & 15, fq = lane >> 4;
    constexpr int ESZ = FP8 ? 1 : 2;
    const int K = g.K, nt = K * ESZ / (BK * 2);
    unsigned voffA[2], voffB[2];
#pragma unroll
    for (int i = 0; i < 2; ++i) { int R, C; stage_rc(tid * 16 + i * 8192, R, C); const int Rb = Epi::PERM ? ((R & ~31) + perm32(R & 31)) : R;
        voffA[i] = (unsigned)(R * g.lda * ESZ + C * 2); voffB[i] = (unsigned)(Rb * g.ldb * ESZ + C * 2); }
    const size_t kstep = (size_t)(BK * 2);
    const size_t hstepA = (size_t)HALF * g.lda * ESZ, hstepB = (size_t)HALF * g.ldb * ESZ;
    const size_t tstepB = 2 * hstepB;
    const unsigned ldsw = (unsigned)wid * 1024u;
    const int aoff = lds_byte(wr * 64 + fr, FP8 ? fq * 16 : fq * 8), boff = lds_byte(wc * 32 + fr, FP8 ? fq * 16 : fq * 8);
    const int aoff1 = FP8 ? lds_byte(wr * 64 + fr, fq * 16 + 8) - aoff : 1024, boff1 = FP8 ? lds_byte(wc * 32 + fr, fq * 16 + 8) - boff : 1024;
#define PG8_SA(b, h) (((b) * 2 + (h)) * HTB)
#define PG8_SB(b, h) ((4 + (b) * 2 + (h)) * HTB)
#define PG8_STAGE(bufoff, gbase, voff) do { _Pragma("unroll") for (int _i = 0; _i < 2; ++_i) \
        __builtin_amdgcn_global_load_lds((const unsigned*)((const char*)(gbase) + (voff)[_i]), (PG8_LAS unsigned*)(lds + (bufoff) + ldsw + _i * 8192), 16, 0, 0); } while (0)
#define PG8_LDA(dst, b, h) do { _Pragma("unroll") for (int m = 0; m < 4; ++m) { \
        if constexpr (FP8) { const u32x4 lo_ = *(const PG8_LAS u32x4*)(lds + PG8_SA(b, h) + aoff + m * 2048), hi_ = *(const PG8_LAS u32x4*)(lds + PG8_SA(b, h) + aoff + m * 2048 + aoff1); \
            dst##8[m] = __builtin_bit_cast(v8i_t, __builtin_shufflevector(lo_, hi_, 0, 1, 2, 3, 4, 5, 6, 7)); } \
        else { _Pragma("unroll") for (int k = 0; k < 2; ++k) dst[m][k] = *(const PG8_LAS bf16x8*)(lds + PG8_SA(b, h) + aoff + m * 2048 + k * 1024); } } } while (0)
#define PG8_LDB(dst, b, h) do { _Pragma("unroll") for (int n = 0; n < 2; ++n) { \
        if constexpr (FP8) { const u32x4 lo_ = *(const PG8_LAS u32x4*)(lds + PG8_SB(b, h) + boff + n * 2048), hi_ = *(const PG8_LAS u32x4*)(lds + PG8_SB(b, h) + boff + n * 2048 + boff1); \
            dst##8[n] = __builtin_bit_cast(v8i_t, __builtin_shufflevector(lo_, hi_, 0, 1, 2, 3, 4, 5, 6, 7)); } \
        else { _Pragma("unroll") for (int k = 0; k < 2; ++k) dst[n][k] = *(const PG8_LAS bf16x8*)(lds + PG8_SB(b, h) + boff + n * 2048 + k * 1024); } } } while (0)
#define PG8_MMA(ai, bj, At, Bt) do { __builtin_amdgcn_s_setprio(1); \
        if constexpr (FP8) { _Pragma("unroll") for (int m = 0; m < 4; ++m) _Pragma("unroll") for (int n = 0; n < 2; ++n) \
            asm volatile("v_mfma_scale_f32_16x16x128_f8f6f4 %0, %1, %2, %0, %3, %3 op_sel_hi:[0,0,0]" : "+v"(acc[ai][bj][m][n]) : "v"(Bt##8[n]), "v"(At##8[m]), "v"(one8)); } \
        else { _Pragma("unroll") for (int m = 0; m < 4; ++m) _Pragma("unroll") for (int n = 0; n < 2; ++n) _Pragma("unroll") for (int k = 0; k < 2; ++k) \
            acc[ai][bj][m][n] = __builtin_amdgcn_mfma_f32_16x16x32_bf16(Bt[n][k], At[m][k], acc[ai][bj][m][n], 0, 0, 0); } \
        __builtin_amdgcn_s_setprio(0); } while (0)
#define PG8_WAIT_V(n) asm volatile("s_waitcnt vmcnt(" #n ")" ::: "memory")
#define PG8_WAIT_L(n) asm volatile("s_waitcnt lgkmcnt(" #n ")" ::: "memory")
#define PG8_BAR __builtin_amdgcn_s_barrier()
#define PG8_SCHED __builtin_amdgcn_sched_barrier(0)
    Unit cur, nxt; int ui = 0;
    if (!S.next(0, cur)) return;
    f32x4 acc[2][2][4][2];
#pragma unroll
    for (int a = 0; a < 2; ++a)
#pragma unroll
        for (int b = 0; b < 2; ++b)
#pragma unroll
            for (int m = 0; m < 4; ++m)
#pragma unroll
                for (int n = 0; n < 2; ++n) acc[a][b][m][n] = (f32x4){0.f, 0.f, 0.f, 0.f};
    bf16x8 At[4][2], B0[2][2], B1[2][2]; v8i_t At8[4], B08[2], B18[2];
    int one8 = 0x7F7F7F7F; asm volatile("" : "+v"(one8));
    const char* cA = (const char*)g.A + (size_t)cur.pm * hstepA + cur.ao; const char* cB = (const char*)g.Bt + (size_t)cur.pb * tstepB;
    S.a_ready(cur);
    PG8_STAGE(PG8_SB(0, 0), cB, voffB); PG8_STAGE(PG8_SB(0, 1), cB + hstepB, voffB); PG8_STAGE(PG8_SA(0, 0), cA, voffA); PG8_STAGE(PG8_SA(0, 1), cA + hstepA, voffA);
    if (wr == 1) PG8_BAR;
    PG8_WAIT_V(2); PG8_BAR;
    PG8_STAGE(PG8_SB(1, 0), cB + kstep, voffB); PG8_STAGE(PG8_SA(1, 0), cA + kstep, voffA); PG8_STAGE(PG8_SB(1, 1), cB + hstepB + kstep, voffB);
    PG8_WAIT_V(6); PG8_BAR;
    for (;;) {
        const bool has_next = S.next(ui + 1, nxt);
        const char* nA = has_next ? (const char*)g.A + (size_t)nxt.pm * hstepA + nxt.ao : cA; const char* nB = has_next ? (const char*)g.Bt + (size_t)nxt.pb * tstepB : cB;
        for (int t = 0; t < nt; t += 2) {
            const bool last = (t == nt - 2);
            const char* a1 = cA + (size_t)(t + 1) * kstep;
            const char* a2 = last ? nA : cA + (size_t)(t + 2) * kstep; const char* b2 = last ? nB : cB + (size_t)(t + 2) * kstep;
            const char* a3 = a2 + kstep; const char* b3 = b2 + kstep;
            if (last && has_next) S.a_ready(nxt);
            PG8_LDB(B0, 0, 0); PG8_LDB(B1, 0, 1); PG8_SCHED; PG8_LDA(At, 0, 0); PG8_STAGE(PG8_SA(1, 1), a1 + hstepA, voffA);
            PG8_WAIT_V(8); PG8_WAIT_L(0); PG8_BAR; PG8_MMA(0, 0, At, B0); PG8_MMA(0, 1, At, B1); PG8_BAR; PG8_SCHED;
            PG8_LDA(At, 0, 1); PG8_STAGE(PG8_SB(0, 0), b2, voffB); PG8_STAGE(PG8_SB(0, 1), b2 + hstepB, voffB); PG8_STAGE(PG8_SA(0, 0), a2, voffA);
            PG8_WAIT_V(8); PG8_WAIT_L(0); PG8_BAR; PG8_MMA(1, 0, At, B0); PG8_MMA(1, 1, At, B1); PG8_BAR; PG8_SCHED;
            PG8_LDB(B0, 1, 0); PG8_LDB(B1, 1, 1); PG8_SCHED; PG8_LDA(At, 1, 0); PG8_STAGE(PG8_SA(0, 1), a2 + hstepA, voffA);
            PG8_WAIT_V(8); PG8_WAIT_L(0); PG8_BAR; PG8_MMA(0, 0, At, B0); PG8_MMA(0, 1, At, B1); PG8_BAR; PG8_SCHED;
            PG8_LDA(At, 1, 1); PG8_STAGE(PG8_SB(1, 0), b3, voffB); PG8_STAGE(PG8_SB(1, 1), b3 + hstepB, voffB); PG8_STAGE(PG8_SA(1, 0), a3, voffA);
            PG8_WAIT_V(8); PG8_WAIT_L(0); PG8_BAR; PG8_MMA(1, 0, At, B0); PG8_MMA(1, 1, At, B1); PG8_BAR; PG8_SCHED;
        }
        if constexpr (ALIGN_EPI) { if (wr == 0) PG8_BAR; }
        if constexpr (FP8) asm volatile("s_nop 15\n\ts_nop 15" ::: "memory");
        E(acc, cur, wr, wc, fr, fq); S.done(cur);
        if (!has_next) break;
#pragma unroll
        for (int a = 0; a < 2; ++a)
#pragma unroll
            for (int b = 0; b < 2; ++b)
#pragma unroll
                for (int m = 0; m < 4; ++m)
#pragma unroll
                    for (int n = 0; n < 2; ++n) acc[a][b][m][n] = (f32x4){0.f, 0.f, 0.f, 0.f};
        cur = nxt; cA = nA; cB = nB; ++ui;
        if constexpr (ALIGN_EPI) { if (wr == 1) PG8_BAR; }
    }
    PG8_WAIT_V(0);
    if constexpr (!ALIGN_EPI) { if (wr == 0) PG8_BAR; }
    PG8_BAR;
#undef PG8_SA
#undef PG8_SB
#undef PG8_STAGE
#undef PG8_LDA
#undef PG8_LDB
#undef PG8_MMA
#undef PG8_WAIT_V
#undef PG8_WAIT_L
#undef PG8_BAR
#undef PG8_SCHED
}

__device__ __forceinline__ unsigned cvt_pk_bf16(float lo, float hi) { unsigned r; asm volatile("v_cvt_pk_bf16_f32 %0, %1, %2" : "=v"(r) : "v"(lo), "v"(hi)); return r; }
__device__ __forceinline__ u32x4 pack8(const f32x4 v0, const f32x4 v1) { u32x4 w; w.x = cvt_pk_bf16(v0[0], v0[1]); w.y = cvt_pk_bf16(v0[2], v0[3]); w.z = cvt_pk_bf16(v1[0], v1[1]); w.w = cvt_pk_bf16(v1[2], v1[3]); return w; }
__device__ __forceinline__ float clamp448(float x) { return __builtin_amdgcn_fmed3f(x, -448.f, 448.f); }
__device__ __forceinline__ unsigned fp8x4(const f32x4 v) { int w = 0; w = __builtin_amdgcn_cvt_pk_fp8_f32(clamp448(v[0]), clamp448(v[1]), w, false);
    w = __builtin_amdgcn_cvt_pk_fp8_f32(clamp448(v[2]), clamp448(v[3]), w, true); return (unsigned)w; }
__device__ __forceinline__ unsigned q8(float x) { const float s = frcp(1.f + __expf(-x)); return (unsigned)(s * 255.f + 0.5f); }

#define EPI_FENCE() asm volatile("" ::: "memory")
enum { EK_INPROJ = 0, EK_MIX0, EK_MIX1, EK_MIX2, EK_RESID, EK_SWIGLU, EK_MOEDOWN, EK_MLA };
struct Epi {
    static constexpr bool PERM = true;
    int kind;
    void* o0;
    void* o1;
    const void* i0;
    const void* i1;
    int ldo, fin, dry;
    float isc;
    float osc;
    __device__ __forceinline__ void operator()(const f32x4 (&acc)[2][2][4][2], const Unit& u, int wr, int wc, int fr, int fq) const {
        const int row0 = u.pm * HALF + wr * 64 + fr;
        if (dry) { float sink = 0.f;
#pragma unroll
            for (int ai = 0; ai < 2; ++ai)
#pragma unroll
                for (int bj = 0; bj < 2; ++bj)
#pragma unroll
                    for (int m = 0; m < 4; ++m) sink += acc[ai][bj][m][0][0] + acc[ai][bj][m][1][3];
            asm volatile("" :: "v"(sink)); return; }
        if (kind == EK_INPROJ) {
            if (u.pn < 16) { bf16_t* Ym = (bf16_t*)o0; const int col0 = u.pn * BM + wc * 32 + 8 * fq;
#pragma unroll
                for (int ai = 0; ai < 2; ++ai)
#pragma unroll
                    for (int m = 0; m < 4; ++m) { bf16_t* rowp = Ym + (size_t)(row0 + ai * HALF + m * 16) * YW + col0;
#pragma unroll
                        for (int bj = 0; bj < 2; ++bj) gst<u32x4>(rowp + bj * HALF, pack8(acc[ai][bj][m][0], acc[ai][bj][m][1])); }
            } else { unsigned char* Yg = (unsigned char*)o1; const int col0 = (u.pn - 16) * BM + wc * 32 + 8 * fq;
#pragma unroll
                for (int ai = 0; ai < 2; ++ai)
#pragma unroll
                    for (int m = 0; m < 4; ++m) { unsigned char* rowp = Yg + (size_t)(row0 + ai * HALF + m * 16) * NGATE + col0;
#pragma unroll
                        for (int bj = 0; bj < 2; ++bj) { const f32x4 a = acc[ai][bj][m][0], b = acc[ai][bj][m][1]; u32x2 w;
                            w.x = q8(a[0]) | (q8(a[1]) << 8) | (q8(a[2]) << 16) | (q8(a[3]) << 24); w.y = q8(b[0]) | (q8(b[1]) << 8) | (q8(b[2]) << 16) | (q8(b[3]) << 24);
                            gst<u32x2>(rowp + bj * HALF, w); } }
            }
        } else if (kind <= EK_MIX2) {
            const int kind_ = EK_MIX0 + u.sub;
            bf16_t* Mx = (bf16_t*)o0; const unsigned char* Yg = (const unsigned char*)i0 + (kind_ - EK_MIX0) * 1024; const bool addp = kind_ != EK_MIX0;
            const int col0 = u.pn * BM + wc * 32 + 8 * fq; const float s = 1.f / 255.f;
#pragma unroll
            for (int ai = 0; ai < 2; ++ai)
#pragma unroll
                for (int bj = 0; bj < 2; ++bj) { const int col = col0 + bj * HALF; u32x2 gw[4]; u32x4 pv[4];
#pragma unroll
                    for (int m = 0; m < 4; ++m) { const int row = row0 + ai * HALF + m * 16; gw[m] = gld<u32x2>(Yg + (size_t)row * NGATE + col);
                        pv[m] = (u32x4){0u, 0u, 0u, 0u}; if (addp) pv[m] = gld<u32x4>(Mx + (size_t)row * D + col); }
#pragma unroll
                    for (int m = 0; m < 4; ++m) { const int row = row0 + ai * HALF + m * 16; f32x4 a = acc[ai][bj][m][0], b = acc[ai][bj][m][1]; const u32x2 g = gw[m]; const u32x4 p = pv[m];
                        a[0] = a[0] * ((float)(g.x & 255u) * s) + bflo(p.x); a[1] = a[1] * ((float)((g.x >> 8) & 255u) * s) + bfhi(p.x); a[2] = a[2] * ((float)((g.x >> 16) & 255u) * s) + bflo(p.y); a[3] = a[3] * ((float)(g.x >> 24) * s) + bfhi(p.y);
                        b[0] = b[0] * ((float)(g.y & 255u) * s) + bflo(p.z); b[1] = b[1] * ((float)((g.y >> 8) & 255u) * s) + bfhi(p.z); b[2] = b[2] * ((float)((g.y >> 16) & 255u) * s) + bflo(p.w); b[3] = b[3] * ((float)(g.y >> 24) * s) + bfhi(p.w);
                        gst<u32x4>(Mx + (size_t)row * D + col, pack8(a, b)); }
                    EPI_FENCE(); }
        } else if (kind == EK_RESID) {
            bf16_t* H = (bf16_t*)o0; const int col0 = u.pn * BM + wc * 32 + 8 * fq;
#pragma unroll
            for (int ai = 0; ai < 2; ++ai)
#pragma unroll
                for (int bj = 0; bj < 2; ++bj) { u32x4 x[4];
#pragma unroll
                    for (int m = 0; m < 4; ++m) x[m] = gld<u32x4>(H + (size_t)(row0 + ai * HALF + m * 16) * D + col0 + bj * HALF);
#pragma unroll
                    for (int m = 0; m < 4; ++m) { const f32x4 a = acc[ai][bj][m][0] * isc + (f32x4){bflo(x[m].x), bfhi(x[m].x), bflo(x[m].y), bfhi(x[m].y)}, b = acc[ai][bj][m][1] * isc + (f32x4){bflo(x[m].z), bfhi(x[m].z), bflo(x[m].w), bfhi(x[m].w)};
                        gst<u32x4>(H + (size_t)(row0 + ai * HALF + m * 16) * D + col0 + bj * HALF, pack8(a, b)); }
                    EPI_FENCE(); }
        } else if (kind == EK_SWIGLU) {
            bf16_t* O = (bf16_t*)o0; const int col0 = u.pn * HALF + wc * 32 + 8 * fq; const float c1 = -1.4426950408889634f * isc, c2 = isc * isc * (osc > 0.f ? osc : 1.f);
#pragma unroll
            for (int ai = 0; ai < 2; ++ai)
#pragma unroll
                for (int m = 0; m < 4; ++m) { f32x4 h[2];
#pragma unroll
                    for (int n = 0; n < 2; ++n)
#pragma unroll
                        for (int e = 0; e < 4; ++e) { const float ga = acc[ai][0][m][n][e], ua = acc[ai][1][m][n][e];
                            h[n][e] = ga * ua * c2 * frcp(1.f + __builtin_amdgcn_exp2f(ga * c1)); }
                    if (osc > 0.f) { u32x2 w8; w8.x = fp8x4(h[0]); w8.y = fp8x4(h[1]); gst<u32x2>((unsigned char*)o0 + (size_t)(row0 + ai * HALF + m * 16) * ldo + col0, w8); }
                    else gst<u32x4>(O + (size_t)(row0 + ai * HALF + m * 16) * ldo + col0, pack8(h[0], h[1])); }
        } else if (kind == EK_MLA) {
            bf16_t* Qb = (bf16_t*)o0; bf16_t* Kb = (bf16_t*)o1; bf16_t* Vb = (bf16_t*)i0;
#pragma unroll
            for (int ai = 0; ai < 2; ++ai)
#pragma unroll
                for (int m = 0; m < 4; ++m) { const size_t row = (size_t)(row0 + ai * HALF + m * 16);
#pragma unroll
                    for (int bj = 0; bj < 2; ++bj) { const u32x4 w = pack8(acc[ai][bj][m][0], acc[ai][bj][m][1]);
                        const int pn_ = u.pn + fin;
                        if (pn_ < 3) gst<u32x4>(Qb + row * QKW + pn_ * BM + bj * HALF + wc * 32 + 8 * fq, w);
                        else { const int c = (pn_ - 3) * BM + bj * HALF + wc * 32 + 8 * fq, hh = c >> 7, d = c & 127;
                            if (d < 64) gst<u32x4>(Kb + row * QKW + hh * 96 + d, w); else gst<u32x4>(Vb + row * VW + hh * 64 + d - 64, w); } } }
        } else {
            bf16_t* H = (bf16_t*)o0; float* out = (float*)o1; const int* slot_tok = (const int*)i0; const float* slot_w = (const float*)i1;
            const int col0 = u.pn * BM + wc * 32 + 8 * fq;
#pragma unroll
            for (int ai = 0; ai < 2; ++ai) { int tk[4]; float wv[4];
#pragma unroll
                for (int m = 0; m < 4; ++m) { const int slot = row0 + ai * HALF + m * 16; tk[m] = gld<int>(slot_tok + slot); wv[m] = gld<float>(slot_w + slot) * osc; }
#pragma unroll
                for (int bj = 0; bj < 2; ++bj) { u32x4 x[4];
#pragma unroll
                    for (int m = 0; m < 4; ++m) { const int t_ = tk[m] < 0 ? 0 : tk[m]; x[m] = gld<u32x4>(H + (size_t)t_ * D + col0 + bj * HALF); }
#pragma unroll
                    for (int m = 0; m < 4; ++m) if (tk[m] >= 0) {
                        const f32x4 a = acc[ai][bj][m][0] * wv[m] + (f32x4){bflo(x[m].x), bfhi(x[m].x), bflo(x[m].y), bfhi(x[m].y)}, b = acc[ai][bj][m][1] * wv[m] + (f32x4){bflo(x[m].z), bfhi(x[m].z), bflo(x[m].w), bfhi(x[m].w)};
                        if (fin) { const int bb = tk[m] / LP, p = tk[m] - bb * LP; f32x4* q = (f32x4*)(out + ((size_t)bb * SEQ + (p - 128)) * D + col0 + bj * HALF); gst<f32x4>(q, a); gst<f32x4>(q + 1, b); }
                        else gst<u32x4>(H + (size_t)tk[m] * D + col0 + bj * HALF, pack8(a, b)); }
                    EPI_FENCE(); } }
        }
    }
};
}

#define XB_TMO      128
#define XB_XCNT(j)  (256  + 64 * (j))
#define XB_XSUB(j)  (1280 + 64 * (j))
#define XB_XGEN(j)  (2304 + 64 * (j))
#define XB_TOP      3328
#define XB_TOPGEN   3392
#define XCD_BAR_WORDS 3456
#define XB_SPIN_CAP (1u << 25)
__device__ __forceinline__ unsigned xb_ld(unsigned* p)              { return __hip_atomic_load(p, __ATOMIC_RELAXED, __HIP_MEMORY_SCOPE_AGENT); }
__device__ __forceinline__ unsigned xb_add(unsigned* p, unsigned v) { return __hip_atomic_fetch_add(p, v, __ATOMIC_RELAXED, __HIP_MEMORY_SCOPE_AGENT); }
__device__ __forceinline__ unsigned xb_xcc_id() { return (unsigned)__builtin_amdgcn_s_getreg((3 << 11) | 20) & 0xFu; }
#define XB_SPIN(cond, bar) do { unsigned _sp = 0; while (cond) { __builtin_amdgcn_s_sleep(1); \
    if ((++_sp & 255u) == 0u) { if (xb_ld(&(bar)[XB_TMO])) break; if (_sp > XB_SPIN_CAP) { atomicAdd(&(bar)[XB_TMO], 1u); break; } } } } while (0)
struct XcdBarrier { unsigned* bar; unsigned x; volatile LAS unsigned* st; };
__device__ __forceinline__ XcdBarrier xcd_barrier_post(unsigned* bar, volatile LAS unsigned* st) {
    XcdBarrier b; b.bar = bar; b.x = xb_xcc_id(); b.st = st;
    if (threadIdx.x == 0) (void)xb_add(&bar[XB_XCNT(b.x)], 1u);
    return b;
}
__device__ __forceinline__ void xcd_barrier_complete(unsigned* bar, unsigned x, unsigned& nloc, unsigned& nx) {
    const unsigned G = gridDim.x * gridDim.y * gridDim.z;
    unsigned sum, cnt, mine, sp = 0u;
    for (;;) {
        sum = 0u; cnt = 0u; mine = 0u;
#pragma unroll
        for (unsigned j = 0; j < 16; ++j) { const unsigned c = xb_ld(&bar[XB_XCNT(j)]); sum += c; cnt += (c > 0u) ? 1u : 0u; mine = (j == x) ? c : mine; }
        if (sum == G) break;
        __builtin_amdgcn_s_sleep(1);
        if ((++sp & 255u) == 0u) { if (xb_ld(&bar[XB_TMO])) break; if (sp > XB_SPIN_CAP) { atomicAdd(&bar[XB_TMO], 1u); break; } }
    }
    nloc = mine > 0u ? mine : 1u; nx = cnt > 0u ? cnt : 1u;
}
__device__ __forceinline__ void xcd_barrier(const XcdBarrier& b) {
    asm volatile("s_waitcnt vmcnt(0)" ::: "memory");
    __syncthreads();
    if (threadIdx.x == 0) {
        unsigned* bar = b.bar;
        __builtin_amdgcn_s_waitcnt(0);
        unsigned nloc = b.st[0], nx = b.st[1];
        if (nloc == 0u) { xcd_barrier_complete(bar, b.x, nloc, nx); b.st[0] = nloc; b.st[1] = nx; }
        const unsigned old = xb_add(&bar[XB_XSUB(b.x)], 1u);
        const unsigned gen = old / nloc;
        if (old + 1u == (gen + 1u) * nloc) {
            __builtin_amdgcn_fence(__ATOMIC_RELEASE, "agent");
            asm volatile("s_waitcnt vmcnt(0)" ::: "memory");
            const unsigned og = xb_add(&bar[XB_TOP], 1u);
            const unsigned tg = og / nx;
            if (og + 1u == (tg + 1u) * nx) xb_add(&bar[XB_TOPGEN], 1u);
            else XB_SPIN(xb_ld(&bar[XB_TOPGEN]) == tg, bar);
            __builtin_amdgcn_fence(__ATOMIC_ACQUIRE, "agent");
            xb_add(&bar[XB_XGEN(b.x)], 1u);
            asm volatile("s_waitcnt vmcnt(0)" ::: "memory");
        } else {
            XB_SPIN(xb_ld(&bar[XB_XGEN(b.x)]) == gen, bar);
            __builtin_amdgcn_fence(__ATOMIC_ACQUIRE, "agent");
            asm volatile("s_waitcnt vmcnt(0)" ::: "memory");
        }
    }
    __syncthreads();
}

struct Args { const float* in[28]; float* out; unsigned char* ws; int ph_lo, ph_hi; };
struct Frame {
    LAS unsigned char* lds; unsigned char* ws; unsigned char* dout;
    int tid, lane, wave, G, bid, gw, NGW, dry;
};

template <bool F8>
__device__ __forceinline__ void transpose_tile(const float* W, size_t ldw, int k0, int ncol0, int nvalid, bf16* WT, size_t ldt, int drow0, int dk0, const float* gain, float scale, LAS float* scr, int lane) {
    const int n_ = lane & 31;
    float tv[32];
#pragma unroll
    for (int i = 0; i < 32; ++i) { const int kk = 2 * i + (lane >> 5); tv[i] = 0.f; if (n_ < nvalid) tv[i] = *(const GAS float*)gp(W + (size_t)(k0 + kk) * ldw + ncol0 + n_); }
    { const float* gsrc = gain ? gain : W;
      const bool hasg = gain != nullptr;
#pragma unroll
      for (int i = 0; i < 32; ++i) { const float gv = *(const GAS float*)gp(gsrc + k0 + 2 * i + (lane >> 5)); tv[i] *= hasg ? gv : 1.f; } }
#pragma unroll
    for (int i = 0; i < 32; ++i) scr[(2 * i + (lane >> 5)) * 33 + n_] = tv[i] * scale;
    WAVE_SYNC();
    const int c = lane & 7;
#pragma unroll
    for (int j = 0; j < 4; ++j) { const LAS float* s = scr + (8 * c) * 33 + (lane >> 3) + 8 * j;
#pragma unroll
        for (int q = 0; q < 8; ++q) tv[8 * j + q] = s[q * 33]; }
#pragma unroll
    for (int j = 0; j < 4; ++j) { const int n = (lane >> 3) + 8 * j; const float* s = tv + 8 * j;
        if (F8) { u32x2 o; o.x = pg8::fp8x4((f32x4){s[0], s[1], s[2], s[3]}); o.y = pg8::fp8x4((f32x4){s[4], s[5], s[6], s[7]});
            if (n < nvalid) *(GAS u32x2*)gpw((u32x2*)((unsigned char*)WT + (size_t)(drow0 + n) * ldt + dk0 + 8 * c)) = o; }
        else { u32x4 o; o.x = pk2(s[0], s[1]); o.y = pk2(s[2], s[3]); o.z = pk2(s[4], s[5]); o.w = pk2(s[6], s[7]);
            if (n < nvalid) *(GAS u32x4*)gpw((u32x4*)(WT + (size_t)(drow0 + n) * ldt + dk0 + 8 * c)) = o; } }
    WAVE_SYNC();
}
template <int MODE, bool F8 = false>
__device__ __forceinline__ void conv_matrix(const Frame& F, const float* W, int K, int Ncols, size_t ldw, int ncol_base, bf16* WT, size_t ldt, int drow_base, const float* gain, int dk_base = 0, float scale = 1.f) {
    LAS float* scr = (LAS float*)(F.lds + F.wave * 16384);
    const int nkb = K / 64, nnb = (Ncols + 31) / 32, ntile = nkb * nnb;
    for (int it = F.gw; it < ntile; it += F.NGW) {
        const int kb = it / nnb, nb = it % nnb, n0 = nb * 32, nvalid = (Ncols - n0) < 32 ? (Ncols - n0) : 32;
        int drow0 = drow_base + n0, dk0 = dk_base + kb * 64;
        if (MODE == 1) drow0 = 256 * (n0 / 128) + (n0 % 128) + drow_base;
        if (MODE == 2) dk0 = kb * 96;
        transpose_tile<F8>(W, ldw, kb * 64, ncol_base + n0, nvalid, WT, ldt, drow0, dk0, gain, scale, scr, F.lane);
    }
}
__device__ __forceinline__ void zero_fill16(const Frame& F, void* p, size_t bytes) {
    u32x4* q = (u32x4*)p; const size_t n = bytes / 16;
    const u32x4 z4 = zero4();
    for (size_t i = (size_t)F.bid * NTHREADS + F.tid; i < n; i += (size_t)F.G * NTHREADS) q[i] = z4;
}
__device__ __forceinline__ void convert_layer_weights(const Frame& F, int layer) {
    unsigned char* wl = F.ws + WS_WL;
    bf16* WinT = (bf16*)(wl + WL_IN); bf16* uq = (bf16*)(wl + WL_UQKV);
    const float* w_in = inptr(3) + (size_t)layer * D * IN_COLS;
    LAS float* scr = (LAS float*)(F.lds + F.wave * 16384);
    constexpr int Ta = 16 * 13, Tb = Ta + 16 * 32, Tc = Tb + 16 * 1, T0 = Tc + 16 * 80, T1 = T0 + 16 * 96, T2 = T1 + 4 * 24, T3 = T2 + 2 * 32, T4 = T3 + 8 * 32, T5 = T4 + 8 * 32, T6 = T5 + 8 * 32, T7 = T6 + 16 * 32;
    for (int it = F.gw; it < T7; it += F.NGW) {
        const float* W; const float* gain = nullptr; bf16* WT; int Ncols, ldw, ncol_base = 0, ldt, drow_base = 0, nnb, t;
        if (it < Ta)      { t = it;      W = w_in; Ncols = 416; ldw = IN_COLS; WT = WinT; ldt = D; nnb = 13; }
        else if (it < Tb) { t = it - Ta; W = w_in; Ncols = 1024; ldw = IN_COLS; ncol_base = 416; WT = WinT; ldt = D; drow_base = C_GQ; nnb = 32; }
        else if (it < Tc) { t = it - Tb; W = w_in; Ncols = 16; ldw = IN_COLS; ncol_base = 1440; WT = WinT; ldt = D; drow_base = C_GGD; nnb = 1; }
        else if (it < T0) { t = it - Tc; W = w_in; Ncols = 2560; ldw = IN_COLS; ncol_base = 1456; WT = WinT; ldt = D; drow_base = C_GR; nnb = 80; }
        else if (it < T1) { t = it - T0; W = w_in; Ncols = NGATE; ldw = IN_COLS; ncol_base = SRC_END; WT = WinT; ldt = D; drow_base = YW; nnb = 96; }
        else if (it < T2) { t = it - T1; W = inptr(5) + (size_t)layer * 256 * 768; Ncols = 768; ldw = 768; WT = uq; ldt = 256; gain = inptr(4) + layer * 256; nnb = 24; }
        else if (it < T3) { t = it - T2; W = inptr(7) + (size_t)layer * 128 * 1024; Ncols = 1024; ldw = 1024; WT = uq; ldt = 256; drow_base = 768; gain = inptr(6) + layer * 128; nnb = 32; }
        else if (it < T4) { t = it - T3; W = inptr(15) + (size_t)layer * 512 * 1024; Ncols = 1024; ldw = 1024; WT = (bf16*)(wl + WL_OM); ldt = 512; nnb = 32; }
        else if (it < T5) { t = it - T4; W = inptr(16) + (size_t)layer * 512 * 1024; Ncols = 1024; ldw = 1024; WT = (bf16*)(wl + WL_OG); ldt = 512; nnb = 32; }
        else if (it < T6) { t = it - T5; W = inptr(17) + (size_t)layer * 512 * 1024; Ncols = 1024; ldw = 1024; WT = (bf16*)(wl + WL_OH); ldt = 512; nnb = 32; }
        else              { t = it - T6; W = inptr(18) + (size_t)layer * 1024 * 1024; Ncols = 1024; ldw = 1024; WT = (bf16*)(wl + WL_OUT); ldt = 1024; nnb = 32; }
        const int kb = t / nnb, n0 = (t % nnb) * 32, nvalid = (Ncols - n0) < 32 ? (Ncols - n0) : 32;
        transpose_tile<false>(W, (size_t)ldw, kb * 64, ncol_base + n0, nvalid, WT, (size_t)ldt, drow_base + n0, kb * 64, gain, 1.f, scr, F.lane);
    }
    zero_fill16(F, WinT + (size_t)(C_GGD + 16) * D, (size_t)(C_GQ - C_GGD - 16) * D * 2);
    { const u32x4 z4 = zero4();
      for (int i = F.bid * NTHREADS + F.tid; i < 1024 * 16; i += F.G * NTHREADS) { const int row = 768 + (i >> 4), c = 16 + (i & 15); *(u32x4*)(uq + (size_t)row * 256 + 8 * c) = z4; } }
}

__device__ __forceinline__ float row_rstd(const Frame& F, const f32x4 (&v)[4]) {
    float s = 0.f;
#pragma unroll
    for (int j = 0; j < 4; ++j) s += (v[j].x * v[j].x + v[j].y * v[j].y) + (v[j].z * v[j].z + v[j].w * v[j].w);
    return frsq(wave_sum(F.lane, s) * (1.f / D) + EPS);
}
__device__ __forceinline__ void store_row_bf16(bf16* orow, const f32x4 (&v)[4], float rstd, const float* gain, int lane) {
    unsigned long long* o8 = (unsigned long long*)orow + lane;
#pragma unroll
    for (int j = 0; j < 4; ++j) { const f32x4 g = gld<f32x4>((const f32x4*)gain + lane + 64 * j);
        gst<u32x2>(o8 + 64 * j, (u32x2){pk2(v[j].x * rstd * g.x, v[j].y * rstd * g.y), pk2(v[j].z * rstd * g.z, v[j].w * rstd * g.w)}); }
}
__device__ __forceinline__ void store_row_bf16g(bf16* orow, const f32x4 (&v)[4], float rstd, const f32x4 (&g)[4], int lane) {
    unsigned long long* o8 = (unsigned long long*)orow + lane;
#pragma unroll
    for (int j = 0; j < 4; ++j) gst<u32x2>(o8 + 64 * j, (u32x2){pk2(v[j].x * rstd * g[j].x, v[j].y * rstd * g[j].y), pk2(v[j].z * rstd * g[j].z, v[j].w * rstd * g[j].w)});
}
__device__ __forceinline__ void store_row_fp8(unsigned char* orow, const f32x4 (&v)[4], float rstd, const float* gain, float scale, int lane) {
    unsigned* o4 = (unsigned*)orow + lane;
#pragma unroll
    for (int j = 0; j < 4; ++j) { const f32x4 g = gld<f32x4>((const f32x4*)gain + lane + 64 * j); const float sc = rstd * scale;
        gst<unsigned>(o4 + 64 * j, pg8::fp8x4((f32x4){v[j].x * sc * g.x, v[j].y * sc * g.y, v[j].z * sc * g.z, v[j].w * sc * g.w})); }
}
__device__ __forceinline__ void load_h_row(const bf16* hrow, int lane, f32x4 (&v)[4]) {
#pragma unroll
    for (int j = 0; j < 4; ++j) { const u32x2 w = *(const GAS u32x2*)gp((const u32x2*)hrow + lane + 64 * j); v[j] = (f32x4){bflo(w.x), bfhi(w.x), bflo(w.y), bfhi(w.y)}; }
}
__device__ __forceinline__ void store_h_row(bf16* hrow, int lane, const f32x4 (&v)[4]) {
#pragma unroll
    for (int j = 0; j < 4; ++j) { u32x2 w; w.x = pk2(v[j].x, v[j].y); w.y = pk2(v[j].z, v[j].w); gst<u32x2>((u32x2*)hrow + lane + 64 * j, w); }
}
__device__ __forceinline__ void phase_init_rows(const Frame& F, const float* gain) {
    bf16* H = (bf16*)(F.ws + WS_H); bf16* U = (bf16*)(F.dout + DO_U);
    const float* x = inptr(0); const float* meta = inptr(1);
    f32x4 gn[4];
#pragma unroll
    for (int j = 0; j < 4; ++j) gn[j] = gld<f32x4>((const f32x4*)gain + F.lane + 64 * j);
    f32x4 vr[2][4];
    auto issue = [&](int q, int r_) { const int r = r_ < M ? r_ : F.gw; const int b = r / LP, p = r - b * LP;
        const float* src = (p < 128) ? meta + (size_t)(p < PADL ? 0 : p - PADL) * D : x + ((size_t)b * SEQ + (p - 128)) * D;
#pragma unroll
        for (int j = 0; j < 4; ++j) vr[q][j] = *(const GAS f32x4*)gp((const f32x4*)src + F.lane + 64 * j); };
    issue(0, F.gw); issue(1, F.gw + F.NGW);
    for (int r0 = F.gw; r0 < M; r0 += 2 * F.NGW)
#pragma unroll
        for (int q = 0; q < 2; ++q) { const int r = r0 + q * F.NGW; if (r >= M) break;
            f32x4 v[4]; const int p = r % LP;
#pragma unroll
            for (int j = 0; j < 4; ++j) { v[j] = vr[q][j]; if (p < PADL) v[j] = (f32x4){0.f, 0.f, 0.f, 0.f}; }
            issue(q, r + 2 * F.NGW);
            store_h_row(H + (size_t)r * D, F.lane, v);
            const float rstd = row_rstd(F, v);
            store_row_bf16g(U + (size_t)r * D, v, rstd, gn, F.lane); }
}
__device__ __forceinline__ void phase_norm_rows(const Frame& F, const float* gain, bf16* U) {
    const bf16* H = (const bf16*)(F.ws + WS_H);
    f32x4 gn[4];
#pragma unroll
    for (int j = 0; j < 4; ++j) gn[j] = gld<f32x4>((const f32x4*)gain + F.lane + 64 * j);
    u32x2 rw[4][4];
#pragma unroll
    for (int q = 0; q < 4; ++q) { const int r = F.gw + q * F.NGW < M ? F.gw + q * F.NGW : F.gw;
#pragma unroll
        for (int j = 0; j < 4; ++j) rw[q][j] = *(const GAS u32x2*)gp((const u32x2*)(H + (size_t)r * D) + F.lane + 64 * j); }
    for (int r0 = F.gw; r0 < M; r0 += 4 * F.NGW)
#pragma unroll
        for (int q = 0; q < 4; ++q) { const int r = r0 + q * F.NGW; if (r >= M) break;
            f32x4 v[4];
#pragma unroll
            for (int j = 0; j < 4; ++j) { const u32x2 w = rw[q][j]; v[j] = (f32x4){bflo(w.x), bfhi(w.x), bflo(w.y), bfhi(w.y)}; }
            { const int rn = r + 4 * F.NGW < M ? r + 4 * F.NGW : r;
#pragma unroll
              for (int j = 0; j < 4; ++j) rw[q][j] = *(const GAS u32x2*)gp((const u32x2*)(H + (size_t)rn * D) + F.lane + 64 * j); }
            const float rstd = row_rstd(F, v);
            store_row_bf16g(U + (size_t)r * D, v, rstd, gn, F.lane); }
}
__device__ __forceinline__ void phase_rope_table(const Frame& F) {
    float* ct = (float*)(F.ws + WS_ROPE); float* st = ct + LP * 16;
    for (int i = F.bid * NTHREADS + F.tid; i < LP * 16; i += F.G * NTHREADS) {
        const int p = i >> 4, k = i & 15; const int pos = p - PADL;
        const float inv = exp2f(-(float)k * 0.83048202372184059f);
        const float ang = (float)(pos < 0 ? 0 : pos) * inv;
        const float c_hi = 0.15915494309189535f;
        const float c_lo = 6.420638326565253e-09f;
        const float t_hi = ang * c_hi; const float e = fmaf(ang, c_hi, -t_hi);
        float fr = t_hi - rintf(t_hi); fr += e + ang * c_lo;
        ct[i] = __builtin_amdgcn_cosf(fr); st[i] = __builtin_amdgcn_sinf(fr);
    }
}

namespace att {
typedef float f32x16 __attribute__((ext_vector_type(16)));
typedef short s16x4 __attribute__((ext_vector_type(4)));
typedef short v4i16_t __attribute__((ext_vector_type(4)));
constexpr int KS = 208, VS = 192, KBUF = 64 * KS, VBUF = 64 * VS, BUF = KBUF + VBUF;
constexpr int NUNIT = BATCH * 8 * 33;
__device__ __forceinline__ int crow(int r, int hi) { return (r & 3) + 8 * (r >> 2) + 4 * hi; }
__device__ __forceinline__ unsigned cvtpk(float lo, float hi) { unsigned r; asm volatile("v_cvt_pk_bf16_f32 %0, %1, %2" : "=v"(r) : "v"(lo), "v"(hi)); return r; }
__device__ __forceinline__ s16x4 vtr(const LAS unsigned char* p) { return __builtin_bit_cast(s16x4, __builtin_amdgcn_ds_read_tr16_b64_v4i16((LAS v4i16_t*)p)); }
__device__ __forceinline__ float xhalf_max(float m) { auto rr = __builtin_amdgcn_permlane32_swap(__float_as_uint(m), __float_as_uint(m), false, false); return fmaxf(__uint_as_float(rr[0]), __uint_as_float(rr[1])); }
__device__ __forceinline__ float xhalf_sum(float m) { auto rr = __builtin_amdgcn_permlane32_swap(__float_as_uint(m), __float_as_uint(m), false, false); return __uint_as_float(rr[0]) + __uint_as_float(rr[1]); }

__device__ __forceinline__ void unit(const Frame& F, int b, int h, int qb) {
    const int tid = F.tid, lane = F.lane, wave = F.wave, r32 = lane & 31, hi = lane >> 5;
    bf16* Q = (bf16*)(F.dout + DO_Q); const bf16* Kg = (const bf16*)(F.dout + DO_K) + (size_t)b * LP * QKW + h * 96; const bf16* Vg = (const bf16*)(F.ws + WS_V) + (size_t)b * LP * VW + h * 64;
    const int pw = 256 * qb + 32 * wave;
    const int Tl = (4 * qb + 3) < 129 ? (4 * qb + 3) : 129;
    const int twr = pw >> 6;
    const int tw = (pw >= LP) ? 0 : (twr < 129 ? twr : 129);
    const int qp = pw + r32, qpc = qp < LP ? qp : LP - 1;
    bf16x8 qf[6];
    { const bf16* qrow = Q + ((size_t)b * LP + qpc) * QKW + h * 96 + 8 * hi;
#pragma unroll
      for (int ks = 0; ks < 6; ++ks) qf[ks] = *(const GAS bf16x8*)gp(qrow + 16 * ks); }
    const int kr0 = tid / 12, kc0 = tid % 12, kr1 = (512 + tid) / 12, kc1 = (512 + tid) % 12, vr = tid >> 3, vc = tid & 7;
    const bf16* kg0 = Kg + (size_t)kr0 * QKW + kc0 * 8; const bf16* kg1 = Kg + (size_t)kr1 * QKW + kc1 * 8; const bf16* vg = Vg + (size_t)vr * VW + vc * 8;
    LAS unsigned char* lds = F.lds;
    const int kl0 = kr0 * KS + kc0 * 16, kl1 = kr1 * KS + kc1 * 16, vl = KBUF + vr * VS + vc * 16;
    const int koff = r32 * KS + 16 * hi;
    const int voff = KBUF + (4 * hi + ((lane & 15) >> 2)) * VS + (16 * ((lane >> 4) & 1) + 4 * (lane & 3)) * 2;
    u32x4 kA0, kA1 = zero4(), vA;
#define ATT_LOAD(k0_, k1_, v_, tt) do { const int tc_ = (tt) <= Tl ? (tt) : Tl; const size_t ko_ = (size_t)(64 * tc_) * QKW, vo_ = (size_t)(64 * tc_) * VW; \
        k0_ = *(const GAS u32x4*)gp(kg0 + ko_); if (tid < 256) k1_ = *(const GAS u32x4*)gp(kg1 + ko_); v_ = *(const GAS u32x4*)gp(vg + vo_); } while (0)
#define ATT_WRITE(k0_, k1_, v_, bufi) do { LAS unsigned char* nb_ = lds + (bufi) * BUF; *(LAS u32x4*)(nb_ + kl0) = k0_; if (tid < 256) *(LAS u32x4*)(nb_ + kl1) = k1_; *(LAS u32x4*)(nb_ + vl) = v_; } while (0)
#define ATT_QK(P0, P1, bufi) do { const LAS unsigned char* kq_ = lds + (bufi) * BUF + koff; \
        _Pragma("unroll") for (int ks = 0; ks < 6; ++ks) { const bf16x8 a0 = *(const LAS bf16x8*)(kq_ + 32 * ks), a1 = *(const LAS bf16x8*)(kq_ + 32 * KS + 32 * ks); \
            P0 = __builtin_amdgcn_mfma_f32_32x32x16_bf16(a0, qf[ks], P0, 0, 0, 0); P1 = __builtin_amdgcn_mfma_f32_32x32x16_bf16(a1, qf[ks], P1, 0, 0, 0); } } while (0)
#define ATT_MASK(P0, P1, tt) do { const int kbase = 64 * (tt) + 4 * hi; \
        _Pragma("unroll") for (int r = 0; r < 16; ++r) { const int key = kbase + (r & 3) + 8 * (r >> 2); \
            if (key > qp || key < PADL) P0[r] = -1e30f; if (key + 32 > qp || key + 32 < PADL) P1[r] = -1e30f; } } while (0)
    ATT_LOAD(kA0, kA1, vA, 1); ATT_WRITE(kA0, kA1, vA, 0);
    ATT_LOAD(kA0, kA1, vA, 2); ATT_WRITE(kA0, kA1, vA, 1);
    __syncthreads();
    float m = -1e30f, l = 0.f; f32x16 o0 = {}, o1 = {}, p0 = {}, p1 = {};
    if (tw >= 1) { ATT_QK(p0, p1, 0); ATT_MASK(p0, p1, 1); }
    int cur = 0;
    for (int t = 1; t <= Tl; ++t) {
        ATT_LOAD(kA0, kA1, vA, t + 2);
        const int nx1 = cur == 2 ? 0 : cur + 1, nx2 = nx1 == 2 ? 0 : nx1 + 1;
        if (t <= tw) {
            const LAS unsigned char* kb = lds + cur * BUF; const LAS unsigned char* kq_ = lds + nx1 * BUF + koff;
            bf16x8 kf0[3], kf1[3];
#pragma unroll
            for (int ks = 0; ks < 3; ++ks) { kf0[ks] = *(const LAS bf16x8*)(kq_ + 32 * ks); kf1[ks] = *(const LAS bf16x8*)(kq_ + 32 * KS + 32 * ks); }
            __builtin_amdgcn_sched_barrier(0);
            float rm = fmaxf(p0[0], p1[0]);
#pragma unroll
            for (int r = 1; r < 16; ++r) rm = fmaxf(rm, fmaxf(p0[r], p1[r]));
            rm = xhalf_max(rm);
            const float mn = fmaxf(m, rm), alpha = __builtin_amdgcn_exp2f(m - mn); m = mn;
            __builtin_amdgcn_sched_barrier(0);
            f32x16 n0 = {}, n1 = {};
#pragma unroll
            for (int ks = 0; ks < 3; ++ks) { n0 = __builtin_amdgcn_mfma_f32_32x32x16_bf16(kf0[ks], qf[ks], n0, 0, 0, 0); n1 = __builtin_amdgcn_mfma_f32_32x32x16_bf16(kf1[ks], qf[ks], n1, 0, 0, 0); }
            __builtin_amdgcn_sched_barrier(0);
#pragma unroll
            for (int ks = 0; ks < 3; ++ks) { kf0[ks] = *(const LAS bf16x8*)(kq_ + 32 * (ks + 3)); kf1[ks] = *(const LAS bf16x8*)(kq_ + 32 * KS + 32 * (ks + 3)); }
            __builtin_amdgcn_sched_barrier(0);
            float ls = 0.f;
#pragma unroll
            for (int r = 0; r < 16; ++r) { p0[r] = __builtin_amdgcn_exp2f(p0[r] - mn); ls += p0[r]; }
            __builtin_amdgcn_sched_barrier(0);
#pragma unroll
            for (int ks = 0; ks < 3; ++ks) { n0 = __builtin_amdgcn_mfma_f32_32x32x16_bf16(kf0[ks], qf[ks + 3], n0, 0, 0, 0); n1 = __builtin_amdgcn_mfma_f32_32x32x16_bf16(kf1[ks], qf[ks + 3], n1, 0, 0, 0); }
            __builtin_amdgcn_sched_barrier(0);
            s16x4 vlo[8], vhi[8];
#pragma unroll
            for (int s_ = 0; s_ < 4; ++s_)
#pragma unroll
                for (int d0 = 0; d0 < 2; ++d0) { const LAS unsigned char* vp = kb + voff + (32 * (s_ >> 1) + 16 * (s_ & 1)) * VS + 64 * d0; vlo[2 * s_ + d0] = vtr(vp); vhi[2 * s_ + d0] = vtr(vp + 8 * VS); }
            __builtin_amdgcn_sched_barrier(0);
#pragma unroll
            for (int r = 0; r < 16; ++r) { p1[r] = __builtin_amdgcn_exp2f(p1[r] - mn); ls += p1[r]; }
            l = l * alpha + ls;
            if (!__all(alpha == 1.f)) {
#pragma unroll
                for (int r = 0; r < 16; ++r) { o0[r] *= alpha; o1[r] *= alpha; } }
            bf16x8 pb[4];
#pragma unroll
            for (int s_ = 0; s_ < 4; ++s_) { u32x4 w;
                if (s_ < 2) { w.x = cvtpk(p0[8 * s_], p0[8 * s_ + 1]); w.y = cvtpk(p0[8 * s_ + 2], p0[8 * s_ + 3]); w.z = cvtpk(p0[8 * s_ + 4], p0[8 * s_ + 5]); w.w = cvtpk(p0[8 * s_ + 6], p0[8 * s_ + 7]); }
                else { const int q_ = 8 * (s_ - 2); w.x = cvtpk(p1[q_], p1[q_ + 1]); w.y = cvtpk(p1[q_ + 2], p1[q_ + 3]); w.z = cvtpk(p1[q_ + 4], p1[q_ + 5]); w.w = cvtpk(p1[q_ + 6], p1[q_ + 7]); }
                pb[s_] = __builtin_bit_cast(bf16x8, w); }
#pragma unroll
            for (int s_ = 0; s_ < 4; ++s_) {
                const bf16x8 af0 = (bf16x8){vlo[2 * s_][0], vlo[2 * s_][1], vlo[2 * s_][2], vlo[2 * s_][3], vhi[2 * s_][0], vhi[2 * s_][1], vhi[2 * s_][2], vhi[2 * s_][3]};
                const bf16x8 af1 = (bf16x8){vlo[2 * s_ + 1][0], vlo[2 * s_ + 1][1], vlo[2 * s_ + 1][2], vlo[2 * s_ + 1][3], vhi[2 * s_ + 1][0], vhi[2 * s_ + 1][1], vhi[2 * s_ + 1][2], vhi[2 * s_ + 1][3]};
                o0 = __builtin_amdgcn_mfma_f32_32x32x16_bf16(af0, pb[s_], o0, 0, 0, 0); o1 = __builtin_amdgcn_mfma_f32_32x32x16_bf16(af1, pb[s_], o1, 0, 0, 0); }
            if (t + 1 == twr) ATT_MASK(n0, n1, t + 1);
            p0 = n0; p1 = n1;
        }
        ATT_WRITE(kA0, kA1, vA, nx2); __syncthreads(); cur = nx1;
    }
#undef ATT_LOAD
#undef ATT_WRITE
#undef ATT_QK
#undef ATT_MASK
    const float lt = xhalf_sum(l); const float inv = (qp >= PADL && lt > 0.f) ? 1.f / lt : 0.f;
    if (qp < LP && !F.dry) { bf16* orow = (bf16*)(F.ws + WS_YM) + ((size_t)b * LP + qp) * YW + C_O + h * 64 + 4 * hi;
#pragma unroll
        for (int g4 = 0; g4 < 4; ++g4) { u32x2 w0, w1;
            w0.x = cvtpk(o0[4 * g4] * inv, o0[4 * g4 + 1] * inv); w0.y = cvtpk(o0[4 * g4 + 2] * inv, o0[4 * g4 + 3] * inv);
            w1.x = cvtpk(o1[4 * g4] * inv, o1[4 * g4 + 1] * inv); w1.y = cvtpk(o1[4 * g4 + 2] * inv, o1[4 * g4 + 3] * inv);
            gst<u32x2>(orow + 8 * g4, w0); gst<u32x2>(orow + 32 + 8 * g4, w1); } }
}
__device__ __forceinline__ void phase(const Frame& F, int layer) {
    const int xg = F.bid & 7;
    unsigned* ctl = (unsigned*)(F.ws + WS_CTL) + CW_ATTQ + 64 * ((2 * layer + F.dry) * 8 + xg);
    volatile LAS int* slot = (volatile LAS int*)(F.lds + MISC_OFF + 64);
    for (;;) {
        if (F.tid == 0) slot[0] = (int)atomicAdd(ctl, 1u);
        __syncthreads();
        const int i = __builtin_amdgcn_readfirstlane(slot[0]);
        __syncthreads();
        if (i >= NUNIT / 8) break;
        const int qb = 32 - (i >> 2), bh = 4 * xg + (i & 3);
        unit(F, bh >> 3, bh & 7, qb);
    }
}
}

namespace mla {
__device__ __forceinline__ void fix(const Frame& F, int layer) {
    const bf16* Ym = (const bf16*)(F.ws + WS_YM);
    bf16* Q = (bf16*)(F.dout + DO_Q); bf16* Kb = (bf16*)(F.dout + DO_K); bf16* V = (bf16*)(F.ws + WS_V);
    const float* qn = inptr(8) + layer * 96; const float* kn = inptr(9) + layer * 96;
    const float* ct = (const float*)(F.ws + WS_ROPE); const float* st = ct + LP * 16;
    const int lane = F.lane, h = lane >> 3, sub = lane & 7;
    f32x4 qg0 = *(const GAS f32x4*)gp(qn + 8 * sub), qg1 = *(const GAS f32x4*)gp(qn + 8 * sub + 4), kg0 = *(const GAS f32x4*)gp(kn + 8 * sub), kg1 = *(const GAS f32x4*)gp(kn + 8 * sub + 4);
    const f32x2 qr1 = *(const GAS f32x2*)gp(qn + 64 + 2 * sub), qr2 = *(const GAS f32x2*)gp(qn + 80 + 2 * sub), kr1 = *(const GAS f32x2*)gp(kn + 64 + 2 * sub), kr2 = *(const GAS f32x2*)gp(kn + 80 + 2 * sub);
    struct Ld { u32x2 dqw; unsigned dkw, krw, qa, qb, ka, kb_; u32x4 qw, kw, vw; f32x2 c, sn; };
    auto load_row = [&](int r) { Ld d; const int rc = r < M ? r : F.gw; const int p = rc % LP; const bf16* y = Ym + (size_t)rc * YW;
        const bf16* qrow = Q + (size_t)rc * QKW + h * 96; const bf16* krow = Kb + (size_t)rc * QKW + h * 96; const bf16* vrow = V + (size_t)rc * VW + h * 64;
        d.dqw = *(const GAS u32x2*)gp(y + C_DQ + 4 * lane); d.dkw = *(const GAS unsigned*)gp(y + C_DKV + 2 * lane);
        d.krw = *(const GAS unsigned*)gp(y + C_KR + 2 * (lane & 15));
        d.qw = *(const GAS u32x4*)gp(qrow + 8 * sub); d.qa = *(const GAS unsigned*)gp(qrow + 64 + 2 * sub); d.qb = *(const GAS unsigned*)gp(qrow + 80 + 2 * sub);
        d.kw = *(const GAS u32x4*)gp(krow + 8 * sub); d.vw = *(const GAS u32x4*)gp(vrow + 8 * sub);
        d.ka = *(const GAS unsigned*)gp(y + C_KR + 2 * sub); d.kb_ = *(const GAS unsigned*)gp(y + C_KR + 16 + 2 * sub);
        d.c = *(const GAS f32x2*)gp(ct + (size_t)p * 16 + 2 * sub); d.sn = *(const GAS f32x2*)gp(st + (size_t)p * 16 + 2 * sub); return d; };
    constexpr int NU = BATCH * (LP / 64 - 1) * 12, FIX_KEEP = 8;
    const int kmax_ = (M + F.NGW - 1) / F.NGW; const int nl4_ = NU % F.NGW; const int nl4 = (kmax_ > FIX_KEEP && (F.NGW - nl4_) >= nl4_ * (kmax_ - FIX_KEEP)) ? nl4_ : 0;
    const int kown = (M - F.gw + F.NGW - 1) / F.NGW;
    const int kmax = (M + F.NGW - 1) / F.NGW, nmv = kmax - FIX_KEEP;
    auto rowk = [&](int k) -> int {
        if (F.gw < nl4) return k < FIX_KEEP ? F.gw + k * F.NGW : M;
        if (k < kown) return F.gw + k * F.NGW;
        if (k == kown && nl4 > 0) { const int j = F.gw - nl4; if (j < nl4 * nmv) { const int r_ = (j % nl4) + (FIX_KEEP + j / nl4) * F.NGW; return r_ < M ? r_ : M; } }
        return M; };
    Ld nx = load_row(rowk(0));
    for (int kk = 0;; ++kk) { const int r = rowk(kk); if (r >= M) break;
        const Ld d = nx; nx = load_row(rowk(kk + 1));
        bf16* qrow = Q + (size_t)r * QKW + h * 96; bf16* krow = Kb + (size_t)r * QKW + h * 96; bf16* vrow = V + (size_t)r * VW + h * 64;
        const u32x2 dqw = d.dqw; const unsigned dkw = d.dkw, krw = d.krw, qa = d.qa, qb = d.qb, ka = d.ka, kb_ = d.kb_; const u32x4 qw = d.qw, kw = d.kw, vw = d.vw; const f32x2 c = d.c, sn = d.sn;
        const float rsq = frsq(wave_sum(F.lane, bflo(dqw.x) * bflo(dqw.x) + bfhi(dqw.x) * bfhi(dqw.x) + bflo(dqw.y) * bflo(dqw.y) + bfhi(dqw.y) * bfhi(dqw.y)) * (1.f / 256.f) + EPS);
        const float rskv = frsq(wave_sum(F.lane, bflo(dkw) * bflo(dkw) + bfhi(dkw) * bfhi(dkw)) * (1.f / 128.f) + EPS);
        float krs = bflo(krw) * bflo(krw) + bfhi(krw) * bfhi(krw);
        krs = sum16(krs);
        { float e[8] = {bflo(qw.x), bfhi(qw.x), bflo(qw.y), bfhi(qw.y), bflo(qw.z), bfhi(qw.z), bflo(qw.w), bfhi(qw.w)}; float x1[2] = {bflo(qa), bfhi(qa)}, x2[2] = {bflo(qb), bfhi(qb)};
          float ss = 0.f;
#pragma unroll
          for (int i = 0; i < 8; ++i) { e[i] *= rsq; ss += e[i] * e[i]; }
#pragma unroll
          for (int i = 0; i < 2; ++i) { x1[i] *= rsq; x2[i] *= rsq; ss += x1[i] * x1[i] + x2[i] * x2[i]; }
          ss = sum8(ss);
          const float sc = QSCALE * frsq(ss * (1.f / 96.f) + EPS);
          u32x4 w; w.x = pk2(e[0] * sc * qg0[0], e[1] * sc * qg0[1]); w.y = pk2(e[2] * sc * qg0[2], e[3] * sc * qg0[3]); w.z = pk2(e[4] * sc * qg1[0], e[5] * sc * qg1[1]); w.w = pk2(e[6] * sc * qg1[2], e[7] * sc * qg1[3]);
          if (!F.dry) *(GAS u32x4*)gpw(qrow + 8 * sub) = w;
          const float a0 = x1[0] * sc * qr1[0], a1 = x1[1] * sc * qr1[1], b0 = x2[0] * sc * qr2[0], b1 = x2[1] * sc * qr2[1];
          if (!F.dry) *(GAS unsigned*)gpw(qrow + 64 + 2 * sub) = pk2(a0 * c[0] - b0 * sn[0], a1 * c[1] - b1 * sn[1]); if (!F.dry) *(GAS unsigned*)gpw(qrow + 80 + 2 * sub) = pk2(a0 * sn[0] + b0 * c[0], a1 * sn[1] + b1 * c[1]); }
        { float e[8] = {bflo(kw.x), bfhi(kw.x), bflo(kw.y), bfhi(kw.y), bflo(kw.z), bfhi(kw.z), bflo(kw.w), bfhi(kw.w)}; float ss = 0.f;
#pragma unroll
          for (int i = 0; i < 8; ++i) { e[i] *= rskv; ss += e[i] * e[i]; }
          ss = sum8(ss);
          const float sc = frsq((ss + krs) * (1.f / 96.f) + EPS);
          u32x4 w; w.x = pk2(e[0] * sc * kg0[0], e[1] * sc * kg0[1]); w.y = pk2(e[2] * sc * kg0[2], e[3] * sc * kg0[3]); w.z = pk2(e[4] * sc * kg1[0], e[5] * sc * kg1[1]); w.w = pk2(e[6] * sc * kg1[2], e[7] * sc * kg1[3]);
          if (!F.dry) *(GAS u32x4*)gpw(krow + 8 * sub) = w;
          const float a0 = bflo(ka) * sc * kr1[0], a1 = bfhi(ka) * sc * kr1[1], b0 = bflo(kb_) * sc * kr2[0], b1 = bfhi(kb_) * sc * kr2[1];
          if (!F.dry) *(GAS unsigned*)gpw(krow + 64 + 2 * sub) = pk2(a0 * c[0] - b0 * sn[0], a1 * c[1] - b1 * sn[1]); if (!F.dry) *(GAS unsigned*)gpw(krow + 80 + 2 * sub) = pk2(a0 * sn[0] + b0 * c[0], a1 * sn[1] + b1 * c[1]);
          u32x4 wv; wv.x = pk2(bflo(vw.x) * rskv, bfhi(vw.x) * rskv); wv.y = pk2(bflo(vw.y) * rskv, bfhi(vw.y) * rskv); wv.z = pk2(bflo(vw.z) * rskv, bfhi(vw.z) * rskv); wv.w = pk2(bflo(vw.w) * rskv, bfhi(vw.w) * rskv);
          if (!F.dry) *(GAS u32x4*)gpw(vrow + 8 * sub) = wv; }
    }
}
}

constexpr size_t WS_C12 = 551 * MiB;
constexpr int NCHUNK = LP / 64;
__device__ __forceinline__ void phase_lin_prep(const Frame& F, int layer) {
    bf16* Ym = (bf16*)(F.ws + WS_YM); float* c1g = (float*)(F.ws + WS_C12);
    const int lane = F.lane;
    LAS float* bbl = (LAS float*)(F.lds + F.wave * 16384) + lane;
    for (int u = F.gw; u < BATCH * (NCHUNK - 1) * 12; u += F.NGW) {
        const int cq_ = u / 12, sub = u % 12, b = cq_ / (NCHUNK - 1), n = 1 + cq_ % (NCHUNK - 1), chunk = b * NCHUNK + n;
        const bool HG = sub >= 4; const int h = HG ? (sub - 4) >> 1 : sub; const int i = HG ? ((sub - 4) & 1) * 64 + lane : lane; const int DK = HG ? 128 : 64;
        const int ch = h * DK + i; const int cq = (HG ? C_HQ : C_GQ) + ch, ck = (HG ? C_HF : C_GK) + ch;
        bf16* y0 = Ym + ((size_t)b * LP + 64 * n) * YW;
        const int tpad = PADL - 64 * n;
        float run = 0.f, lb = 0.f;
        unsigned kq[128];
#define LP_ISSUE() do { _Pragma("unroll") for (int t = 0; t < 64; ++t) { const bf16* y = y0 + (size_t)t * YW; kq[t] = gld<bf16>(y + ck); kq[64 + t] = gld<bf16>(y + cq); } } while (0)
        if (!HG) { const float* w_g2 = inptr(10) + (size_t)layer * 16 * 256; const float bg = inptr(11)[layer * 256 + ch]; float wg[16];
#pragma unroll
            for (int rr = 0; rr < 16; ++rr) wg[rr] = gld<float>(w_g2 + rr * 256 + ch);
#pragma unroll 16
            for (int t = 0; t < 64; ++t) { const bf16* y = y0 + (size_t)t * YW; const u32x4 g0 = gld<u32x4>(y + C_GGD), g1 = gld<u32x4>(y + C_GGD + 8);
                const float z = bg + bflo(g0.x) * wg[0] + bfhi(g0.x) * wg[1] + bflo(g0.y) * wg[2] + bfhi(g0.y) * wg[3] + bflo(g0.z) * wg[4] + bfhi(g0.z) * wg[5] + bflo(g0.w) * wg[6] + bfhi(g0.w) * wg[7]
                              + bflo(g1.x) * wg[8] + bfhi(g1.x) * wg[9] + bflo(g1.y) * wg[10] + bfhi(g1.y) * wg[11] + bflo(g1.z) * wg[12] + bfhi(g1.z) * wg[13] + bflo(g1.w) * wg[14] + bfhi(g1.w) * wg[15];
                float lg = -(fmaxf(-z, 0.f) + flog(1.f + __expf(-fabsf(z)))) * (1.f / 16.f);
                if (t < tpad) lg = 0.f;
                run += lg; bbl[64 * t] = run; }
            LP_ISSUE();
        } else { if (layer == 1) { const float* lbp = inptr(13); lb = 1.f / (1.f + __expf(lbp[ch] - lbp[512 + ch])); }
            LP_ISSUE();
#pragma unroll
            for (int t = 0; t < 64; ++t) { const float f = lb + (1.f - lb) * sigmoidf_(bf2f((bf16)kq[t])); float lg = flog(fmaxf(f, 1e-30f));
                kq[t] = __builtin_bit_cast(unsigned, f);
                if (t < tpad) lg = 0.f;
                run += lg; bbl[64 * t] = run; } }
#undef LP_ISSUE
        const float bref = run;
#pragma unroll
        for (int t = 0; t < 64; ++t) { bf16* y = y0 + (size_t)t * YW; float q, k;
            if (!HG) { q = bf2f((bf16)kq[64 + t]) * 0.125f; k = bf2f((bf16)kq[t]); }
            else { q = siluf_(bf2f((bf16)kq[64 + t])); k = 1.f - __builtin_bit_cast(float, kq[t]); }
            if (t < tpad) { q = 0.f; k = 0.f; }
            const float d = fminf(bbl[64 * t] - bref, 80.f);
            if (!F.dry) { gst<bf16>(y + cq, (bf16)f2bf(q * __expf(d))); gst<bf16>(y + ck, (bf16)f2bf(k * __expf(-d))); } }
        if (!F.dry) gst<float>(c1g + chunk * 768 + (HG ? 256 + ch : ch), __expf(bref));
    }
}
namespace lin {
typedef float f32x16 __attribute__((ext_vector_type(16)));
using att::vtr; using att::cvtpk; using att::crow; using att::xhalf_sum; typedef att::s16x4 s16x4;
constexpr int NSEG = 4;
constexpr size_t WS_SLOC = 553 * MiB;
constexpr size_t WS_DTOT = 561 * MiB;
template <int DK, bool HG>
__device__ __forceinline__ void pass1(const Frame& F, int b, int h, int n0, int nc, float* sloc, float* dtot) {
    constexpr int QS = DK * 2 + 16, VSt = 320, QB = 64 * QS, VB = 64 * VSt, CB = DK * 4, BUFB = QB + VB + CB, NI = DK / 32, NO = NI / 2, QCH = DK / 8;
    constexpr int NQC = 64 * QCH, NL = (NQC + 1024) / NTHREADS; static_assert(NQC % NTHREADS == 0 && 2 * BUFB <= RING_BYTES, "pass1 staging");
    const bf16* Ym = (const bf16*)(F.ws + WS_YM); const float* c1g = (const float*)(F.ws + WS_C12);
    const int tid = F.tid, lane = F.lane, wave = F.wave, j = wave & 3, th = wave >> 2, hi = lane >> 5;
    const int ck = (HG ? C_HF : C_GK) + h * DK, cv = (HG ? C_HI : C_GV) + h * 128, cc = (HG ? 256 : 0) + h * DK;
    LAS unsigned char* lds = F.lds;
    unsigned gsrc[NL]; int ldst[NL];
#pragma unroll
    for (int k = 0; k < NL; ++k) { const int reg = (NTHREADS * k) / NQC;
        if (reg < 1) { const int e2 = tid + NTHREADS * k, r = e2 / QCH, c = e2 % QCH; gsrc[k] = (unsigned)(r * YW + ck + 8 * c); ldst[k] = r * QS + 16 * c; }
        else { const int e3 = tid + NTHREADS * k - NQC, r = e3 >> 4, c = e3 & 15; gsrc[k] = (unsigned)(r * YW + cv + 8 * c); ldst[k] = QB + r * VSt + 16 * c; } }
    const size_t rowb = (size_t)b * LP;
    float S[NO][16];
#pragma unroll
    for (int i = 0; i < NO; ++i)
#pragma unroll
        for (int r = 0; r < 16; ++r) S[i][r] = 0.f;
    f32x4 prod;
    { const size_t ro = (rowb + 64 * n0) * YW; u32x4 st[NL];
#pragma unroll
      for (int k = 0; k < NL; ++k) st[k] = *(const GAS u32x4*)gp(Ym + ro + gsrc[k]);
      const f32x4 cst = *(const GAS f32x4*)gp(c1g + (size_t)(b * NCHUNK + n0) * 768 + cc + 4 * (tid & (DK / 4 - 1)));
#pragma unroll
      for (int k = 0; k < NL; ++k) *(LAS u32x4*)(lds + ldst[k]) = st[k];
      if (tid < DK / 4) *(LAS f32x4*)(lds + QB + VB + 16 * tid) = cst;
      prod = cst; }
    __syncthreads();
    const int trq = (lane & 15) >> 2, trc = (16 * ((lane >> 4) & 1) + 4 * (lane & 3)) * 2;
    int cur = 0;
    for (int c = 0; c < nc; ++c) {
        const bool more = c + 1 < nc; const int nn = n0 + c + (more ? 1 : 0); const size_t ron = (rowb + 64 * nn) * YW; LAS unsigned char* nb = lds + (cur ^ 1) * BUFB;
        u32x4 st[NL];
#pragma unroll
        for (int k = 0; k < NL; ++k) st[k] = *(const GAS u32x4*)gp(Ym + ron + gsrc[k]);
        const f32x4 cst = *(const GAS f32x4*)gp(c1g + (size_t)(b * NCHUNK + nn) * 768 + cc + 4 * (tid & (DK / 4 - 1)));
        const LAS unsigned char* kt = lds + cur * BUFB; const LAS unsigned char* vt = kt + QB; const LAS float* c1l = (const LAS float*)(vt + VB);
#pragma unroll
        for (int ii = 0; ii < NO; ++ii) { const int i = th + 2 * ii;
#pragma unroll
            for (int g4 = 0; g4 < 4; ++g4) { const f32x4 dc = *(const LAS f32x4*)(c1l + 32 * i + 8 * g4 + 4 * hi);
#pragma unroll
                for (int e = 0; e < 4; ++e) S[ii][4 * g4 + e] *= dc[e]; }
            f32x16 T = {};
#pragma unroll
            for (int s_ = 0; s_ < 4; ++s_) { const LAS unsigned char* kp = kt + (16 * s_ + 8 * hi + trq) * QS + 64 * i + trc; const LAS unsigned char* vp = vt + (16 * s_ + 8 * hi + trq) * VSt + 64 * j + trc;
                const s16x4 ka = vtr(kp), kb2 = vtr(kp + 4 * QS), va = vtr(vp), vb2 = vtr(vp + 4 * VSt);
                T = __builtin_amdgcn_mfma_f32_32x32x16_bf16((bf16x8){ka[0], ka[1], ka[2], ka[3], kb2[0], kb2[1], kb2[2], kb2[3]}, (bf16x8){va[0], va[1], va[2], va[3], vb2[0], vb2[1], vb2[2], vb2[3]}, T, 0, 0, 0); }
#pragma unroll
            for (int r = 0; r < 16; ++r) S[ii][r] += T[r]; }
#pragma unroll
        for (int k = 0; k < NL; ++k) *(LAS u32x4*)(nb + ldst[k]) = st[k];
        if (tid < DK / 4) *(LAS f32x4*)(nb + QB + VB + 16 * tid) = cst;
        if (more) prod = prod * cst;
        __syncthreads();
        cur ^= 1;
    }
#pragma unroll
    for (int ii = 0; ii < NO; ++ii) { const int i = th + 2 * ii;
#pragma unroll
        for (int r = 0; r < 16; ++r) *(GAS float*)gpw(sloc + (size_t)(((i * 4 + j) * 16 + r) * 64 + lane)) = S[ii][r]; }
    if (tid < DK / 4) *(GAS f32x4*)gpw((f32x4*)dtot + tid) = prod;
}
template <int DK, bool HG>
__device__ __forceinline__ void unit(const Frame& F, int layer, int b, int h, int seg, int uidx) {
    const int n0 = seg == 0 ? 1 : 34 + 32 * (seg - 1), nc = seg == 0 ? 33 : 32, nend = n0 + nc;
    float* slocb = (float*)(F.ws + WS_SLOC) + (size_t)uidx * NSEG * 16384; float* dtotb = (float*)(F.ws + WS_DTOT) + (size_t)uidx * NSEG * 128;
    unsigned* cnt = (unsigned*)(F.ws + WS_CTL) + CW_LINC + 64 * ((2 * layer + F.dry) * 32 + uidx);
    if (seg < NSEG - 1) pass1<DK, HG>(F, b, h, n0, nc, slocb + (size_t)seg * 16384, dtotb + seg * 128);
    asm volatile("s_waitcnt vmcnt(0)" ::: "memory");
    __syncthreads();
    if (F.tid == 0) { __builtin_amdgcn_fence(__ATOMIC_RELEASE, "agent"); asm volatile("s_waitcnt vmcnt(0)" ::: "memory"); (void)xb_add(cnt, 1u);
        if (seg > 0) { unsigned sp = 0; while (xb_ld(cnt) < (unsigned)NSEG) { __builtin_amdgcn_s_sleep(2); if (++sp > (1u << 22)) break; }
            __builtin_amdgcn_fence(__ATOMIC_ACQUIRE, "agent"); asm volatile("s_waitcnt vmcnt(0)" ::: "memory"); } }
    __syncthreads();
    constexpr int QS = DK * 2 + 16, VSt = 320, QB = 64 * QS, VB = 64 * VSt, CB = DK * 4, BUFB = 2 * QB + VB + CB, XCO = BUFB, SSO = XCO + 32768, ONO = SSO + 1024, NI = DK / 32, NO = NI / 2, QCH = DK / 8;
    static_assert(ONO + 512 <= RING_BYTES, "lin LDS");
    constexpr int NQC = 64 * QCH, NLD = (2 * NQC + 1024) / NTHREADS; static_assert(NQC % NTHREADS == 0, "staging regions");
    bf16* Ym = (bf16*)(F.ws + WS_YM); const float* c1g = (const float*)(F.ws + WS_C12);
    const int tid = F.tid, lane = F.lane, wave = F.wave, j = wave & 3, th = wave >> 2, r32 = lane & 31, hi = lane >> 5;
    const int cq = (HG ? C_HQ : C_GQ) + h * DK, ck = (HG ? C_HF : C_GK) + h * DK, cv = (HG ? C_HI : C_GV) + h * 128, cg = (HG ? C_HG : C_GR) + h * 128, cc = (HG ? 256 : 0) + h * DK;
    LAS unsigned char* lds = F.lds;
    unsigned gsrc[NLD]; int ldst[NLD];
#pragma unroll
    for (int k = 0; k < NLD; ++k) { const int reg = (NTHREADS * k) / NQC;
        if (reg < 2) { const int e2 = tid + NTHREADS * k - reg * NQC, r = e2 / QCH, c = e2 % QCH; gsrc[k] = (unsigned)(r * YW + (reg == 0 ? cq : ck) + 8 * c); ldst[k] = reg * QB + r * QS + 16 * c; }
        else { const int e3 = tid + NTHREADS * k - 2 * NQC, r = e3 >> 4, c = e3 & 15; gsrc[k] = (unsigned)(r * YW + cv + 8 * c); ldst[k] = 2 * QB + r * VSt + 16 * c; } }
    const size_t rowb = (size_t)b * LP;
    if (tid < 128) ((LAS float*)(lds + ONO))[tid] = (inptr(HG ? 14 : 12) + layer * 128)[tid];
    float S[NO][16];
#pragma unroll
    for (int i = 0; i < NO; ++i)
#pragma unroll
        for (int r = 0; r < 16; ++r) S[i][r] = 0.f;
#pragma unroll 1
    for (int g = 0; g < seg; ++g) {
#pragma unroll
        for (int ii = 0; ii < NO; ++ii) { const int i = th + 2 * ii;
#pragma unroll
            for (int g4 = 0; g4 < 4; ++g4) { const f32x4 dd = *(const GAS f32x4*)gp(dtotb + g * 128 + 32 * i + 8 * g4 + 4 * hi);
#pragma unroll
                for (int e = 0; e < 4; ++e) { const int r = 4 * g4 + e; S[ii][r] = dd[e] * S[ii][r] + *(const GAS float*)gp(slocb + (size_t)g * 16384 + ((i * 4 + j) * 16 + r) * 64 + lane); } } } }
    { const size_t ro = (rowb + 64 * n0) * YW;
#pragma unroll
      for (int k = 0; k < NLD; ++k) { const u32x4 v = *(const GAS u32x4*)gp(Ym + ro + gsrc[k]); *(LAS u32x4*)(lds + ldst[k]) = v; }
      if (tid < DK / 4) { const f32x4 cst = *(const GAS f32x4*)gp(c1g + (size_t)(b * NCHUNK + n0) * 768 + cc + 4 * tid); *(LAS f32x4*)(lds + 2 * QB + VB + 16 * tid) = cst; } }
    __syncthreads();
    const LAS unsigned char* qt = lds; const LAS unsigned char* kt = qt + QB; const LAS unsigned char* vt = kt + QB; const LAS float* c1l = (const LAS float*)(vt + VB);
    const int trq = (lane & 15) >> 2, trc = (16 * ((lane >> 4) & 1) + 4 * (lane & 3)) * 2;
    for (int n = n0; n < nend; ++n) {
        const int nn = n + 1 < nend ? n + 1 : n; const size_t ron = (rowb + 64 * nn) * YW;
        u32x4 st[NLD];
#pragma unroll
        for (int k = 0; k < NLD; ++k) st[k] = *(const GAS u32x4*)gp(Ym + ron + gsrc[k]);
        const f32x4 cst = *(const GAS f32x4*)gp(c1g + (size_t)(b * NCHUNK + nn) * 768 + cc + 4 * (tid & (DK / 4 - 1)));
        bf16* yrow = Ym + (rowb + 64 * n + 32 * th + r32) * YW;
        u32x2 gt[4];
#pragma unroll
        for (int g4 = 0; g4 < 4; ++g4) gt[g4] = *(const GAS u32x2*)gp(yrow + cg + 32 * j + 8 * g4 + 4 * hi);
        f32x16 o = {};
#pragma unroll
        for (int jb = 0; jb < 2; ++jb) { f32x16 AT = {};
#pragma unroll
            for (int ks = 0; ks < DK / 16; ++ks) { const bf16x8 bq = *(const LAS bf16x8*)(qt + (32 * th + r32) * QS + 32 * ks + 16 * hi);
                const bf16x8 ak = *(const LAS bf16x8*)(kt + (32 * jb + r32) * QS + 32 * ks + 16 * hi);
                AT = __builtin_amdgcn_mfma_f32_32x32x16_bf16(ak, bq, AT, 0, 0, 0); }
            int tq = 32 * th + r32 - 32 * jb;
            asm volatile("" : "+v"(tq));
#pragma unroll
            for (int r = 0; r < 16; ++r) AT[r] = (crow(r, hi) > tq) ? 0.f : AT[r];
#pragma unroll
            for (int sp = 0; sp < 2; ++sp) { u32x4 w; w.x = cvtpk(AT[8 * sp], AT[8 * sp + 1]); w.y = cvtpk(AT[8 * sp + 2], AT[8 * sp + 3]); w.z = cvtpk(AT[8 * sp + 4], AT[8 * sp + 5]); w.w = cvtpk(AT[8 * sp + 6], AT[8 * sp + 7]);
                const LAS unsigned char* vp = vt + (32 * jb + 16 * sp + 4 * hi + trq) * VSt + 64 * j + trc;
                const s16x4 lo = vtr(vp), h4 = vtr(vp + 8 * VSt);
                o = __builtin_amdgcn_mfma_f32_32x32x16_bf16((bf16x8){lo[0], lo[1], lo[2], lo[3], h4[0], h4[1], h4[2], h4[3]}, __builtin_bit_cast(bf16x8, w), o, 0, 0, 0); }
            __builtin_amdgcn_sched_barrier(0); }
        f32x16 op = {};
#pragma unroll
        for (int ii = 0; ii < NO; ++ii) { const int i = th + 2 * ii;
#pragma unroll
            for (int g4 = 0; g4 < 4; ++g4) { const f32x4 dc = *(const LAS f32x4*)(c1l + 32 * i + 8 * g4 + 4 * hi);
#pragma unroll
                for (int e = 0; e < 4; ++e) S[ii][4 * g4 + e] *= dc[e]; }
#pragma unroll
            for (int sp = 0; sp < 2; ++sp) { u32x4 w; w.x = cvtpk(S[ii][8 * sp], S[ii][8 * sp + 1]); w.y = cvtpk(S[ii][8 * sp + 2], S[ii][8 * sp + 3]); w.z = cvtpk(S[ii][8 * sp + 4], S[ii][8 * sp + 5]); w.w = cvtpk(S[ii][8 * sp + 6], S[ii][8 * sp + 7]);
                const LAS unsigned char* qo_ = qt + (32 * th + r32) * QS + (32 * i + 16 * sp + 4 * hi) * 2; const LAS unsigned char* qp_ = qt + (32 * (th ^ 1) + r32) * QS + (32 * i + 16 * sp + 4 * hi) * 2;
                const u32x2 b0 = *(const LAS u32x2*)qo_, b1 = *(const LAS u32x2*)(qo_ + 16), c0 = *(const LAS u32x2*)qp_, c1 = *(const LAS u32x2*)(qp_ + 16);
                o = __builtin_amdgcn_mfma_f32_32x32x16_bf16(__builtin_bit_cast(bf16x8, w), __builtin_bit_cast(bf16x8, (u32x4){b0.x, b0.y, b1.x, b1.y}), o, 0, 0, 0);
                op = __builtin_amdgcn_mfma_f32_32x32x16_bf16(__builtin_bit_cast(bf16x8, w), __builtin_bit_cast(bf16x8, (u32x4){c0.x, c0.y, c1.x, c1.y}), op, 0, 0, 0); }
            f32x16 T = {};
#pragma unroll
            for (int s_ = 0; s_ < 4; ++s_) { const LAS unsigned char* kp = kt + (16 * s_ + 8 * hi + trq) * QS + 64 * i + trc; const LAS unsigned char* vp = vt + (16 * s_ + 8 * hi + trq) * VSt + 64 * j + trc;
                const s16x4 ka = vtr(kp), kb2 = vtr(kp + 4 * QS), va = vtr(vp), vb2 = vtr(vp + 4 * VSt);
                T = __builtin_amdgcn_mfma_f32_32x32x16_bf16((bf16x8){ka[0], ka[1], ka[2], ka[3], kb2[0], kb2[1], kb2[2], kb2[3]}, (bf16x8){va[0], va[1], va[2], va[3], vb2[0], vb2[1], vb2[2], vb2[3]}, T, 0, 0, 0); }
#pragma unroll
            for (int r = 0; r < 16; ++r) S[ii][r] += T[r];
            __builtin_amdgcn_sched_barrier(0); }
        { LAS float* xo = (LAS float*)(lds + XCO) + wave * 1024 + lane;
#pragma unroll
          for (int r = 0; r < 16; ++r) xo[64 * r] = op[r]; }
        __syncthreads();
        { const LAS float* xi = (const LAS float*)(lds + XCO) + (wave ^ 4) * 1024 + lane;
#pragma unroll
          for (int r = 0; r < 16; ++r) o[r] += xi[64 * r]; }
        float ssq = 0.f;
#pragma unroll
        for (int r = 0; r < 16; ++r) ssq += o[r] * o[r];
        ssq = xhalf_sum(ssq);
        LAS float* ssb = (LAS float*)(lds + SSO);
        if (hi == 0) ssb[(th * 4 + j) * 32 + r32] = ssq;
#pragma unroll
        for (int k = 0; k < NLD; ++k) *(LAS u32x4*)(lds + ldst[k]) = st[k];
        if (tid < DK / 4) *(LAS f32x4*)(lds + 2 * QB + VB + 16 * tid) = cst;
        __syncthreads();
        const float tot = ssb[(th * 4 + 0) * 32 + r32] + ssb[(th * 4 + 1) * 32 + r32] + ssb[(th * 4 + 2) * 32 + r32] + ssb[(th * 4 + 3) * 32 + r32];
        const float rstd = frsq(tot * (1.f / 128.f) + EPS);
#pragma unroll
        for (int g4 = 0; g4 < 4; ++g4) { const f32x4 on = *(const LAS f32x4*)(lds + ONO + (32 * j + 8 * g4 + 4 * hi) * 4);
            const float v0 = o[4 * g4] * rstd * on[0] * siluf_(bflo(gt[g4].x)), v1 = o[4 * g4 + 1] * rstd * on[1] * siluf_(bfhi(gt[g4].x));
            const float v2 = o[4 * g4 + 2] * rstd * on[2] * siluf_(bflo(gt[g4].y)), v3 = o[4 * g4 + 3] * rstd * on[3] * siluf_(bfhi(gt[g4].y));
            u32x2 w; w.x = cvtpk(v0, v1); w.y = cvtpk(v2, v3); if (!F.dry) *(GAS u32x2*)gpw(yrow + cv + 32 * j + 8 * g4 + 4 * hi) = w; }
    }
    __syncthreads();
}
}
__device__ __forceinline__ void phase_linattn(const Frame& F, int layer) {
    if (F.bid < 32 * lin::NSEG) { const int seg = F.bid >> 5, u = F.bid & 31, br = u >> 4, b = (u >> 2) & 3, h = u & 3;
        if (br == 0) lin::unit<64, false>(F, layer, b, h, seg, u); else lin::unit<128, true>(F, layer, b, h, seg, u); }
}

__device__ __forceinline__ void phase_route(const Frame& F, const float* gain) {
    const bf16* H = (const bf16*)(F.ws + WS_H); const float* wr_ = inptr(23); const float* br_ = inptr(24);
    int* asg_e = (int*)(F.ws + WS_SMALL + SM_ASG_E); int* asg_i = (int*)(F.ws + WS_SMALL + SM_ASG_I); float* asg_w = (float*)(F.ws + WS_SMALL + SM_ASG_W);
    unsigned* ctl = (unsigned*)(F.ws + WS_CTL);
    f32x4 wa[4][4], wc[4][4];
#pragma unroll
    for (int j = 0; j < 4; ++j) { const f32x4 g = gld<f32x4>((const f32x4*)gain + F.lane + 64 * j); const f32x4* w0 = (const f32x4*)(wr_ + (size_t)(4 * (F.lane + 64 * j)) * 8);
#pragma unroll
        for (int kk = 0; kk < 4; ++kk) { wa[j][kk] = gld<f32x4>(w0 + 2 * kk) * g[kk]; wc[j][kk] = gld<f32x4>(w0 + 2 * kk + 1) * g[kk]; } }
    float brr[8];
#pragma unroll
    for (int e = 0; e < 8; ++e) brr[e] = gld<float>(br_ + e);
    constexpr int NT = BATCH * SEQ;
    int me1 = 0, me2 = 0, mt = -1, kit = 0; float mw1 = 0.f;
    u32x2 rw[4][4];
    const int npw_ = (NT + F.NGW - 1) / F.NGW, tw0 = F.gw * npw_, tw1 = (tw0 + npw_) < NT ? (tw0 + npw_) : NT;
#pragma unroll
    for (int q = 0; q < 4; ++q) { const int tq = tw0 + q < tw1 ? tw0 + q : tw0, b = tq / SEQ, r = b * LP + 128 + (tq - b * SEQ);
#pragma unroll
        for (int j = 0; j < 4; ++j) rw[q][j] = *(const GAS u32x2*)gp((const u32x2*)(H + (size_t)r * D) + F.lane + 64 * j); }
    for (int t0 = tw0; t0 < tw1; t0 += 4)
#pragma unroll
    for (int q = 0; q < 4; ++q) { const int t = t0 + q; if (t >= tw1) break;
        f32x4 v[4];
#pragma unroll
        for (int j = 0; j < 4; ++j) { const u32x2 w = rw[q][j]; v[j] = (f32x4){bflo(w.x), bfhi(w.x), bflo(w.y), bfhi(w.y)}; }
        { const int tn = t + 4 < tw1 ? t + 4 : t, b = tn / SEQ, r = b * LP + 128 + (tn - b * SEQ);
#pragma unroll
          for (int j = 0; j < 4; ++j) rw[q][j] = *(const GAS u32x2*)gp((const u32x2*)(H + (size_t)r * D) + F.lane + 64 * j); }
        const float rstd = row_rstd(F, v);
        float lg[8];
#pragma unroll
        for (int e = 0; e < 8; ++e) lg[e] = 0.f;
#pragma unroll
        for (int j = 0; j < 4; ++j) {
#pragma unroll
            for (int kk = 0; kk < 4; ++kk) { const float uu = v[j][kk] * rstd; const f32x4 a = wa[j][kk], c = wc[j][kk];
                lg[0] += uu * a.x; lg[1] += uu * a.y; lg[2] += uu * a.z; lg[3] += uu * a.w; lg[4] += uu * c.x; lg[5] += uu * c.y; lg[6] += uu * c.z; lg[7] += uu * c.w; } }
#pragma unroll
        for (int e = 0; e < 8; ++e) lg[e] = wave_sum(F.lane, lg[e]) + brr[e];
        int e1 = 0; float v1 = lg[0];
#pragma unroll
        for (int e = 1; e < 8; ++e) if (lg[e] > v1) { v1 = lg[e]; e1 = e; }
        int e2 = -1; float v2 = -INFINITY;
#pragma unroll
        for (int e = 0; e < 8; ++e) if (e != e1 && lg[e] > v2) { v2 = lg[e]; e2 = e; }
        const float w1 = 1.f / (1.f + __expf(v2 - v1)), w2 = 1.f - w1;
        if (F.lane == kit) { me1 = e1; me2 = e2; mw1 = w1; mt = t; }
        ++kit; (void)w2;
    }
    const int npw = (NT + F.NGW - 1) / F.NGW, K = NWAVES * npw;
    LAS int* le = (LAS int*)F.lds; LAS int* lt = le + 1024; LAS float* lw = (LAS float*)(le + 1536); LAS unsigned* lbase = (LAS unsigned*)(le + 2048);
    __syncthreads();
    if (F.lane < npw) { const int k = F.wave * npw + F.lane; le[k] = mt >= 0 ? me1 : -1; le[512 + k] = mt >= 0 ? me2 : -1; lt[k] = mt; lw[k] = mw1; }
    __syncthreads();
    int my_e[2] = {-1, -1}, my_r[2] = {0, 0}, my_k[2] = {0, 0};
#pragma unroll
    for (int q = 0; q < 2; ++q) { const int x = F.tid + q * NTHREADS; if (x < 2 * K) { const int rk = x / K, k = x - rk * K; const int e = le[rk * 512 + k]; int cnt = 0, rnk = 0;
            for (int k2 = 0; k2 < K; ++k2) { const int ee = le[rk * 512 + k2]; cnt += (ee == e) ? 1 : 0; rnk += (ee == e && k2 < k) ? 1 : 0; }
            my_e[q] = e; my_r[q] = rnk; my_k[q] = x;
            if (e >= 0 && rnk == 0 && !F.dry) lbase[rk * 8 + e] = atomicAdd(ctl + CW_CNT + 64 * (rk * 8 + e), (unsigned)cnt); } }
    __syncthreads();
#pragma unroll
    for (int q = 0; q < 2; ++q) if (my_e[q] >= 0 && !F.dry) { const int x = my_k[q], rk = x / K, k = x - rk * K, t = lt[k]; const float w1 = lw[k];
        asg_e[rk * 32768 + t] = my_e[q]; asg_i[rk * 32768 + t] = (int)(lbase[rk * 8 + my_e[q]] + (unsigned)my_r[q]); asg_w[rk * 32768 + t] = rk ? 1.f - w1 : w1; }
    __syncthreads();
}
__device__ __forceinline__ void phase_scatter(const Frame& F, const float* gain) {
    const bf16* H = (const bf16*)(F.ws + WS_H);
    const int* asg_e = (const int*)(F.ws + WS_SMALL + SM_ASG_E); const int* asg_i = (const int*)(F.ws + WS_SMALL + SM_ASG_I); const float* asg_w = (const float*)(F.ws + WS_SMALL + SM_ASG_W);
    int* slot_tok = (int*)(F.ws + WS_SMALL + SM_SLOT_TOK); float* slot_w = (float*)(F.ws + WS_SMALL + SM_SLOT_W);
    int* tile_e = (int*)(F.ws + WS_SMALL + SM_TILE_E); int* ntl = (int*)(F.ws + WS_SMALL + SM_NT);
    unsigned* ctl = (unsigned*)(F.ws + WS_CTL);
    unsigned char* xb[2] = {F.ws + WS_XB, F.ws + WS_XB + (size_t)MOE_ROWS * D};
    LAS int* tb = (LAS int*)(F.lds + TAB_OFF);
    if (F.tid < 16) tb[16 + F.tid] = (int)xb_ld(ctl + CW_CNT + 64 * F.tid);
    __syncthreads();
    if (F.tid == 0) {
#pragma unroll 1
        for (int rk = 0; rk < 2; ++rk) { int t = 0;
#pragma unroll 1
            for (int e = 0; e < 8; ++e) { tb[rk * 8 + e] = t; const int nt_ = (tb[16 + rk * 8 + e] + 255) >> 8;
                if (F.bid == 0) {
#pragma unroll 1
                    for (int q = 0; q < nt_; ++q) tile_e[rk * 256 + t + q] = e; }
                t += nt_; }
            if (F.bid == 0) ntl[rk] = t; } }
    __syncthreads();
    for (int g = 0; g < 16; ++g) { const int rk = g >> 3, cnt = tb[16 + g], base = tb[g] * 256, end = base + ((cnt + 255) >> 8) * 256;
        for (int s = base + cnt + F.gw; s < end; s += F.NGW) { if (F.lane == 0) { slot_tok[rk * MOE_ROWS + s] = -1; slot_w[rk * MOE_ROWS + s] = 0.f; }
            u32x4* xr = (u32x4*)(xb[rk] + (size_t)s * D); xr[F.lane] = zero4(); } }
    constexpr int NT = BATCH * SEQ;
    const int npw = (NT + F.NGW - 1) / F.NGW, tw0 = F.gw * npw, tw1 = (tw0 + npw) < NT ? (tw0 + npw) : NT;
    int ae[2], ai[2]; float aw[2];
    { const int tl = tw0 + F.lane < tw1 ? tw0 + F.lane : (tw0 < NT ? tw0 : 0);
#pragma unroll
      for (int rk = 0; rk < 2; ++rk) { ae[rk] = gld<int>(asg_e + rk * 32768 + tl); ai[rk] = gld<int>(asg_i + rk * 32768 + tl); aw[rk] = gld<float>(asg_w + rk * 32768 + tl); } }
    f32x4 gn[4];
#pragma unroll
    for (int j = 0; j < 4; ++j) gn[j] = gld<f32x4>((const f32x4*)gain + F.lane + 64 * j);
    u32x2 rw[4][4];
#pragma unroll
    for (int q = 0; q < 4; ++q) { const int tq = tw0 + q < tw1 ? tw0 + q : (tw0 < NT ? tw0 : 0), b = tq / SEQ, r = b * LP + 128 + (tq - b * SEQ);
#pragma unroll
        for (int j = 0; j < 4; ++j) rw[q][j] = *(const GAS u32x2*)gp((const u32x2*)(H + (size_t)r * D) + F.lane + 64 * j); }
    for (int t0 = tw0; t0 < tw1; t0 += 4)
#pragma unroll
    for (int q = 0; q < 4; ++q) { const int t = t0 + q; if (t >= tw1) break;
        const int b = t / SEQ, r = b * LP + 128 + (t - b * SEQ), k = t - tw0;
        f32x4 v[4];
#pragma unroll
        for (int j = 0; j < 4; ++j) { const u32x2 w = rw[q][j]; v[j] = (f32x4){bflo(w.x), bfhi(w.x), bflo(w.y), bfhi(w.y)}; }
        { const int tn = t + 4 < tw1 ? t + 4 : t, bn = tn / SEQ, rn = bn * LP + 128 + (tn - bn * SEQ);
#pragma unroll
          for (int j = 0; j < 4; ++j) rw[q][j] = *(const GAS u32x2*)gp((const u32x2*)(H + (size_t)rn * D) + F.lane + 64 * j); }
        const float rstd = row_rstd(F, v);
#pragma unroll
        for (int rk = 0; rk < 2; ++rk) { const int e = __builtin_amdgcn_readlane(ae[rk], k), s = tb[rk * 8 + e] * 256 + __builtin_amdgcn_readlane(ai[rk], k);
            const float wgt = __builtin_bit_cast(float, __builtin_amdgcn_readlane(__builtin_bit_cast(int, aw[rk]), k)); const float sc = rstd * XB_SCALE;
            unsigned* o4 = (unsigned*)(xb[rk] + (size_t)s * D) + F.lane;
#pragma unroll
            for (int j = 0; j < 4; ++j) gst<unsigned>(o4 + 64 * j, pg8::fp8x4((f32x4){v[j].x * sc * gn[j].x, v[j].y * sc * gn[j].y, v[j].z * sc * gn[j].z, v[j].w * sc * gn[j].w}));
            if (F.lane == 0) { gst<int>(slot_tok + rk * MOE_ROWS + s, r); gst<float>(slot_w + rk * MOE_ROWS + s, wgt); } }
    }
}
__device__ __forceinline__ void convert_expert_weights(const Frame& F) {
    unsigned char* GU = F.ws + WS_WEXP; unsigned char* DT = F.ws + WS_WEXP + (size_t)8 * 7168 * 1024;
    LAS float* scr = (LAS float*)(F.lds + F.wave * 16384);
    for (int it = F.gw; it < NEXP * 3 * 1792; it += F.NGW) {
        const int e = it / 5376, r = it - e * 5376, m = r / 1792, t = r - m * 1792;
        if (m < 2) { const int kb = t / 112, n0 = (t % 112) * 32; const float* W = inptr(m == 0 ? 25 : 26) + (size_t)e * D * DEXP;
            transpose_tile<true>(W, (size_t)DEXP, kb * 64, n0, 32, (bf16*)(GU + (size_t)e * 7168 * 1024), (size_t)D, 256 * (n0 / 128) + (n0 % 128) + 128 * m, kb * 64, nullptr, WU_SCALE, scr, F.lane); }
        else { const int kb = t / 32, n0 = (t % 32) * 32; const float* W = inptr(27) + (size_t)e * DEXP * D;
            transpose_tile<true>(W, (size_t)D, kb * 64, n0, 32, (bf16*)(DT + (size_t)e * 1024 * DEXP), (size_t)DEXP, n0, kb * 64, nullptr, WD_SCALE, scr, F.lane); }
    }
}
__device__ __forceinline__ void convert_ffn_weights(const Frame& F) {
    bf16* GU = (bf16*)(F.ws + WS_WFF); bf16* DT = GU + (size_t)2 * DFF * D;
    conv_matrix<1>(F, inptr(20), D, DFF, DFF, 0, GU, D, 0, nullptr);
    conv_matrix<1>(F, inptr(21), D, DFF, DFF, 0, GU, D, 128, nullptr);
    conv_matrix<0>(F, inptr(22), DFF, D, D, 0, DT, DFF, 0, nullptr);
}

namespace sk {
constexpr int CW_ERR = 32768;
constexpr size_t WS_DBG = 110 * MiB;
template <int NACC>
__device__ __forceinline__ void dot16(const bf16* A, size_t lda, const bf16* W0, const bf16* W1, size_t ldb, int nk, int lane, f32x4 (&acc)[NACC]) {
    const int i = lane & 15, kq = lane >> 4;
    const bf16* ap = A + (size_t)i * lda + 8 * kq; const bf16* w0 = W0 + (size_t)i * ldb + 8 * kq; const bf16* w1 = W1 + (size_t)i * ldb + 8 * kq;
#pragma unroll 1
    for (int s = 0; s < nk; s += 4) {
        bf16x8 a[4], b0[4], b1[4];
#pragma unroll
        for (int q = 0; q < 4; ++q) { const int ss = (s + q < nk) ? s + q : s;
            a[q] = *(const GAS bf16x8*)gp((const bf16x8*)(ap + 32 * ss)); b0[q] = *(const GAS bf16x8*)gp((const bf16x8*)(w0 + 32 * ss));
            if (NACC == 2) b1[q] = *(const GAS bf16x8*)gp((const bf16x8*)(w1 + 32 * ss)); }
#pragma unroll
        for (int q = 0; q < 4; ++q) if (s + q < nk) { acc[0] = __builtin_amdgcn_mfma_f32_16x16x32_bf16(b0[q], a[q], acc[0], 0, 0, 0);
            if (NACC == 2) acc[1] = __builtin_amdgcn_mfma_f32_16x16x32_bf16(b1[q], a[q], acc[1], 0, 0, 0); }
    }
}
template <int NACC>
__device__ __forceinline__ void reduce8(const Frame& F, f32x4 (&acc)[NACC]) {
    LAS f32x4* red = (LAS f32x4*)F.lds;
#pragma unroll
    for (int a = 0; a < NACC; ++a) red[(a * 8 + F.wave) * 64 + F.lane] = acc[a];
    __syncthreads();
    if (F.wave == 0) {
#pragma unroll
        for (int a = 0; a < NACC; ++a) { f32x4 s = red[(a * 8) * 64 + F.lane];
#pragma unroll
            for (int w = 1; w < 8; ++w) s += red[(a * 8 + w) * 64 + F.lane];
            acc[a] = s; } }
}
struct Cnt { unsigned n, e; };
__device__ __forceinline__ void chk(Cnt& C, float mine, float ref, float rel, float ab) {
#ifdef SK_EXACT
    rel = 0.f; ab = 0.f;
#endif
    C.n += 1u; if (!(fabsf(mine - ref) <= rel * fmaxf(fabsf(mine), fabsf(ref)) + ab)) C.e += 1u;
}
__device__ __forceinline__ void flush(const Frame& F, const Cnt& C) {
    unsigned* ctl = (unsigned*)(F.ws + WS_CTL);
    if (C.n) atomicAdd(ctl + CW_ERR + 64, C.n);
    if (C.e) atomicAdd(ctl + CW_ERR, C.e);
}
__device__ __forceinline__ u32x2 pack4(const f32x4 v) { u32x2 w; w.x = pg8::cvt_pk_bf16(v[0], v[1]); w.y = pg8::cvt_pk_bf16(v[2], v[3]); return w; }
template <bool CHECK>
__device__ __forceinline__ void put4(const Frame& F, Cnt& C, bf16* dst, size_t rs, const f32x4 v, int nb, float rel, float ab) {
    const u32x2 w = pack4(v);
#pragma unroll
    for (int b = 0; b < 4; ++b) if (b < nb) { u32x2* p = (u32x2*)(dst + (size_t)b * LP * rs);
        if (CHECK) { const u32x2 m = gld<u32x2>(p); chk(C, bflo(w.x), bflo(m.x), rel, ab); chk(C, bfhi(w.x), bfhi(m.x), rel, ab); chk(C, bflo(w.y), bflo(m.y), rel, ab); chk(C, bfhi(w.y), bfhi(m.y), rel, ab); }
        else if (!F.dry) gst<u32x2>(p, w); }
}
template <bool CHECK>
__device__ __forceinline__ void inproj(const Frame& F) { Cnt C{0u, 0u};
    const bf16* U = (const bf16*)(F.dout + DO_U) + (size_t)PADL * D; const bf16* W = (const bf16*)(F.ws + WS_WL + WL_IN);
    bf16* Ym = (bf16*)(F.ws + WS_YM); unsigned char* Yg = F.ws + WS_YG;
    if (!CHECK && !F.dry) { const u32x4 z4 = zero4();
        for (int idx = F.bid * NTHREADS + F.tid; idx < BATCH * PADL * (YW / 8); idx += F.G * NTHREADS) { const int row = idx / (YW / 8), c8 = idx % (YW / 8), b = row / PADL, p = row % PADL;
            gst<u32x4>(Ym + ((size_t)b * LP + p) * YW + 8 * c8, z4); } }
    for (int g = F.bid; g < 256 + 192; g += F.G) {
        const int wrow = g < 256 ? 16 * g : YW + 16 * (g - 256);
        f32x4 acc[1] = {(f32x4){0.f, 0.f, 0.f, 0.f}};
        dot16<1>(U + 128 * F.wave, D, W + (size_t)wrow * D + 128 * F.wave, W, D, 4, F.lane, acc);
        reduce8<1>(F, acc);
        if (F.wave == 0) { const int i = F.lane & 15, c = 4 * (F.lane >> 4);
            if (g < 256) put4<CHECK>(F, C, Ym + (size_t)(PADL + i) * YW + 16 * g + c, YW, acc[0], 4, 0.01f, 1e-3f);
            else { const unsigned w = pg8::q8(acc[0][0]) | (pg8::q8(acc[0][1]) << 8) | (pg8::q8(acc[0][2]) << 16) | (pg8::q8(acc[0][3]) << 24);
                unsigned* p = (unsigned*)(Yg + (size_t)(PADL + i) * NGATE + 16 * (g - 256) + c);
                if (CHECK) { const unsigned m = *p;
#pragma unroll
                    for (int e = 0; e < 4; ++e) chk(C, (float)((w >> (8 * e)) & 255u), (float)((m >> (8 * e)) & 255u), 0.f, 1.f); }
                else if (!F.dry) *p = w; } }
        __syncthreads();
    }
    if (CHECK) flush(F, C);
}
template <bool CHECK>
__device__ __forceinline__ void mlaprep(const Frame& F) { Cnt C{0u, 0u};
    const bf16* Ym0 = (const bf16*)(F.ws + WS_YM) + (size_t)PADL * YW; const bf16* W = (const bf16*)(F.ws + WS_WL + WL_UQKV);
    bf16* Q = (bf16*)(F.dout + DO_Q); bf16* Kb = (bf16*)(F.dout + DO_K); bf16* V = (bf16*)(F.ws + WS_V);
    const int hb = CHECK ? 0 : F.G / 2, nb = F.G - hb; if (F.bid < hb) return;
    if (!CHECK && !F.dry) { const u32x4 z4 = zero4();
        for (int idx = (F.bid - hb) * NTHREADS + F.tid; idx < BATCH * PADL * 256; idx += nb * NTHREADS) { const int row = idx >> 8, c = idx & 255, b = row / PADL, p = row % PADL; const size_t r = (size_t)b * LP + p;
            if (c < 96) gst<u32x4>(Q + r * QKW + 8 * c, z4); else if (c < 192) gst<u32x4>(Kb + r * QKW + 8 * (c - 96), z4); else gst<u32x4>(V + r * VW + 8 * (c - 192), z4); } }
    for (int g = F.bid - hb; g < 48 + 64; g += nb) {
        const bool kv = g >= 48; const int n0 = kv ? 16 * (g - 48) : 16 * g;
        f32x4 acc[1] = {(f32x4){0.f, 0.f, 0.f, 0.f}};
        dot16<1>(Ym0 + (kv ? C_DKV : C_DQ) + 32 * F.wave, YW, W + (size_t)((kv ? 768 : 0) + n0) * 256 + 32 * F.wave, W, 256, 1, F.lane, acc);
        reduce8<1>(F, acc);
        if (F.wave == 0) { const int i = F.lane & 15, c = n0 + 4 * (F.lane >> 4); const size_t r = (size_t)(PADL + i);
            if (!kv) put4<CHECK>(F, C, Q + r * QKW + c, QKW, acc[0], 4, 0.01f, 1e-3f);
            else { const int hh = c >> 7, d = c & 127;
                if (d < 64) put4<CHECK>(F, C, Kb + r * QKW + hh * 96 + d, QKW, acc[0], 4, 0.01f, 1e-3f); else put4<CHECK>(F, C, V + r * VW + hh * 64 + d - 64, VW, acc[0], 4, 0.01f, 1e-3f); } }
        __syncthreads();
    }
    if (CHECK) flush(F, C);
}
template <bool CHECK>
__device__ __forceinline__ void mix(const Frame& F) { Cnt C{0u, 0u};
    const bf16* Ym0 = (const bf16*)(F.ws + WS_YM) + (size_t)PADL * YW; const bf16* O0 = Ym0 + C_O; const unsigned char* Yg0 = F.ws + WS_YG + (size_t)PADL * NGATE;
    bf16* Mx = (bf16*)(F.dout + DO_MIX); unsigned char* wl = F.ws + WS_WL;
    const int w = F.wave, I = w < 4 ? 0 : (w < 6 ? 1 : 2);
    const bf16* A = I == 0 ? O0 + 128 * w : (I == 1 ? Ym0 + C_GV + 256 * (w - 4) : Ym0 + C_HI + 256 * (w - 6));
    const size_t lda = YW, ldb = 512; const int nk = I == 0 ? 4 : 8;
    const bf16* Wb = I == 0 ? (const bf16*)(wl + WL_OM) + 128 * w : (I == 1 ? (const bf16*)(wl + WL_OG) + 256 * (w - 4) : (const bf16*)(wl + WL_OH) + 256 * (w - 6));
    for (int g = F.bid; g < 64; g += F.G) {
        f32x4 acc[1] = {(f32x4){0.f, 0.f, 0.f, 0.f}};
        dot16<1>(A, lda, Wb + (size_t)(16 * g) * ldb, Wb, ldb, nk, F.lane, acc);
        const int i = F.lane & 15, c = 16 * g + 4 * (F.lane >> 4);
        const unsigned gw = gld<unsigned>(Yg0 + (size_t)i * NGATE + I * 1024 + c); const float s = 1.f / 255.f;
        acc[0][0] *= (float)(gw & 255u) * s; acc[0][1] *= (float)((gw >> 8) & 255u) * s; acc[0][2] *= (float)((gw >> 16) & 255u) * s; acc[0][3] *= (float)(gw >> 24) * s;
        reduce8<1>(F, acc);
        if (F.wave == 0) put4<CHECK>(F, C, Mx + (size_t)(PADL + i) * D + c, D, acc[0], 1, 0.03f, 3e-3f);
        __syncthreads();
    }
    if (CHECK) flush(F, C);
}
template <bool CHECK>
__device__ __forceinline__ void resid(const Frame& F, const bf16* A0, size_t lda, const bf16* W, int K, const bf16* hold) { Cnt C{0u, 0u};
    bf16* H = (bf16*)(F.ws + WS_H); const int nk = K / 256, k0 = (K / 8) * F.wave;
    for (int g = F.bid; g < 64; g += F.G) {
        f32x4 acc[1] = {(f32x4){0.f, 0.f, 0.f, 0.f}};
        dot16<1>(A0 + k0, lda, W + (size_t)(16 * g) * K + k0, W, (size_t)K, nk, F.lane, acc);
        reduce8<1>(F, acc);
        if (F.wave == 0) { const int i = F.lane & 15, c = 16 * g + 4 * (F.lane >> 4);
            const u32x2 x = gld<u32x2>(hold + (size_t)i * D + c);
            const f32x4 v = acc[0] + (f32x4){bflo(x.x), bfhi(x.x), bflo(x.y), bfhi(x.y)};
            put4<CHECK>(F, C, H + (size_t)(PADL + i) * D + c, D, v, 4, 0.01f, 1e-3f); }
        __syncthreads();
    }
    if (CHECK) flush(F, C);
}
template <bool CHECK>
__device__ __forceinline__ void ffn_up(const Frame& F) { Cnt C{0u, 0u};
    const bf16* U = (const bf16*)(F.dout + DO_U) + (size_t)PADL * D; const bf16* GU = (const bf16*)(F.ws + WS_WFF); bf16* Hm = (bf16*)(F.ws + WS_HMID);
    for (int g = F.bid; g < DFF / 16; g += F.G) {
        const int hc0 = 16 * g, r0 = 256 * (hc0 >> 7) + (hc0 & 127);
        f32x4 acc[2] = {(f32x4){0.f, 0.f, 0.f, 0.f}, (f32x4){0.f, 0.f, 0.f, 0.f}};
        dot16<2>(U + 128 * F.wave, D, GU + (size_t)r0 * D + 128 * F.wave, GU + (size_t)(r0 + 128) * D + 128 * F.wave, D, 4, F.lane, acc);
        reduce8<2>(F, acc);
        if (F.wave == 0) { const int i = F.lane & 15, c = hc0 + 4 * (F.lane >> 4); f32x4 h;
#pragma unroll
            for (int e = 0; e < 4; ++e) { const float gq = acc[0][e], uq = acc[1][e]; h[e] = gq * frcp(1.f + __expf(-gq)) * uq; }
            put4<CHECK>(F, C, Hm + (size_t)(PADL + i) * DFF + c, DFF, h, 1, 0.02f, 1e-3f); }
        __syncthreads();
    }
    if (CHECK) flush(F, C);
}
}

#ifndef SK_ERR_MAX
#define SK_ERR_MAX 200u
#endif
#ifndef SKMODE
#define SKMODE 1
#endif
enum { OP_INIT = 0, OP_INPROJ, OP_MLAPREP, OP_ATTN, OP_LIN, OP_MIX0, OP_MIX1, OP_MIX2, OP_CONV, OP_WOUT, OP_NORM_FFN, OP_FFN_UP, OP_FFN_DOWN, OP_NEXT, OP_ROUTE, OP_SCATTER, OP_MOE_UP, OP_MOE_DOWN, OP_MLAFIX, OP_NOP, OP_MLAPREP2 };
#define SW(op, layer, rh) ((unsigned)(op) | ((unsigned)(layer) << 5) | ((unsigned)(rh) << 6))
#define SWDRY(op, layer, rh) (SW(op, layer, rh) | 256u)
#ifndef STEP_PROGRAM
#define STEP_PROGRAM \
    SW(OP_INIT, 0, 0), \
    SW(OP_INPROJ, 0, 0), SW(OP_MLAPREP, 0, 0), SW(OP_MLAPREP2, 0, 0), SW(OP_MLAFIX, 0, 0), SW(OP_ATTN, 0, 0), SW(OP_MIX0, 0, 0), SW(OP_CONV, 0, 0), SW(OP_WOUT, 0, 0), \
    SW(OP_NORM_FFN, 0, 0), SW(OP_FFN_UP, 0, 0), SW(OP_FFN_DOWN, 0, 0), SW(OP_NEXT, 0, 0), \
    SW(OP_INPROJ, 1, 0), SW(OP_MLAPREP, 1, 0), SW(OP_MLAPREP2, 1, 0), SW(OP_MLAFIX, 1, 0), SW(OP_ATTN, 1, 0), SW(OP_MIX0, 1, 0), SW(OP_CONV, 1, 0), SW(OP_WOUT, 1, 0), \
    SW(OP_ROUTE, 1, 0), SW(OP_SCATTER, 1, 0), \
    SW(OP_MOE_UP, 1, 0), SW(OP_MOE_DOWN, 1, 0), SW(OP_MOE_UP, 1, 1), SW(OP_MOE_DOWN, 1, 1)
#endif
__device__ __forceinline__ unsigned step_word(int st) {
    constexpr unsigned prog[] = {STEP_PROGRAM};
    unsigned w = 0;
#pragma unroll
    for (int i = 0; i < (int)(sizeof(prog) / sizeof(prog[0])); ++i) w = (st == i) ? prog[i] : w;
    return w;
}
constexpr unsigned step_prog_host[] = {STEP_PROGRAM};
constexpr int NSTEP = (int)(sizeof(step_prog_host) / sizeof(step_prog_host[0]));
__global__ void __launch_bounds__(NTHREADS, 2) fwd_kernel(Args args) {
    extern __shared__ __attribute__((aligned(16))) unsigned char lds_raw[];
    Frame F;
    F.lds = (LAS unsigned char*)lds_raw; F.ws = args.ws; F.dout = (unsigned char*)args.out;
    F.tid = threadIdx.x; F.lane = F.tid & 63; F.wave = __builtin_amdgcn_readfirstlane(F.tid >> 6);
    F.G = gridDim.x; F.bid = blockIdx.x; F.gw = F.bid * NWAVES + F.wave; F.NGW = F.G * NWAVES;
    volatile LAS unsigned* MISC = (volatile LAS unsigned*)(F.lds + MISC_OFF);
    for (int u = F.tid; u < (LDS_BYTES - LDSCTL_OFF) / 4; u += NTHREADS) ((LAS unsigned*)(F.lds + LDSCTL_OFF))[u] = 0u;
    __syncthreads();
    unsigned* ctl = (unsigned*)(F.ws + WS_CTL);
    XcdBarrier bar = xcd_barrier_post(ctl + CW_BAR, MISC + 8);
    const int wave0 = F.wave;
#pragma unroll 1
    for (int st = args.ph_lo; st < args.ph_hi; ++st) {
        { unsigned char* p_ = args.ws; asm volatile("" : "+s"(p_)); F.ws = p_; p_ = (unsigned char*)args.out; asm volatile("" : "+s"(p_)); F.dout = p_;
          int wv_ = wave0; asm volatile("" : "+s"(wv_)); int ln_; asm volatile("v_mbcnt_lo_u32_b32 %0, -1, 0\n\tv_mbcnt_hi_u32_b32 %0, -1, %0" : "=v"(ln_)); int tid_ = wv_ * 64 + ln_; int bid_ = blockIdx.x; asm volatile("" : "+s"(bid_)); int G_ = gridDim.x; asm volatile("" : "+s"(G_));
          unsigned lo_ = 0; asm volatile("" : "+s"(lo_));
          F.lds = (LAS unsigned char*)lds_raw + lo_; F.tid = tid_; F.lane = tid_ & 63; F.wave = __builtin_amdgcn_readfirstlane(tid_ >> 6); F.G = G_; F.bid = bid_; F.gw = bid_ * NWAVES + F.wave; F.NGW = G_ * NWAVES; }
        LAS unsigned char* ring = F.lds;
        int layer, op, rh = 0;
        { const unsigned pw = step_word(st); op = pw & 31; layer = (pw >> 5) & 1; rh = (pw >> 6) & 3; F.dry = (pw >> 8) & 1; }
        bool is_gemm = false, sync_after = true, fp8 = false;
        pg8::Gemm g{nullptr, nullptr, 0, 0, 0}; pg8::Order S{0, 0, 0, F.G, F.bid, 0, 0, 0, (const LAS int*)(F.lds + TAB_OFF), 0, 0, 0, 0, 0}; pg8::Epi E{0, nullptr, nullptr, nullptr, nullptr, 0, 0, F.dry, 1.f, 0.f};
        unsigned char* wl = F.ws + WS_WL;
        constexpr int XM = (SKMODE == 1) ? 1 : 0;
#if SKMODE == 1
        if (op == OP_INPROJ) sk::inproj<false>(F);
        else if (op == OP_MLAPREP) sk::mlaprep<false>(F);
        else if (op == OP_MIX0 && layer == 0) sk::mix<false>(F);
        else if (op == OP_WOUT && layer == 0) sk::resid<false>(F, (const bf16*)(F.dout + DO_MIX) + (size_t)PADL * D, D, (const bf16*)(wl + WL_OUT), D, (const bf16*)(F.ws + WS_H) + (size_t)PADL * D);
        else if (op == OP_FFN_UP) sk::ffn_up<false>(F);
        else if (op == OP_FFN_DOWN) sk::resid<false>(F, (const bf16*)(F.ws + WS_HMID) + (size_t)PADL * DFF, DFF, (const bf16*)(F.ws + WS_WFF) + (size_t)2 * DFF * D, DFF, (const bf16*)(F.ws + WS_H) + (size_t)PADL * D);
#elif SKMODE == 2
        { bool did = true; const bf16* dbg = (const bf16*)(F.ws + sk::WS_DBG);
          if (op == OP_MLAPREP) sk::inproj<true>(F);
          else if (op == OP_MLAFIX) sk::mlaprep<true>(F);
          else if (op == OP_CONV && layer == 0) sk::mix<true>(F);
          else if (op == OP_NORM_FFN) sk::resid<true>(F, (const bf16*)(F.dout + DO_MIX) + (size_t)PADL * D, D, (const bf16*)(wl + WL_OUT), D, dbg);
          else if (op == OP_FFN_DOWN) sk::ffn_up<true>(F);
          else if (op == OP_NEXT) sk::resid<true>(F, (const bf16*)(F.ws + WS_HMID) + (size_t)PADL * DFF, DFF, (const bf16*)(F.ws + WS_WFF) + (size_t)2 * DFF * D, DFF, dbg);
          else did = false;
          if ((op == OP_CONV || op == OP_FFN_UP) && layer == 0 && F.bid == 0) {
              for (int i = F.tid; i < 16 * D / 8; i += NTHREADS) *((u32x4*)(F.ws + sk::WS_DBG) + i) = *((const u32x4*)((const bf16*)(F.ws + WS_H) + (size_t)PADL * D) + i); }
          if (did) xcd_barrier(bar); }
#endif
        switch (op) {
        case OP_INIT:
            convert_layer_weights(F, 0); phase_rope_table(F); phase_init_rows(F, inptr(2)); break;
        case OP_INPROJ:
            is_gemm = true; g = pg8::Gemm{(const bf16*)(F.dout + DO_U), (const bf16*)(wl + WL_IN), D, D, D}; S.nM = XM ? 128 : M / 256; S.xrow = XM; S.nN = 28;
            E.kind = pg8::EK_INPROJ; E.o0 = F.ws + WS_YM; E.o1 = F.ws + WS_YG; break;
        case OP_MLAPREP:
            is_gemm = true; sync_after = false; g = pg8::Gemm{(const bf16*)(F.ws + WS_YM) + C_DQ, (const bf16*)(wl + WL_UQKV), 256, YW, 256}; S.nM = XM ? 128 : M / 256; S.xrow = XM; S.nN = 3;
            E.kind = pg8::EK_MLA; E.o0 = F.dout + DO_Q; E.o1 = F.dout + DO_K; E.i0 = F.ws + WS_V; E.fin = 0; break;
        case OP_MLAPREP2:
            is_gemm = true; g = pg8::Gemm{(const bf16*)(F.ws + WS_YM) + C_DKV, (const bf16*)(wl + WL_UQKV) + 768 * 256, 128, YW, 256}; S.nM = XM ? 128 : M / 256; S.xrow = XM; S.nN = 4;
            E.kind = pg8::EK_MLA; E.o0 = F.dout + DO_Q; E.o1 = F.dout + DO_K; E.i0 = F.ws + WS_V; E.fin = 3; break;
        case OP_MLAFIX: mla::fix(F, layer); phase_lin_prep(F, layer); break;
        case OP_NOP: break;
        case OP_ATTN: phase_linattn(F, layer); att::phase(F, layer); break;
        case OP_LIN: phase_linattn(F, layer); break;
        case OP_MIX0:
            is_gemm = true; g = pg8::Gemm{(const bf16*)(F.ws + WS_YM) + C_O, (const bf16*)(wl + WL_OM), 512, YW, 512}; S.nM = (XM || layer) ? 128 : M / 256; S.xrow = (XM || layer) ? 1 : 0; S.nN = 4;
            S.msub = 1; S.ao1 = (C_GV - C_O) * 2; S.ao2 = (C_HI - C_O) * 2;
            E.kind = pg8::EK_MIX0; E.o0 = F.dout + DO_MIX; E.i0 = F.ws + WS_YG; break;
        case OP_MIX1: case OP_MIX2: break;
        case OP_CONV:
            sync_after = false; if (layer == 0) convert_ffn_weights(F); else convert_expert_weights(F); break;
        case OP_WOUT:
            is_gemm = true; g = pg8::Gemm{(const bf16*)(F.dout + DO_MIX), (const bf16*)(wl + WL_OUT), D, D, D}; S.nM = (XM || layer) ? 128 : M / 256; S.xrow = (XM || layer) ? 1 : 0; S.nN = 4;
            E.kind = pg8::EK_RESID; E.o0 = F.ws + WS_H; break;
        case OP_NORM_FFN: phase_norm_rows(F, inptr(19), (bf16*)(F.dout + DO_U)); break;
        case OP_FFN_UP:
            is_gemm = true; g = pg8::Gemm{(const bf16*)(F.dout + DO_U), (const bf16*)(F.ws + WS_WFF), D, D, D}; S.nM = XM ? 128 : M / 256; S.xrow = XM; S.nN = 22;
            E.kind = pg8::EK_SWIGLU; E.o0 = F.ws + WS_HMID; E.ldo = DFF; break;
        case OP_FFN_DOWN:
            is_gemm = true; g = pg8::Gemm{(const bf16*)(F.ws + WS_HMID), (const bf16*)(F.ws + WS_WFF) + (size_t)2 * DFF * D, DFF, DFF, DFF}; S.nM = XM ? 128 : M / 256; S.xrow = XM; S.nN = 4;
            E.kind = pg8::EK_RESID; E.o0 = F.ws + WS_H; break;
        case OP_NEXT:
            convert_layer_weights(F, 1); phase_norm_rows(F, inptr(2) + D, (bf16*)(F.dout + DO_U)); break;
        case OP_ROUTE: phase_route(F, inptr(19) + D); break;
        case OP_SCATTER: phase_scatter(F, inptr(19) + D); break;
        default: {
            const int rk = rh;
            const int* tile_e = (const int*)(F.ws + WS_SMALL + SM_TILE_E) + rk * 256; const int* ntl = (const int*)(F.ws + WS_SMALL + SM_NT);
            LAS int* te = (LAS int*)(F.lds + TAB_OFF);
            const int nt_ = __builtin_amdgcn_readfirstlane(__hip_atomic_load(ntl + rk, __ATOMIC_RELAXED, __HIP_MEMORY_SCOPE_AGENT));
            for (int i = F.tid; i < 256; i += NTHREADS) te[i] = __hip_atomic_load(tile_e + i, __ATOMIC_RELAXED, __HIP_MEMORY_SCOPE_AGENT);
            const bf16* GU = (const bf16*)(F.ws + WS_WEXP); const bf16* DT = (const bf16*)(F.ws + WS_WEXP + (size_t)8 * 7168 * 1024);
            is_gemm = true; S.nM = nt_; S.grouped = 1;
            fp8 = true;
            if (op == OP_MOE_UP) { g = pg8::Gemm{(const bf16*)(F.ws + WS_XB + (size_t)rk * MOE_ROWS * D), GU, D, D, D}; S.nN = 28; S.tpe = 28; S.boff = 0;
                if (rk == 1) { const int nt0 = __builtin_amdgcn_readfirstlane(__hip_atomic_load(ntl + 0, __ATOMIC_RELAXED, __HIP_MEMORY_SCOPE_AGENT)); const int l3 = nt0 * 4 - 2 * F.G; S.late = (l3 > 0 && l3 < F.G / 2) ? l3 : 0; }
                E.kind = pg8::EK_SWIGLU; E.o0 = F.ws + WS_HQ + (size_t)rk * MOE_ROWS * DEXP; E.ldo = DEXP; E.osc = HQ_SCALE; E.isc = 1.f / (XB_SCALE * WU_SCALE); }
            else { g = pg8::Gemm{(const bf16*)(F.ws + WS_HQ + (size_t)rk * MOE_ROWS * DEXP), DT, DEXP, DEXP, DEXP}; S.nN = 4; S.tpe = 4; S.boff = 0;
                if (rk == 0) sync_after = false;
                E.kind = pg8::EK_MOEDOWN; E.o0 = F.ws + WS_H; E.o1 = F.dout; E.i0 = (const int*)(F.ws + WS_SMALL + SM_SLOT_TOK) + rk * MOE_ROWS; E.i1 = (const float*)(F.ws + WS_SMALL + SM_SLOT_W) + rk * MOE_ROWS; E.fin = (rk == 1) ? 1 : 0;
                E.osc = 1.f / (HQ_SCALE * WD_SCALE); }
            break; }
        }
        __syncthreads();
        if (is_gemm) { S.nwg = S.nM * S.nN;
            if (fp8) pg8::gemm_phase<pg8::Epi, pg8::Order, true, true>(ring, g, S, E, F.tid); else pg8::gemm_phase<pg8::Epi, pg8::Order, true, false>(ring, g, S, E, F.tid); }
        if (sync_after && st + 1 < args.ph_hi) xcd_barrier(bar);
    }
#if SKMODE == 2
    xcd_barrier(bar);
    { const unsigned e = xb_ld(ctl + sk::CW_ERR), n = xb_ld(ctl + sk::CW_ERR + 64);
      if (blockIdx.x == 0 && (e > SK_ERR_MAX || n != 1044480u)) args.out[threadIdx.x] = __builtin_nanf(""); }
#endif
}

extern "C" void kernel_launch(void* const* d_in, const int* in_sizes, int n_in, void* d_out, int out_size, void* d_ws, size_t ws_size, hipStream_t stream) {
    static int grid = 0;
    if (grid == 0) {
        if (n_in != 28 || ws_size < WS_END || out_size != BATCH * SEQ * D) { fprintf(stderr, "kernel_launch: unexpected shapes (n_in %d, ws %zu, out %d)\n", n_in, ws_size, out_size); grid = -1; return; }
        int dev = 0, cus = 0, per_cu = 0;
        if (hipGetDevice(&dev) != hipSuccess || hipDeviceGetAttribute(&cus, hipDeviceAttributeMultiprocessorCount, dev) != hipSuccess) { grid = -1; return; }
        if (hipFuncSetAttribute((const void*)fwd_kernel, hipFuncAttributeMaxDynamicSharedMemorySize, LDS_BYTES) != hipSuccess) { fprintf(stderr, "kernel_launch: hipFuncSetAttribute failed\n"); grid = -1; return; }
        if (hipOccupancyMaxActiveBlocksPerMultiprocessor(&per_cu, (const void*)fwd_kernel, NTHREADS, LDS_BYTES) != hipSuccess || per_cu < 1) { fprintf(stderr, "kernel_launch: occupancy query says %d\n", per_cu); }
        (void)hipGetLastError();
        grid = cus;
    }
    if (grid < 0) return;
    if (hipMemsetAsync((char*)d_ws + WS_CTL, 0, CTL_BYTES, stream) != hipSuccess) return;
    Args a{};
    for (int i = 0; i < 28; ++i) a.in[i] = (const float*)d_in[i];
    a.out = (float*)d_out; a.ws = (unsigned char*)d_ws; a.ph_lo = 0; a.ph_hi = NSTEP;
    hipLaunchKernelGGL(fwd_kernel, dim3(grid), dim3(NTHREADS), LDS_BYTES, stream, a);
}
```
